# Optimizing an MI355X kernel written in HIP

```python
import jax, jax.numpy as jnp
from jax import lax
import numpy as np

D_MODEL = 1024
BATCH = 2
SEQ = 8192
DEPTH = 1

CHUNK = 64
Q_BLOCK = 128
EPS = 1e-6
D_ATTN = D_MODEL // 2
HEAD_DIM = 64
N_HEADS = D_ATTN // HEAD_DIM
N_IDX_HEADS = 4
IDX_DIM = 64
TOPK_MAX = 256
D_POOL = D_MODEL // 2
POOL_WINDOWS = (2, 4, 8, 16)
N_POOL_GROUPS = len(POOL_WINDOWS)
POOL_GROUP_DIM = D_POOL // N_POOL_GROUPS
N_BRANCH = 2
N_EXPERTS = 32
TOP_K_EXPERTS = 4
D_EXPERT = D_MODEL
SWIGLU_LIMIT = 7.0
SWIGLU_ALPHA = 1.702
_WIDTHS = (D_ATTN, D_ATTN, D_ATTN, N_IDX_HEADS * IDX_DIM, IDX_DIM, N_IDX_HEADS, D_POOL, N_BRANCH * D_MODEL)
D_IN_PROJ = sum(_WIDTHS)
SPLIT_OFFSETS = tuple(int(v) for v in np.cumsum(_WIDTHS)[:-1])

kernel_name = "hybrid_dsa_pool_moe_block"


def _rmsnorm(x, g):
    xf = x.astype(jnp.float32)
    xf = xf * lax.rsqrt(jnp.mean(xf * xf, axis=-1, keepdims=True) + EPS)
    return (xf * g.astype(jnp.float32)).astype(x.dtype)


def _gather_rows(kb, ib):
    return kb[ib]


def _dsa_attention(q, k, v, iq, ik, iw, q_norm_g, k_norm_g):
    B_, S_ = q.shape[0], q.shape[1]
    L = S_
    topk = min(TOPK_MAX, L // 4)
    n_blocks = S_ // Q_BLOCK
    q = _rmsnorm(q, q_norm_g)
    k = _rmsnorm(k, k_norm_g)
    scale = HEAD_DIM ** -0.5
    idx_scale = IDX_DIM ** -0.5
    iw = iw.astype(jnp.float32) * (N_IDX_HEADS ** -0.5)
    key_pos = jnp.arange(S_)

    def to_blocks(a):
        return jnp.swapaxes(a.reshape((B_, n_blocks, Q_BLOCK) + a.shape[2:]), 0, 1)

    def one_block(args):
        qb, iqb, iwb, blk = args
        t = blk * Q_BLOCK + jnp.arange(Q_BLOCK)
        limit = (t // CHUNK + 1) * CHUNK
        admissible = key_pos[None, :] < limit[:, None]
        dots = jnp.einsum('bthd,bsd->bths', iqb, ik).astype(jnp.float32) * idx_scale
        score = jnp.einsum('bths,bth->bts', jax.nn.relu(dots), iwb)
        score = jnp.where(admissible[None], score, -jnp.inf)
        _, sel = lax.top_k(score, topk)
        valid = sel < limit[None, :, None]
        ksel = jax.vmap(_gather_rows)(k, sel)
        vsel = jax.vmap(_gather_rows)(v, sel)
        logits = jnp.einsum('bthd,btkhd->bhtk', qb, ksel).astype(jnp.float32) * scale
        logits = jnp.where(valid[:, None], logits, -jnp.inf)
        p = jax.nn.softmax(logits, axis=-1)
        return jnp.einsum('bhtk,btkhd->bthd', p.astype(vsel.dtype), vsel)

    out = lax.map(one_block, (to_blocks(q), to_blocks(iq), to_blocks(iw), jnp.arange(n_blocks)))
    out = jnp.swapaxes(out, 0, 1).reshape(B_, S_, N_HEADS * HEAD_DIM)
    return out


def _pool_mixer(u, pool_w, pool_b, pool_scale):
    B_, S_, _ = u.shape
    uf = u.astype(jnp.float32)
    csum = jnp.concatenate([jnp.zeros((B_, 1, D_POOL), jnp.float32), jnp.cumsum(uf, axis=1)], axis=1)
    t = jnp.arange(S_)
    groups = []
    for g, w in enumerate(POOL_WINDOWS):
        sl = slice(g * POOL_GROUP_DIM, (g + 1) * POOL_GROUP_DIM)
        lo = jnp.maximum(t + 1 - w, 0)
        cnt = (t + 1 - lo).astype(jnp.float32)
        c = csum[:, :, sl]
        mean = (c[:, 1:] - jnp.take(c, lo, axis=1)) / cnt[None, :, None]
        groups.append(mean - uf[:, :, sl])
    y = jnp.stack(groups, axis=2).astype(u.dtype)
    y = jnp.einsum('bsgc,gcd->bsgd', y, pool_w).reshape(B_, S_, D_POOL)
    return (y + pool_b) * pool_scale


def _moe(h, router_w, router_b, w1, b1, w2, b2):
    B_, S_, D_ = h.shape
    tok = h.reshape(-1, D_)
    logits = (tok @ router_w).astype(jnp.float32) + router_b.astype(jnp.float32)
    topv, topi = lax.top_k(logits, TOP_K_EXPERTS)
    topw = jax.nn.softmax(topv, axis=-1)
    combine = jnp.sum(jax.nn.one_hot(topi, N_EXPERTS, dtype=jnp.float32) * topw[..., None], axis=1)
    out = jnp.zeros(tok.shape, jnp.float32)
    for e in range(N_EXPERTS):
        gu = tok @ w1[e] + b1[e]
        gate = jnp.minimum(gu[:, :D_EXPERT], SWIGLU_LIMIT)
        lin = jnp.clip(gu[:, D_EXPERT:], -SWIGLU_LIMIT, SWIGLU_LIMIT)
        act = (lin + 1) * gate * jax.nn.sigmoid(SWIGLU_ALPHA * gate)
        out = out + combine[:, e:e + 1] * (act @ w2[e] + b2[e])
    return out.reshape(B_, S_, D_).astype(h.dtype)


def setup_inputs(seed: int = 0) -> dict:
    key = jax.random.key(seed)
    ks = jax.random.split(key, 20)
    f32 = jnp.float32
    nrm = lambda k, shape, s: jax.random.normal(k, shape, f32) * s
    return {
        "x": nrm(ks[0], (BATCH, SEQ, D_MODEL), 1.0),
        "attn_norm_g": 1.0 + nrm(ks[1], (DEPTH, D_MODEL), 0.05),
        "w_in": nrm(ks[2], (DEPTH, D_MODEL, D_IN_PROJ), D_MODEL ** -0.5),
        "q_norm_g": 1.0 + nrm(ks[3], (DEPTH, HEAD_DIM), 0.05),
        "k_norm_g": 1.0 + nrm(ks[4], (DEPTH, HEAD_DIM), 0.05),
        "pool_w": nrm(ks[5], (DEPTH, N_POOL_GROUPS, POOL_GROUP_DIM, POOL_GROUP_DIM), POOL_GROUP_DIM ** -0.5),
        "pool_b": nrm(ks[6], (DEPTH, D_POOL), 0.02),
        "pool_scale": 1.0 + nrm(ks[7], (DEPTH, D_POOL), 0.05),
        "w_branch_attn": nrm(ks[8], (DEPTH, D_ATTN, D_MODEL), D_ATTN ** -0.5),
        "w_branch_pool": nrm(ks[9], (DEPTH, D_POOL, D_MODEL), D_POOL ** -0.5),
        "w_out": nrm(ks[10], (DEPTH, D_MODEL, D_MODEL), D_MODEL ** -0.5),
        "ffn_norm_g": 1.0 + nrm(ks[11], (DEPTH, D_MODEL), 0.05),
        "router_w": nrm(ks[12], (DEPTH, D_MODEL, N_EXPERTS), D_MODEL ** -0.5),
        "router_b": nrm(ks[13], (DEPTH, N_EXPERTS), 0.01),
        "expert_w1": nrm(ks[14], (DEPTH, N_EXPERTS, D_MODEL, 2 * D_EXPERT), D_MODEL ** -0.5),
        "expert_b1": nrm(ks[15], (DEPTH, N_EXPERTS, 2 * D_EXPERT), 0.02),
        "expert_w2": nrm(ks[16], (DEPTH, N_EXPERTS, D_EXPERT, D_MODEL), D_EXPERT ** -0.5),
        "expert_b2": nrm(ks[17], (DEPTH, N_EXPERTS, D_MODEL), 0.02),
    }


def reference(x, attn_norm_g, w_in, q_norm_g, k_norm_g, pool_w, pool_b, pool_scale,
              w_branch_attn, w_branch_pool, w_out, ffn_norm_g, router_w, router_b,
              expert_w1, expert_b1, expert_w2, expert_b2):
    B_, S_, _ = x.shape
    for l in range(DEPTH):
        h = _rmsnorm(x, attn_norm_g[l])
        proj = h @ w_in[l]
        q, k, v, iq, ik, iw, u, gates = jnp.split(proj, SPLIT_OFFSETS, axis=-1)
        q = q.reshape(B_, S_, N_HEADS, HEAD_DIM)
        k = k.reshape(B_, S_, N_HEADS, HEAD_DIM)
        v = v.reshape(B_, S_, N_HEADS, HEAD_DIM)
        iq = iq.reshape(B_, S_, N_IDX_HEADS, IDX_DIM)
        y_attn = _dsa_attention(q, k, v, iq, ik, iw, q_norm_g[l], k_norm_g[l])
        y_pool = _pool_mixer(u, pool_w[l], pool_b[l], pool_scale[l])
        g_attn, g_pool = jnp.split(jax.nn.sigmoid(gates.astype(jnp.float32)), N_BRANCH, axis=-1)
        merged = g_attn * (y_attn @ w_branch_attn[l]) + g_pool * (y_pool @ w_branch_pool[l])
        x = x + merged.astype(x.dtype) @ w_out[l]
        h2 = _rmsnorm(x, ffn_norm_g[l])
        x = x + _moe(h2, router_w[l], router_b[l], expert_w1[l], expert_b1[l], expert_w2[l], expert_b2[l])
    return x
```

```cpp
#define MK_SPLIT 0
#include <hip/hip_runtime.h>
#include <hip/hip_bf16.h>
#include <cstdio>
#include <cstdint>
#include <cmath>
constexpr int NWAVES = 8;
#ifndef MK_SPLIT
#define MK_SPLIT 0
#endif
constexpr int N_PHASES = 11;

constexpr int BATCH = 2, SEQ = 8192, DMODEL = 1024, M = BATCH * SEQ;
constexpr int DATT = 512, HD = 64, NH = 8, NIH = 4, IDIM = 64, TOPK = 256, DPOOL = 512, NEXP = 32, TOPE = 4, DEXP = 1024;
constexpr int NIN = 4420;
constexpr int NINP = 4608;
constexpr float EPS = 1e-6f;
constexpr int MP_TILES = 288, MPAD = MP_TILES * 256;

constexpr size_t MiB = 1u << 20;
constexpr size_t WS_CTL = 0, CTL_ZERO_BYTES = 1 * MiB;
constexpr size_t WS_WIN = 2 * MiB;
constexpr size_t WS_WAB = 12 * MiB;
constexpr size_t WS_WOUT = 16 * MiB;
constexpr size_t WS_WPOOL = 18 * MiB;
constexpr size_t WS_W1 = 20 * MiB;
constexpr size_t WS_W2 = 148 * MiB;
constexpr size_t WS_H = 212 * MiB;
constexpr size_t WS_Q = 244 * MiB, WS_K = 260 * MiB, WS_V = 276 * MiB;
constexpr size_t WS_IQ = 292 * MiB;
constexpr size_t WS_IK = 300 * MiB;
constexpr size_t WS_IW = 302 * MiB;
constexpr size_t WS_U = 303 * MiB;
constexpr size_t WS_DIFF = 319 * MiB;
constexpr size_t WS_GA = 335 * MiB, WS_GB = 367 * MiB;
constexpr size_t WS_MASK = 399 * MiB;
constexpr size_t WS_YAP = 415 * MiB;
constexpr size_t WS_MERGED = 447 * MiB;
constexpr size_t WS_H2 = 479 * MiB;
constexpr size_t WS_TOKE = 511 * MiB;
constexpr size_t WS_ROWW = 512 * MiB;
constexpr size_t WS_XP = 514 * MiB;
constexpr size_t WS_ACT = 658 * MiB;
constexpr size_t WS_END = 802 * MiB;

constexpr int CW_TMO = 0, CW_CODE = 1;
constexpr int CW_CNT = 64;
constexpr int CW_BAR = 4096;

constexpr int RING_OFF = 0, RING_BYTES = 147456;
constexpr int LDSCTL_OFF = RING_BYTES, MISC_OFF = LDSCTL_OFF + 320;
constexpr int XTRA_OFF = LDSCTL_OFF + 1024;
constexpr int LDS_BYTES = 163840;
static_assert(XTRA_OFF + 14336 <= LDS_BYTES, "LDS map");

#define GAS __attribute__((address_space(1)))
#define LAS __attribute__((address_space(3)))
typedef unsigned short bf16;
typedef unsigned v4u __attribute__((ext_vector_type(4)));
typedef unsigned v2u __attribute__((ext_vector_type(2)));
typedef float f32x4 __attribute__((ext_vector_type(4)));
typedef short bf16x8 __attribute__((ext_vector_type(8)));
typedef float f32x16 __attribute__((ext_vector_type(16)));
typedef GAS unsigned gu32;
#define RLX_AGENT __ATOMIC_RELAXED, __HIP_MEMORY_SCOPE_AGENT
#define LDS_WAIT() asm volatile("s_waitcnt lgkmcnt(0)" ::: "memory")
#define VM_WAIT() asm volatile("s_waitcnt vmcnt(0)" ::: "memory")
__device__ __forceinline__ unsigned f2bf(float f) { unsigned u = __builtin_bit_cast(unsigned, f); return (u + 0x7fffu + ((u >> 16) & 1u)) >> 16; }
__device__ __forceinline__ unsigned pk2(float lo, float hi) { return f2bf(lo) | (f2bf(hi) << 16); }
__device__ __forceinline__ float bflo(unsigned w) { return __uint_as_float(w << 16); }
__device__ __forceinline__ float bfhi(unsigned w) { return __uint_as_float(w & 0xffff0000u); }
namespace pg8 {
#define PG8_LAS __attribute__((address_space(3)))
typedef unsigned short bf16_t;
typedef short bf16x8 __attribute__((ext_vector_type(8)));
typedef float f32x4 __attribute__((ext_vector_type(4)));
typedef unsigned u32x4 __attribute__((ext_vector_type(4)));
constexpr int BM = 256, BK = 64, HALF = 128, HTB = HALF * BK * 2  , STAGE_BYTES = 8 * HTB, NXCD = 8, WGM = 8;

__host__ __device__ __forceinline__ int lds_byte(int r, int c) { const int st = (r >> 4) * 2 + (c >> 5), rr = r & 15, cc = c & 31, ob = rr * 64 + cc * 2; return st * 1024 + (ob ^ (((ob >> 9) & 1) << 5)); }
__host__ __device__ __forceinline__ void stage_rc(int b, int& R, int& C) { const int st = b / 1024, sb = b % 1024, swz = sb ^ (((sb >> 9) & 1) << 5); R = (st >> 1) * 16 + swz / 64; C = (st & 1) * 32 + (swz % 64) / 2; }
__host__ __device__ __forceinline__ int perm32(int rho) { const int n = rho >> 4, i = rho & 15; return 8 * (i >> 2) + 4 * n + (i & 3); }

struct Unit { int pm, pn; };
struct Gemm { const bf16_t* A; const bf16_t* Bt; int M, N, K; };

struct StaticOrder {
    int nM, nN, nwg, G, c;
    __host__ __device__ void init(int M, int N, int G_, int c_) { nM = M / BM; nN = N / BM; nwg = nM * nN; G = G_; c = c_; }
    __host__ __device__ bool next(int i, Unit& u) const {
        const long L = (long)i * G + c; if (L >= nwg) return false;
        int wgid = (int)L; { const int q = nwg / NXCD, r = nwg % NXCD, xcd = wgid % NXCD, off = wgid / NXCD; wgid = (xcd < r ? xcd * (q + 1) : r * (q + 1) + (xcd - r) * q) + off; }
        const int nig = WGM * nN, gid = wgid / nig, fm = gid * WGM, gsz = (nM - fm) < WGM ? (nM - fm) : WGM;
        u.pm = fm + ((wgid % nig) % gsz); u.pn = (wgid % nig) / gsz; return true;
    }
    __device__ __forceinline__ void a_ready(const Unit&) const {}
    __device__ __forceinline__ void done(const Unit&) const {}
};
__device__ __forceinline__ unsigned cvt_pk_bf16(float lo, float hi) { unsigned r; asm volatile("v_cvt_pk_bf16_f32 %0, %1, %2" : "=v"(r) : "v"(lo), "v"(hi)); return r; }
typedef float f32x2 __attribute__((ext_vector_type(2)));
typedef unsigned u32x2 __attribute__((ext_vector_type(2)));
__device__ __forceinline__ float sigmoidf_fast(float x) { return __builtin_amdgcn_rcpf(1.0f + __builtin_amdgcn_exp2f(-1.4426950408889634f * x)); }
__device__ __forceinline__ float bf_lo(unsigned w) { return __uint_as_float(w << 16); }
__device__ __forceinline__ float bf_hi(unsigned w) { return __uint_as_float(w & 0xffff0000u); }

struct EpiInProj {
    static constexpr bool PERM = true, AFTER_DRAIN = false;
    unsigned char* ws;
    static constexpr unsigned oq = (unsigned)WS_Q, ok = (unsigned)WS_K, ov = (unsigned)WS_V, oiq = (unsigned)WS_IQ, oik = (unsigned)WS_IK, ou = (unsigned)WS_U, oga = (unsigned)WS_GA, ogb = (unsigned)WS_GB, oiw = (unsigned)WS_IW;
    __device__ __forceinline__ void operator()(const f32x4 (&acc)[2][2][4][2], const Unit& un, int wr, int wc, int fr, int fq) const {
        const int pn = un.pn, row0 = un.pm * BM + wr * 64 + fr;
        if (pn == 7) {
#pragma unroll
            for (int ai = 0; ai < 2; ++ai)
#pragma unroll
                for (int m = 0; m < 4; ++m) { const size_t row = (size_t)(row0 + ai * HALF + m * 16);
                    const f32x4 v0 = acc[ai][0][m][0], v1 = acc[ai][0][m][1];
                    if (wc < 2) { u32x4 w; w.x = cvt_pk_bf16(v0[0], v0[1]); w.y = cvt_pk_bf16(v0[2], v0[3]); w.z = cvt_pk_bf16(v1[0], v1[1]); w.w = cvt_pk_bf16(v1[2], v1[3]);
                        *(u32x4*)((bf16_t*)(ws + oik) + row * 64 + wc * 32 + 8 * fq) = w; }
                    else if (wc == 2 && fq == 0) { *(f32x4*)((float*)(ws + oiw) + row * 4) = v0; } }
            return;
        }
        unsigned boff; int ldc, colt; bool sig = false;
        if (pn < 6) { boff = pn < 2 ? oq : (pn < 4 ? ok : ov); ldc = 512; colt = (pn & 1) * 256; }
        else if (pn == 6) { boff = oiq; ldc = 256; colt = 0; }
        else if (pn < 10) { boff = ou; ldc = 512; colt = (pn - 8) * 256; }
        else { sig = true; boff = pn < 14 ? oga : ogb; ldc = 1024; colt = ((pn - 10) & 3) * 256; }
        bf16_t* base = (bf16_t*)(ws + boff);
        const int col0 = colt + wc * 32 + 8 * fq;
#pragma unroll
        for (int ai = 0; ai < 2; ++ai)
#pragma unroll
            for (int m = 0; m < 4; ++m) { bf16_t* rowp = base + (size_t)(row0 + ai * HALF + m * 16) * ldc + col0;
#pragma unroll
                for (int bj = 0; bj < 2; ++bj) { f32x4 v0 = acc[ai][bj][m][0], v1 = acc[ai][bj][m][1];
                    if (sig) {
#pragma unroll
                        for (int j = 0; j < 4; ++j) { v0[j] = sigmoidf_fast(v0[j]); v1[j] = sigmoidf_fast(v1[j]); } }
                    u32x4 w; w.x = cvt_pk_bf16(v0[0], v0[1]); w.y = cvt_pk_bf16(v0[2], v0[3]); w.z = cvt_pk_bf16(v1[0], v1[1]); w.w = cvt_pk_bf16(v1[2], v1[3]);
                    *(u32x4*)(rowp + bj * HALF) = w; } }
    }
};
struct EpiPool {
    static constexpr bool PERM = true, AFTER_DRAIN = false;
    bf16_t* yap; const float* pb; const float* ps;
    __device__ __forceinline__ void operator()(const f32x4 (&acc)[2][2][4][2], const Unit& un, int wr, int wc, int fr, int fq) const {
        const int row0 = un.pm * BM + wr * 64 + fr, col0 = un.pn * BM + wc * 32 + 8 * fq;
        f32x4 bv[2][2], sv[2][2];
#pragma unroll
        for (int bj = 0; bj < 2; ++bj)
#pragma unroll
            for (int n = 0; n < 2; ++n) { bv[bj][n] = *(const f32x4*)(pb + col0 + bj * HALF + 4 * n); sv[bj][n] = *(const f32x4*)(ps + col0 + bj * HALF + 4 * n); }
#pragma unroll
        for (int ai = 0; ai < 2; ++ai)
#pragma unroll
            for (int m = 0; m < 4; ++m) { bf16_t* rowp = yap + (size_t)(row0 + ai * HALF + m * 16) * 1024 + 512 + col0;
#pragma unroll
                for (int bj = 0; bj < 2; ++bj) { const f32x4 v0 = (acc[ai][bj][m][0] + bv[bj][0]) * sv[bj][0], v1 = (acc[ai][bj][m][1] + bv[bj][1]) * sv[bj][1];
                    u32x4 w; w.x = cvt_pk_bf16(v0[0], v0[1]); w.y = cvt_pk_bf16(v0[2], v0[3]); w.z = cvt_pk_bf16(v1[0], v1[1]); w.w = cvt_pk_bf16(v1[2], v1[3]);
                    *(u32x4*)(rowp + bj * HALF) = w; } }
    }
};
struct EpiMerge {
    static constexpr bool PERM = true, AFTER_DRAIN = false;
    const bf16_t *gA, *gB; bf16_t* merged;
    __device__ __forceinline__ void operator()(const f32x4 (&acc)[2][2][4][2], const Unit& un, int wr, int wc, int fr, int fq) const {
        const int row0 = un.pm * BM + wr * 64 + fr, col0 = un.pn * HALF + wc * 32 + 8 * fq;
#pragma unroll
        for (int ai = 0; ai < 2; ++ai)
#pragma unroll
            for (int m = 0; m < 4; ++m) { const size_t off = (size_t)(row0 + ai * HALF + m * 16) * 1024 + col0;
                const u32x4 a = *(const u32x4*)(gA + off), b = *(const u32x4*)(gB + off);
                const f32x4 p0 = acc[ai][0][m][0], p1 = acc[ai][0][m][1], r0 = acc[ai][1][m][0], r1 = acc[ai][1][m][1];
                u32x4 w;
                w.x = cvt_pk_bf16(bf_lo(a.x) * p0[0] + bf_lo(b.x) * r0[0], bf_hi(a.x) * p0[1] + bf_hi(b.x) * r0[1]);
                w.y = cvt_pk_bf16(bf_lo(a.y) * p0[2] + bf_lo(b.y) * r0[2], bf_hi(a.y) * p0[3] + bf_hi(b.y) * r0[3]);
                w.z = cvt_pk_bf16(bf_lo(a.z) * p1[0] + bf_lo(b.z) * r1[0], bf_hi(a.z) * p1[1] + bf_hi(b.z) * r1[1]);
                w.w = cvt_pk_bf16(bf_lo(a.w) * p1[2] + bf_lo(b.w) * r1[2], bf_hi(a.w) * p1[3] + bf_hi(b.w) * r1[3]);
                *(u32x4*)(merged + off) = w; }
    }
};
struct EpiResF32 {
    static constexpr bool PERM = false, AFTER_DRAIN = false;
    const float* base; float* C;
    __device__ __forceinline__ void operator()(const f32x4 (&acc)[2][2][4][2], const Unit& un, int wr, int wc, int fr, int fq) const {
        const int row0 = un.pm * BM + wr * 64 + fr, col0 = un.pn * BM + wc * 32 + 4 * fq;
#pragma unroll
        for (int ai = 0; ai < 2; ++ai)
#pragma unroll
            for (int m = 0; m < 4; ++m) { const size_t off = (size_t)(row0 + ai * HALF + m * 16) * 1024 + col0;
#pragma unroll
                for (int bj = 0; bj < 2; ++bj)
#pragma unroll
                    for (int n = 0; n < 2; ++n) *(f32x4*)(C + off + bj * HALF + n * 16) = *(const f32x4*)(base + off + bj * HALF + n * 16) + acc[ai][bj][m][n]; }
    }
};
struct EpiSwiglu {
    static constexpr bool PERM = true, AFTER_DRAIN = false;
    const float* b1; bf16_t* act;
    __device__ __forceinline__ void operator()(const f32x4 (&acc)[2][2][4][2], const Unit& un, int wr, int wc, int fr, int fq) const {
        const int e = un.pn >> 3, n8 = un.pn & 7, row0 = un.pm * BM + wr * 64 + fr, col0 = n8 * HALF + wc * 32 + 8 * fq;
        const float* bp = b1 + (size_t)e * 2048 + col0;
        const f32x4 bg0 = *(const f32x4*)(bp), bg1 = *(const f32x4*)(bp + 4), bl0 = *(const f32x4*)(bp + 1024), bl1 = *(const f32x4*)(bp + 1028);
#pragma unroll
        for (int ai = 0; ai < 2; ++ai)
#pragma unroll
            for (int m = 0; m < 4; ++m) {
                f32x4 g0 = acc[ai][0][m][0] + bg0, g1 = acc[ai][0][m][1] + bg1, l0 = acc[ai][1][m][0] + bl0, l1 = acc[ai][1][m][1] + bl1, o0, o1;
#pragma unroll
                for (int j = 0; j < 4; ++j) {
                    const float ga = fminf(g0[j], 7.0f), gb = fminf(g1[j], 7.0f);
                    const float la = fminf(fmaxf(l0[j], -7.0f), 7.0f), lb = fminf(fmaxf(l1[j], -7.0f), 7.0f);
                    o0[j] = (la + 1.0f) * ga * sigmoidf_fast(1.702f * ga); o1[j] = (lb + 1.0f) * gb * sigmoidf_fast(1.702f * gb); }
                u32x4 w; w.x = cvt_pk_bf16(o0[0], o0[1]); w.y = cvt_pk_bf16(o0[2], o0[3]); w.z = cvt_pk_bf16(o1[0], o1[1]); w.w = cvt_pk_bf16(o1[2], o1[3]);
                *(u32x4*)(act + (size_t)(row0 + ai * HALF + m * 16) * 1024 + col0) = w; }
    }
};
struct EpiDown {
    static constexpr bool PERM = true, AFTER_DRAIN = false;
    const float* b2; const float* roww; bf16_t* Y;
    __device__ __forceinline__ void operator()(const f32x4 (&acc)[2][2][4][2], const Unit& un, int wr, int wc, int fr, int fq) const {
        const int e = un.pn >> 2, n4 = un.pn & 3, row0 = un.pm * BM + wr * 64 + fr, col0 = n4 * BM + wc * 32 + 8 * fq;
        const float* bp = b2 + (size_t)e * 1024 + col0;
        f32x4 bv[2][2];
#pragma unroll
        for (int bj = 0; bj < 2; ++bj)
#pragma unroll
            for (int n = 0; n < 2; ++n) bv[bj][n] = *(const f32x4*)(bp + bj * HALF + 4 * n);
#pragma unroll
        for (int ai = 0; ai < 2; ++ai)
#pragma unroll
            for (int m = 0; m < 4; ++m) { const int row = row0 + ai * HALF + m * 16; const float rw = roww[row];
#pragma unroll
                for (int bj = 0; bj < 2; ++bj) { const f32x4 v0 = (acc[ai][bj][m][0] + bv[bj][0]) * rw, v1 = (acc[ai][bj][m][1] + bv[bj][1]) * rw;
                    u32x4 w; w.x = cvt_pk_bf16(v0[0], v0[1]); w.y = cvt_pk_bf16(v0[2], v0[3]); w.z = cvt_pk_bf16(v1[0], v1[1]); w.w = cvt_pk_bf16(v1[2], v1[3]);
                    *(u32x4*)(Y + (size_t)row * 1024 + col0 + bj * HALF) = w; } }
    }
};
struct ListOrder {
    const PG8_LAS unsigned* list;
    __device__ __forceinline__ bool next(int i, Unit& u) const { const unsigned w = (unsigned)__builtin_amdgcn_readfirstlane((int)list[i]); if (w == 0xffffffffu) return false; u.pm = (int)(w & 0xffffu); u.pn = (int)(w >> 16); return true; }
    __device__ __forceinline__ void a_ready(const Unit&) const {}
    __device__ __forceinline__ void done(const Unit&) const {}
};
template <class Epi, class Sched, bool ALIGN_EPI = false, bool SP2 = false>
__device__ __forceinline__ void gemm_phase(PG8_LAS unsigned char* lds, const Gemm g, const Sched& S, const Epi& E) {
    const int tid = threadIdx.x, wid = __builtin_amdgcn_readfirstlane(tid >> 6), lane = tid & 63, wr = wid >> 2, wc = wid & 3, fr = lane & 15, fq = lane >> 4;
    const int K = g.K, nt = K / BK;
    unsigned voffA[2], voffB[2];
#pragma unroll
    for (int i = 0; i < 2; ++i) { int R, C; stage_rc(tid * 16 + i * 8192, R, C); const int Rb = Epi::PERM ? ((R & ~31) + perm32(R & 31)) : R;
        voffA[i] = (unsigned)(R * K + C) * 2u; voffB[i] = (unsigned)(Rb * K + C) * 2u; }
    const size_t kstep = (size_t)(BK * 2);
    const size_t hstep = (size_t)HALF * K * 2;
    const size_t tstep = 2 * hstep;
    const unsigned ldsw = (unsigned)wid * 1024u;
    const int aoff = lds_byte(wr * 64 + fr, fq * 8), boff = lds_byte(wc * 32 + fr, fq * 8);
#define PG8_SA(b, h) (((b) * 2 + (h)) * HTB)
#define PG8_SB(b, h) ((4 + (b) * 2 + (h)) * HTB)
#define PG8_STAGE(bufoff, gbase, voff) do { _Pragma("unroll") for (int _i = 0; _i < 2; ++_i) \
        __builtin_amdgcn_global_load_lds((const unsigned*)((const char*)(gbase) + (voff)[_i]), (PG8_LAS unsigned*)(lds + (bufoff) + ldsw + _i * 8192), 16, 0, 0); } while (0)
#define PG8_LDA(dst, b, h) do { _Pragma("unroll") for (int m = 0; m < 4; ++m) _Pragma("unroll") for (int k = 0; k < 2; ++k) dst[m][k] = *(const PG8_LAS bf16x8*)(lds + PG8_SA(b, h) + aoff + m * 2048 + k * 1024); } while (0)
#define PG8_LDB(dst, b, h) do { _Pragma("unroll") for (int n = 0; n < 2; ++n) _Pragma("unroll") for (int k = 0; k < 2; ++k) dst[n][k] = *(const PG8_LAS bf16x8*)(lds + PG8_SB(b, h) + boff + n * 2048 + k * 1024); } while (0)
#define PG8_MMA(ai, bj, At, Bt) do { __builtin_amdgcn_s_setprio(1); _Pragma("unroll") for (int m = 0; m < 4; ++m) _Pragma("unroll") for (int n = 0; n < 2; ++n) _Pragma("unroll") for (int k = 0; k < 2; ++k) \
        acc[ai][bj][m][n] = __builtin_amdgcn_mfma_f32_16x16x32_bf16(Bt[n][k], At[m][k], acc[ai][bj][m][n], 0, 0, 0); __builtin_amdgcn_s_setprio(0); } while (0)
#define PG8_WAIT_V(n) asm volatile("s_waitcnt vmcnt(" #n ")" ::: "memory")
#define PG8_WAIT_L(n) asm volatile("s_waitcnt lgkmcnt(" #n ")" ::: "memory")
#define PG8_BAR __builtin_amdgcn_s_barrier()
#define PG8_SCHED __builtin_amdgcn_sched_barrier(0)
    Unit cur, nxt; int ui = 0;
    if (!S.next(0, cur)) return;
    f32x4 acc[2][2][4][2];
#pragma unroll
    for (int a = 0; a < 2; ++a)
#pragma unroll
        for (int b = 0; b < 2; ++b)
#pragma unroll
            for (int m = 0; m < 4; ++m)
#pragma unroll
                for (int n = 0; n < 2; ++n) acc[a][b][m][n] = (f32x4){0.f, 0.f, 0.f, 0.f};
    bf16x8 At[4][2], B0[2][2], B1[2][2];
    const char* cA = (const char*)g.A + (size_t)cur.pm * tstep; const char* cB = (const char*)g.Bt + (size_t)cur.pn * tstep;
    S.a_ready(cur);
    if constexpr (SP2) {
        PG8_STAGE(PG8_SB(0, 0), cB, voffB); PG8_STAGE(PG8_SB(0, 1), cB + hstep, voffB); PG8_STAGE(PG8_SA(0, 0), cA, voffA); PG8_STAGE(PG8_SA(0, 1), cA + hstep, voffA);
        if (wr == 1) PG8_BAR;
        PG8_WAIT_V(2); PG8_BAR;
        PG8_STAGE(PG8_SB(1, 0), cB + kstep, voffB); PG8_STAGE(PG8_SA(1, 0), cA + kstep, voffA); PG8_STAGE(PG8_SB(1, 1), cB + hstep + kstep, voffB);
        PG8_WAIT_V(6); PG8_BAR;
    } else {
        PG8_STAGE(PG8_SB(0, 0), cB, voffB); PG8_STAGE(PG8_SA(0, 0), cA, voffA); PG8_STAGE(PG8_SB(0, 1), cB + hstep, voffB); PG8_STAGE(PG8_SA(0, 1), cA + hstep, voffA);
        if (wr == 1) PG8_BAR;
        PG8_WAIT_V(4); PG8_BAR;
        PG8_STAGE(PG8_SB(1, 0), cB + kstep, voffB); PG8_STAGE(PG8_SA(1, 0), cA + kstep, voffA); PG8_STAGE(PG8_SB(1, 1), cB + hstep + kstep, voffB);
        PG8_WAIT_V(6); PG8_BAR;
    }
    for (;;) {
        const bool has_next = S.next(ui + 1, nxt);
        const char* nA = has_next ? (const char*)g.A + (size_t)nxt.pm * tstep : cA; const char* nB = has_next ? (const char*)g.Bt + (size_t)nxt.pn * tstep : cB;
        for (int t = 0; t < nt; t += 2) {
            const bool last = (t == nt - 2);
            const char* a1 = cA + (size_t)(t + 1) * kstep;
            const char* a2 = last ? nA : cA + (size_t)(t + 2) * kstep; const char* b2 = last ? nB : cB + (size_t)(t + 2) * kstep;
            const char* a3 = a2 + kstep; const char* b3 = b2 + kstep;
            if (last && has_next) S.a_ready(nxt);
            if constexpr (SP2) {
            PG8_LDB(B0, 0, 0); PG8_LDB(B1, 0, 1); PG8_SCHED; PG8_LDA(At, 0, 0); PG8_STAGE(PG8_SA(1, 1), a1 + hstep, voffA);
            PG8_WAIT_V(8); PG8_WAIT_L(0); PG8_BAR; PG8_MMA(0, 0, At, B0); PG8_MMA(0, 1, At, B1); PG8_BAR; PG8_SCHED;
            PG8_LDA(At, 0, 1); PG8_STAGE(PG8_SB(0, 0), b2, voffB); PG8_STAGE(PG8_SB(0, 1), b2 + hstep, voffB); PG8_STAGE(PG8_SA(0, 0), a2, voffA);
            PG8_WAIT_V(8); PG8_WAIT_L(0); PG8_BAR; PG8_MMA(1, 0, At, B0); PG8_MMA(1, 1, At, B1); PG8_BAR; PG8_SCHED;
            PG8_LDB(B0, 1, 0); PG8_LDB(B1, 1, 1); PG8_SCHED; PG8_LDA(At, 1, 0); PG8_STAGE(PG8_SA(0, 1), a2 + hstep, voffA);
            PG8_WAIT_V(8); PG8_WAIT_L(0); PG8_BAR; PG8_MMA(0, 0, At, B0); PG8_MMA(0, 1, At, B1); PG8_BAR; PG8_SCHED;
            PG8_LDA(At, 1, 1); PG8_STAGE(PG8_SB(1, 0), b3, voffB); PG8_STAGE(PG8_SB(1, 1), b3 + hstep, voffB); PG8_STAGE(PG8_SA(1, 0), a3, voffA);
            PG8_WAIT_V(8); PG8_WAIT_L(0); PG8_BAR; PG8_MMA(1, 0, At, B0); PG8_MMA(1, 1, At, B1); PG8_BAR; PG8_SCHED;
            } else {
            PG8_LDB(B0, 0, 0); PG8_SCHED; PG8_LDA(At, 0, 0); PG8_STAGE(PG8_SA(1, 1), a1 + hstep, voffA);
            PG8_WAIT_L(8); PG8_BAR; PG8_WAIT_L(0); PG8_MMA(0, 0, At, B0); PG8_BAR; PG8_SCHED;
            PG8_LDB(B1, 0, 1); PG8_STAGE(PG8_SB(0, 0), b2, voffB);
            PG8_BAR; PG8_WAIT_L(0); PG8_MMA(0, 1, At, B1); PG8_BAR;
            PG8_LDA(At, 0, 1); PG8_STAGE(PG8_SA(0, 0), a2, voffA);
            PG8_BAR; PG8_WAIT_L(0); PG8_MMA(1, 0, At, B0); PG8_BAR; PG8_SCHED;
            PG8_STAGE(PG8_SB(0, 1), b2 + hstep, voffB);
            PG8_WAIT_V(6); PG8_BAR; PG8_MMA(1, 1, At, B1); PG8_BAR;
            PG8_LDB(B0, 1, 0); PG8_SCHED; PG8_LDA(At, 1, 0); PG8_STAGE(PG8_SA(0, 1), a2 + hstep, voffA);
            PG8_WAIT_L(8); PG8_BAR; PG8_WAIT_L(0); PG8_MMA(0, 0, At, B0); PG8_BAR; PG8_SCHED;
            PG8_LDB(B1, 1, 1); PG8_STAGE(PG8_SB(1, 0), b3, voffB);
            PG8_BAR; PG8_WAIT_L(0); PG8_MMA(0, 1, At, B1); PG8_BAR;
            PG8_LDA(At, 1, 1); PG8_STAGE(PG8_SA(1, 0), a3, voffA);
            PG8_BAR; PG8_WAIT_L(0); PG8_MMA(1, 0, At, B0); PG8_BAR; PG8_SCHED;
            PG8_STAGE(PG8_SB(1, 1), b3 + hstep, voffB);
            PG8_WAIT_V(6); PG8_BAR; PG8_MMA(1, 1, At, B1); PG8_BAR;
            }
        }
        if constexpr (ALIGN_EPI) { if (wr == 0) PG8_BAR; }
        if constexpr (!Epi::AFTER_DRAIN) { E(acc, cur, wr, wc, fr, fq); S.done(cur); }
        if (!has_next) break;
#pragma unroll
        for (int a = 0; a < 2; ++a)
#pragma unroll
            for (int b = 0; b < 2; ++b)
#pragma unroll
                for (int m = 0; m < 4; ++m)
#pragma unroll
                    for (int n = 0; n < 2; ++n) acc[a][b][m][n] = (f32x4){0.f, 0.f, 0.f, 0.f};
        cur = nxt; cA = nA; cB = nB; ++ui;
        if constexpr (ALIGN_EPI) { if (wr == 1) PG8_BAR; }
    }
    PG8_WAIT_V(0);
    if constexpr (!ALIGN_EPI) { if (wr == 0) PG8_BAR; }
    PG8_BAR;
    if constexpr (Epi::AFTER_DRAIN) { E.fused(acc, cur, wr, wc, fr, fq, lds, wid, lane); S.done(cur); }
#undef PG8_SA
#undef PG8_SB
#undef PG8_STAGE
#undef PG8_LDA
#undef PG8_LDB
#undef PG8_MMA
#undef PG8_WAIT_V
#undef PG8_WAIT_L
#undef PG8_BAR
#undef PG8_SCHED
}
}
namespace attn_body {
using bf16=__hip_bfloat16;
using bf16x8=__attribute__((ext_vector_type(8)))short;
using s16x4=__attribute__((ext_vector_type(4)))short;
using f32x16=__attribute__((ext_vector_type(16)))float;
using u32x4=__attribute__((ext_vector_type(4)))unsigned;
constexpr int BATCH=2,NHEAD=8,SEQ=8192,D=64,DM=NHEAD*D,OPITCH=1024;
constexpr int NW=8,QBLK=32,QB=QBLK*NW,KVBLK=64,NQB=SEQ/QB;
__device__ __forceinline__ int crow(int r,int hi){return (r&3)+8*(r>>2)+4*hi;}
#define SBAR() __builtin_amdgcn_sched_barrier(0)
constexpr int NSLOT=3, SLOTB=8192;
constexpr int LDS_K=0, LDS_V=NSLOT*SLOTB, LDS_WS=2*NSLOT*SLOTB, LDS_OST=LDS_WS+NW*64*4, LDS_BYTES=LDS_OST+NW*4096;
constexpr float C2=0.125f*1.4426950408889634f;
__device__ __forceinline__ void glds16(const void*gsrc,unsigned lds_dst){unsigned keep;
  asm volatile("s_mov_b32 %0, m0\n\ts_mov_b32 m0, %2\n\ts_nop 0\n\tglobal_load_lds_dwordx4 %1, off\n\ts_mov_b32 m0, %0":"=&s"(keep):"v"(gsrc),"s"(lds_dst):"memory");}
__device__ __forceinline__ unsigned long long gld8(const unsigned long long*sbase,unsigned voff){unsigned long long r; asm volatile("global_load_dwordx2 %0, %1, %2":"=&v"(r):"v"(voff),"s"(sbase):"memory"); return r;}
typedef float f32x2_t __attribute__((ext_vector_type(2))); typedef __bf16 bf16x2_t __attribute__((ext_vector_type(2)));
__device__ __forceinline__ unsigned cvtpk_s(float lo,float hi){f32x2_t v={lo,hi};bf16x2_t b=__builtin_convertvector(v,bf16x2_t);return __builtin_bit_cast(unsigned,b);}

__device__ __forceinline__ void qkt(f32x16&p0,f32x16&p1,const char*Kslot,const bf16x8*qr,int r32,int hi){
  const f32x16 negm=f32x16{};
  const char*kb=Kslot+hi*1024+r32*16;
  #pragma unroll
  for(int d0=0;d0<4;++d0){
    const bf16x8 b0=*reinterpret_cast<const bf16x8*>(kb+d0*2048);
    const bf16x8 b1=*reinterpret_cast<const bf16x8*>(kb+d0*2048+512);
    if(d0==0){p0=__builtin_amdgcn_mfma_f32_32x32x16_bf16(b0,qr[0],negm,0,0,0);p1=__builtin_amdgcn_mfma_f32_32x32x16_bf16(b1,qr[0],negm,0,0,0);}
    else{p0=__builtin_amdgcn_mfma_f32_32x32x16_bf16(b0,qr[d0],p0,0,0,0);p1=__builtin_amdgcn_mfma_f32_32x32x16_bf16(b1,qr[d0],p1,0,0,0);}}
}
typedef __attribute__((address_space(3))) const char* lds_cptr;
typedef short v4i16_t __attribute__((ext_vector_type(4)));
__device__ __forceinline__ void kload8(bf16x8*kf,lds_cptr kp){
  kf[0]=*(const __attribute__((address_space(3))) bf16x8*)(kp);      kf[1]=*(const __attribute__((address_space(3))) bf16x8*)(kp+512);
  kf[2]=*(const __attribute__((address_space(3))) bf16x8*)(kp+2048); kf[3]=*(const __attribute__((address_space(3))) bf16x8*)(kp+2560);
  kf[4]=*(const __attribute__((address_space(3))) bf16x8*)(kp+4096); kf[5]=*(const __attribute__((address_space(3))) bf16x8*)(kp+4608);
  kf[6]=*(const __attribute__((address_space(3))) bf16x8*)(kp+6144); kf[7]=*(const __attribute__((address_space(3))) bf16x8*)(kp+6656);
}
__device__ __forceinline__ void kload2(bf16x8*kf,lds_cptr kp,int j){ kf[2*j]=*(const __attribute__((address_space(3))) bf16x8*)(kp+j*2048); kf[2*j+1]=*(const __attribute__((address_space(3))) bf16x8*)(kp+j*2048+512); }
__device__ __forceinline__ s16x4 vtr(lds_cptr p){ return __builtin_bit_cast(s16x4,__builtin_amdgcn_ds_read_tr16_b64_v4i16((__attribute__((address_space(3))) v4i16_t*)p)); }
__device__ __forceinline__ void pv(f32x16*o,int vb,bf16x8 pa0,bf16x8 pa1,bf16x8 pa2,bf16x8 pa3){
  #pragma unroll
  for(int d0=0;d0<2;++d0){s16x4 lo[4],hi[4];
    #pragma unroll
    for(int ks=0;ks<4;++ks){
      asm volatile("ds_read_b64_tr_b16 %0,%1 offset:%c2":"=&v"(lo[ks]):"v"(vb),"i"(d0*4096+ks*1024):"memory");
      asm volatile("ds_read_b64_tr_b16 %0,%1 offset:%c2":"=&v"(hi[ks]):"v"(vb),"i"(d0*4096+ks*1024+512):"memory");}
    asm volatile("s_waitcnt lgkmcnt(0)":::"memory");SBAR();
    #define PK(k) (bf16x8){lo[k][0],lo[k][1],lo[k][2],lo[k][3],hi[k][0],hi[k][1],hi[k][2],hi[k][3]}
    o[d0]=__builtin_amdgcn_mfma_f32_32x32x16_bf16(pa0,PK(0),o[d0],0,0,0);
    o[d0]=__builtin_amdgcn_mfma_f32_32x32x16_bf16(pa1,PK(1),o[d0],0,0,0);
    o[d0]=__builtin_amdgcn_mfma_f32_32x32x16_bf16(pa2,PK(2),o[d0],0,0,0);
    o[d0]=__builtin_amdgcn_mfma_f32_32x32x16_bf16(pa3,PK(3),o[d0],0,0,0);
    #undef PK
  }
}
#define MSK(v,w,r) __uint_as_float(__float_as_uint(v)&(unsigned)__builtin_amdgcn_sbfe((int)(w),((r)&3)+8*((r)>>2),1))

__device__ __forceinline__ void attn_unit(int b,int h,int qb,const bf16*Q,const bf16*__restrict__ K,const bf16*__restrict__ V,bf16*O,const unsigned long long*MK,float cshift,char*shm){
  const int tid=threadIdx.x,lane=tid&63,r32=lane&31,hi=lane>>5; const int wid=__builtin_amdgcn_readfirstlane(tid>>6);
  const long rowbase=(long)b*SEQ; const int q0=qb*QB;
  const bf16*Qw=Q+(rowbase+q0+wid*QBLK)*DM+h*D;
  const bf16*Kh=K+rowbase*DM+h*D,*Vh=V+rowbase*DM+h*D;
  const unsigned lds0=(unsigned)(uintptr_t)shm;
  float*wsf=(float*)(shm+LDS_WS)+wid*64;
  const bf16*ksrc=Kh+(long)lane*DM+wid*8;
  const bf16*vsrc=Vh+(long)(16*(wid&3)+(lane>>2))*DM+(wid>>2)*32+(lane&3)*8;
  const unsigned kdst=lds0+LDS_K+wid*1024, vdst=lds0+LDS_V+wid*1024;
  #define DMA_K(t,slot) glds16(ksrc+(long)(t)*KVBLK*DM,(unsigned)__builtin_amdgcn_readfirstlane(kdst+(slot)))
  #define DMA_V(t,slot) glds16(vsrc+(long)(t)*KVBLK*DM,(unsigned)__builtin_amdgcn_readfirstlane(vdst+(slot)))
  const int vb0=(int)(lds0+LDS_V)+((lane>>4)&1)*32+(lane&3)*8+(4*hi+((lane&15)>>2))*64;
  const char*Kbase=shm+LDS_K; bf16x8 kf[8];
  const lds_cptr shm3=(lds_cptr)shm; const lds_cptr kp0=shm3+LDS_K+hi*1024+r32*16; const lds_cptr vp0=shm3+LDS_V+((lane>>4)&1)*32+(lane&3)*8+(4*hi+((lane&15)>>2))*64;
  const int NT=(q0+QB)/KVBLK;
  const unsigned long long*mbase=MK+(size_t)b*(SEQ/KVBLK)*SEQ; const unsigned moff=(unsigned)(q0+wid*QBLK+r32)*8u;
  DMA_K(0,0);DMA_V(0,0);DMA_K(1,SLOTB);
  bf16x8 qr[4];
  #pragma unroll
  for(int d0=0;d0<4;++d0)qr[d0]=*reinterpret_cast<const bf16x8*>(&Qw[(long)r32*DM+d0*16+hi*8]);
  unsigned long long mC=gld8(mbase,moff), mN=gld8(mbase+SEQ,moff);
  float l_reg=0.f;f32x16 o[2];o[0]=f32x16{};o[1]=f32x16{};const f32x16 negm=f32x16{};
  (void)cshift;
  #define WAIT_BAR(N) asm volatile("s_waitcnt vmcnt(" #N ") lgkmcnt(0)\n\ts_barrier":"+v"(mN),"+v"(mC)::"memory")
  f32x16 pA0,pA1,pB0,pB1;
  int sl_prev=0,sl_cur=0,sl_next=SLOTB;
  #define ROT() do{sl_prev=sl_cur;sl_cur=sl_next;sl_next=(sl_next==(NSLOT-1)*SLOTB)?0:sl_next+SLOTB;}while(0)
  DMA_K(2,2*SLOTB);
  WAIT_BAR(3);
  qkt(pA0,pA1,Kbase,qr,r32,hi);asm volatile("s_nop 15\n\ts_nop 7":"+v"(pA0),"+v"(pA1));
  _Pragma("unroll") for(int r=0;r<16;++r){pA0[r]=__builtin_amdgcn_exp2f(pA0[r]);pA1[r]=__builtin_amdgcn_exp2f(pA1[r]);}
  WAIT_BAR(0);
  { const unsigned ma_=(unsigned)mC>>(4*hi), mb_=(unsigned)(mC>>32)>>(4*hi);
    _Pragma("unroll") for(int r=0;r<16;++r){pA0[r]=MSK(pA0[r],ma_,r);pA1[r]=MSK(pA1[r],mb_,r);} }
  DMA_K(3,0);DMA_V(1,SLOTB);
  ROT();
  kload8(kf,kp0+sl_cur);
  WAIT_BAR(2);
  s16x4 vlo[8],vhi[8]; u32x4 pw0,pw1,pw2,pw3;
  #define PKW(P,B) cvtpk_s(P[B],P[B+1])
  #define PAF(k) __builtin_bit_cast(bf16x8,pw##k)
  #define VFR(i) (bf16x8){vlo[i][0],vlo[i][1],vlo[i][2],vlo[i][3],vhi[i][0],vhi[i][1],vhi[i][2],vhi[i][3]}
  #define PIN(x) asm volatile("":"+v"(x))
  #define GAPA(MF,A0,A1,A2,A3,W0,W1,PW) do{ MF; sacc+=A0; sacc+=A1; sacc+=A2; sacc+=A3; PIN(sacc); W0; W1; PIN(PW); SBAR(); }while(0)
  #define EX(v) __builtin_amdgcn_exp2f(v)
  #define GAPB(MF,X,B,W) do{ MF; X[B]=MSK(EX(X[B]),W,B); X[B+1]=MSK(EX(X[B+1]),W,B+1); X[B+2]=MSK(EX(X[B+2]),W,B+2); X[B+3]=MSK(EX(X[B+3]),W,B+3); PIN(X); SBAR(); }while(0)
  #define VRD(i) do{ vlo[i]=vtr(vp_+(((i)>>2)*4096+((i)&3)*1024)); vhi[i]=vtr(vp_+(((i)>>2)*4096+((i)&3)*1024+512)); }while(0)
  #define KRD(G,j) do{ if(G){ kload2(kf,kp0+sl_next,j); SBAR(); } }while(0)
  #define STEP(C0,C1,P0,P1,t,GK,GV,GL) do{ SBAR(); \
    const unsigned ma_=(unsigned)mN>>(4*hi), mb_=(unsigned)(mN>>32)>>(4*hi); \
    if((t)+1<NT){ mN=gld8(mbase+(size_t)((t)+1)*SEQ,moff); } \
    const lds_cptr vp_=vp0+sl_prev; \
    VRD(0); SBAR(); float sacc=(P0[0]+P0[1]); \
    GAPA(C0=__builtin_amdgcn_mfma_f32_32x32x16_bf16(kf[0],qr[0],negm,0,0,0), P0[2],P0[3],P0[4],P0[5],     pw0[0]=PKW(P0,0), pw0[1]=PKW(P0,2), pw0); \
    VRD(4); SBAR(); GAPA(C1=__builtin_amdgcn_mfma_f32_32x32x16_bf16(kf[1],qr[0],negm,0,0,0), P0[6],P0[7],P0[8],P0[9],     pw0[2]=PKW(P0,4), pw0[3]=PKW(P0,6), pw0); \
    VRD(1); SBAR(); GAPA(C0=__builtin_amdgcn_mfma_f32_32x32x16_bf16(kf[2],qr[1],C0,0,0,0),   P0[10],P0[11],P0[12],P0[13], pw1[0]=PKW(P0,8), pw1[1]=PKW(P0,10), pw1); \
    VRD(5); SBAR(); GAPA(C1=__builtin_amdgcn_mfma_f32_32x32x16_bf16(kf[3],qr[1],C1,0,0,0),   P0[14],P0[15],P1[0],P1[1],   pw1[2]=PKW(P0,12),pw1[3]=PKW(P0,14), pw1); \
    VRD(2); SBAR(); GAPA(C0=__builtin_amdgcn_mfma_f32_32x32x16_bf16(kf[4],qr[2],C0,0,0,0),   P1[2],P1[3],P1[4],P1[5],     pw2[0]=PKW(P1,0), pw2[1]=PKW(P1,2), pw2); \
    VRD(6); SBAR(); GAPA(C1=__builtin_amdgcn_mfma_f32_32x32x16_bf16(kf[5],qr[2],C1,0,0,0),   P1[6],P1[7],P1[8],P1[9],     pw2[2]=PKW(P1,4), pw2[3]=PKW(P1,6), pw2); \
    VRD(3); SBAR(); GAPA(C0=__builtin_amdgcn_mfma_f32_32x32x16_bf16(kf[6],qr[3],C0,0,0,0),   P1[10],P1[11],P1[12],P1[13], pw3[0]=PKW(P1,8), pw3[1]=PKW(P1,10), pw3); \
    VRD(7); SBAR(); GAPA(C1=__builtin_amdgcn_mfma_f32_32x32x16_bf16(kf[7],qr[3],C1,0,0,0),   P1[14],P1[15],0.f,0.f,       pw3[2]=PKW(P1,12),pw3[3]=PKW(P1,14), pw3); \
    l_reg+=sacc; \
    if(GK){DMA_K((t)+3,sl_cur);} if(GV){DMA_V((t)+1,sl_next);} \
    SBAR(); \
    GAPB(o[0]=__builtin_amdgcn_mfma_f32_32x32x16_bf16(PAF(0),VFR(0),o[0],0,0,0), C0,0,ma_); \
    GAPB(o[1]=__builtin_amdgcn_mfma_f32_32x32x16_bf16(PAF(0),VFR(4),o[1],0,0,0), C0,4,ma_); \
    KRD(GL,0); GAPB(o[0]=__builtin_amdgcn_mfma_f32_32x32x16_bf16(PAF(1),VFR(1),o[0],0,0,0), C0,8,ma_); \
    KRD(GL,1); GAPB(o[1]=__builtin_amdgcn_mfma_f32_32x32x16_bf16(PAF(1),VFR(5),o[1],0,0,0), C0,12,ma_); \
    KRD(GL,2); GAPB(o[0]=__builtin_amdgcn_mfma_f32_32x32x16_bf16(PAF(2),VFR(2),o[0],0,0,0), C1,0,mb_); \
    KRD(GL,3); GAPB(o[1]=__builtin_amdgcn_mfma_f32_32x32x16_bf16(PAF(2),VFR(6),o[1],0,0,0), C1,4,mb_); \
    GAPB(o[0]=__builtin_amdgcn_mfma_f32_32x32x16_bf16(PAF(3),VFR(3),o[0],0,0,0), C1,8,mb_); \
    GAPB(o[1]=__builtin_amdgcn_mfma_f32_32x32x16_bf16(PAF(3),VFR(7),o[1],0,0,0), C1,12,mb_); \
    }while(0)
  int t=1;
  for(;t+5<NT;t+=2){
    STEP(pB0,pB1,pA0,pA1,t,true,true,true);     WAIT_BAR(2); ROT();
    STEP(pA0,pA1,pB0,pB1,t+1,true,true,true);   WAIT_BAR(2); ROT();
  }
  #define ENDW(tt) do{ if((tt)+3<NT){WAIT_BAR(2);} else if((tt)+2<NT){WAIT_BAR(1);} else {WAIT_BAR(0);} }while(0)
  for(;t+1<NT;t+=2){
    STEP(pB0,pB1,pA0,pA1,t,(t+3<NT),(t+1<NT),(t+1<NT));       ENDW(t);   ROT();
    STEP(pA0,pA1,pB0,pB1,t+1,(t+4<NT),(t+2<NT),(t+2<NT));     ENDW(t+1); ROT();
  }
  STEP(pB0,pB1,pA0,pA1,NT-1,false,false,false);
  { float sacc=pB0[0]+pB0[1]; _Pragma("unroll") for(int r=2;r<16;++r)sacc+=pB0[r]; _Pragma("unroll") for(int r=0;r<16;++r)sacc+=pB1[r]; l_reg+=sacc;
    pw0=(u32x4){PKW(pB0,0),PKW(pB0,2),PKW(pB0,4),PKW(pB0,6)};pw1=(u32x4){PKW(pB0,8),PKW(pB0,10),PKW(pB0,12),PKW(pB0,14)};pw2=(u32x4){PKW(pB1,0),PKW(pB1,2),PKW(pB1,4),PKW(pB1,6)};pw3=(u32x4){PKW(pB1,8),PKW(pB1,10),PKW(pB1,12),PKW(pB1,14)};
    SBAR(); pv(o,vb0+sl_cur,PAF(0),PAF(1),PAF(2),PAF(3)); }
  #undef PKW
  #undef PAF
  #undef VFR
  #undef PIN
  #undef GAPA
  #undef GAPB
  #undef EX
  #undef VRD
  #undef KRD
  #undef STEP
  #undef ENDW
  {auto rr=__builtin_amdgcn_permlane32_swap(__float_as_uint(l_reg),__float_as_uint(l_reg),false,false);l_reg=__uint_as_float(rr[0])+__uint_as_float(rr[1]);}
  if(hi==0)wsf[32+r32]=l_reg;asm volatile("s_waitcnt lgkmcnt(0)":::"memory");
  float rli[16];
  #pragma unroll
  for(int r=0;r<16;++r)rli[r]=__builtin_amdgcn_rcpf(wsf[32+crow(r,hi)]);
  bf16*Ow=O+(rowbase+q0+wid*QBLK)*OPITCH+h*D;
  { bf16*stg=(bf16*)(shm+LDS_OST)+wid*2048;
    #pragma unroll
    for(int r=0;r<16;++r){const int orow=crow(r,hi);
      #pragma unroll
      for(int d0=0;d0<2;++d0)stg[orow*64+d0*32+r32]=__float2bfloat16(o[d0][r]*rli[r]);}
    asm volatile("s_waitcnt lgkmcnt(0)":::"memory");
    #pragma unroll
    for(int i=0;i<4;++i){const int row=i*8+(lane>>3),ch=lane&7; const u32x4 v=*(const u32x4*)(stg+row*64+ch*8); *(u32x4*)(Ow+(long)row*OPITCH+ch*8)=v;} }
  asm volatile("s_waitcnt lgkmcnt(0)\n\ts_barrier":::"memory");
  #undef DMA_K
  #undef DMA_V
  #undef ROT
  #undef WAIT_BAR
}
#undef MSK
constexpr int ATTN_LDS_BYTES=LDS_BYTES;
#undef SBAR
}
#define XB_TMO      128
#define XB_XCNT(j)  (256  + 64 * (j))
#define XB_XSUB(j)  (1280 + 64 * (j))
#define XB_XGEN(j)  (2304 + 64 * (j))
#define XB_TOP      3328
#define XB_TOPGEN   3392
#define XCD_BAR_WORDS 3456
#define XB_SPIN_CAP (1u << 18)

__device__ __forceinline__ unsigned xb_ld(unsigned* p)              { return __hip_atomic_load(p, __ATOMIC_RELAXED, __HIP_MEMORY_SCOPE_AGENT); }
__device__ __forceinline__ unsigned xb_add(unsigned* p, unsigned v) { return __hip_atomic_fetch_add(p, v, __ATOMIC_RELAXED, __HIP_MEMORY_SCOPE_AGENT); }
__device__ __forceinline__ unsigned xb_xcc_id() { return (unsigned)__builtin_amdgcn_s_getreg((3 << 11) | 20) & 0xFu; }
#define XB_SPIN(cond, bar) do { unsigned _sp = 0; while (cond) { __builtin_amdgcn_s_sleep(1); \
    if ((++_sp & 255u) == 0u) { if (xb_ld(&(bar)[XB_TMO])) break; if (_sp > XB_SPIN_CAP) { atomicAdd(&(bar)[XB_TMO], 1u); break; } } } } while (0)

struct XcdBarrier {
    unsigned* bar; unsigned x;
    volatile LAS unsigned* st;
};

__device__ __forceinline__ XcdBarrier xcd_barrier_post(unsigned* bar, volatile LAS unsigned* st) {
    XcdBarrier b; b.bar = bar; b.x = xb_xcc_id(); b.st = st;
    if (threadIdx.x == 0) (void)xb_add(&bar[XB_XCNT(b.x)], 1u);
    return b;
}
__device__ __forceinline__ void xcd_barrier_complete(unsigned* bar, unsigned x, unsigned& nloc, unsigned& nx) {
    const unsigned G = gridDim.x * gridDim.y * gridDim.z;
    unsigned sum, cnt, mine, sp = 0u;
    for (;;) {
        sum = 0u; cnt = 0u; mine = 0u;
#pragma unroll
        for (unsigned j = 0; j < 16; ++j) { const unsigned c = xb_ld(&bar[XB_XCNT(j)]); sum += c; cnt += (c > 0u) ? 1u : 0u; mine = (j == x) ? c : mine; }
        if (sum == G) break;
        __builtin_amdgcn_s_sleep(1);
        if ((++sp & 255u) == 0u) { if (xb_ld(&bar[XB_TMO])) break; if (sp > XB_SPIN_CAP) { atomicAdd(&bar[XB_TMO], 1u); break; } }
    }
    nloc = mine > 0u ? mine : 1u; nx = cnt > 0u ? cnt : 1u;
}

__device__ __forceinline__ void xcd_barrier(const XcdBarrier& b) {
    asm volatile("s_waitcnt vmcnt(0)" ::: "memory");
    __syncthreads();
    if (threadIdx.x == 0) {
        unsigned* bar = b.bar;
        __builtin_amdgcn_s_waitcnt(0);
        unsigned nloc = b.st[0], nx = b.st[1];
        if (nloc == 0u) { xcd_barrier_complete(bar, b.x, nloc, nx); b.st[0] = nloc; b.st[1] = nx; }
        const unsigned old = xb_add(&bar[XB_XSUB(b.x)], 1u);
        const unsigned gen = old / nloc;
        if (old + 1u == (gen + 1u) * nloc) {
            __builtin_amdgcn_fence(__ATOMIC_RELEASE, "agent");
            asm volatile("s_waitcnt vmcnt(0)" ::: "memory");
            const unsigned og = xb_add(&bar[XB_TOP], 1u);
            const unsigned tg = og / nx;
            if (og + 1u == (tg + 1u) * nx) xb_add(&bar[XB_TOPGEN], 1u);
            else XB_SPIN(xb_ld(&bar[XB_TOPGEN]) == tg, bar);
            __builtin_amdgcn_fence(__ATOMIC_ACQUIRE, "agent");
            xb_add(&bar[XB_XGEN(b.x)], 1u);
            asm volatile("s_waitcnt vmcnt(0)" ::: "memory");
        } else {
            XB_SPIN(xb_ld(&bar[XB_XGEN(b.x)]) == gen, bar);
            __builtin_amdgcn_fence(__ATOMIC_ACQUIRE, "agent");
            asm volatile("s_waitcnt vmcnt(0)" ::: "memory");
        }
    }
    __syncthreads();
}
struct Frame {
    LAS unsigned char* lds;
    volatile LAS unsigned* MISC;
    gu32* ctl;
    int tid, lane, wave;
    int vcu, G;
    unsigned char* ws;
    const float* in[18]; float* out;
};
__device__ __forceinline__ float wave_sum(float v) {
#pragma unroll
    for (int o = 1; o < 64; o <<= 1) v += __shfl_xor(v, o);
    return v;
}
__device__ __forceinline__ float wave_max(float v) {
#pragma unroll
    for (int o = 1; o < 64; o <<= 1) v = fmaxf(v, __shfl_xor(v, o));
    return v;
}
template <int MODE> __device__ __forceinline__ int tr_row(int n) {
    if (MODE == 0) return n < 1860 ? n : n + 188;
    if (MODE == 1) return n < 1024 ? 256 * (n >> 7) + (n & 127) : 256 * ((n - 1024) >> 7) + 128 + ((n - 1024) & 127);
    if (MODE == 4) return 256 * (n >> 7) + (n & 127);
    if (MODE == 5) return 256 * (n >> 7) + 128 + (n & 127);
    return n;
}
template <int MODE> __device__ __forceinline__ void tr_item(const float* W, int N, bf16* WT, int ldt, int koff, LAS float* scr, int kb, int nb, int lane) {
    const int k0 = 64 * kb, n0 = 32 * nb; const bool colok = (n0 + (lane & 31)) < N;
#pragma unroll 8
    for (int i = 0; i < 32; ++i) { const int kk = 2 * i + (lane >> 5); scr[kk * 33 + (lane & 31)] = colok ? W[(size_t)(k0 + kk) * N + n0 + (lane & 31)] : 0.f; }
    LDS_WAIT(); asm volatile("" ::: "memory");
    const int c = lane & 7;
#pragma unroll
    for (int j = 0; j < 4; ++j) { const int n = (lane >> 3) + 8 * j; const LAS float* s = scr + (8 * c) * 33 + n;
        v4u o; o.x = pk2(s[0 * 33], s[1 * 33]); o.y = pk2(s[2 * 33], s[3 * 33]); o.z = pk2(s[4 * 33], s[5 * 33]); o.w = pk2(s[6 * 33], s[7 * 33]);
        if (n0 + n < N) *(GAS v4u*)(WT + (size_t)tr_row<MODE>(n0 + n) * ldt + koff + k0 + 8 * c) = o; }
    LDS_WAIT(); asm volatile("" ::: "memory");
}
__device__ __forceinline__ void rms_row_to_bf16(const float* xrow, const float* g, bf16* orow, int lane) {
    const GAS f32x4* xr = (const GAS f32x4*)xrow + lane; const GAS f32x4* gr = (const GAS f32x4*)g + lane;
    f32x4 v[4]; float s = 0.f;
#pragma unroll
    for (int j = 0; j < 4; ++j) { v[j] = xr[64 * j]; s += (v[j].x * v[j].x + v[j].y * v[j].y) + (v[j].z * v[j].z + v[j].w * v[j].w); }
    const float r = 1.0f / sqrtf(wave_sum(s) * (1.f / 1024.f) + EPS);
    GAS unsigned long long* o8 = (GAS unsigned long long*)orow + lane;
#pragma unroll
    for (int j = 0; j < 4; ++j) { const f32x4 gv = gr[64 * j]; o8[64 * j] = (unsigned long long)pk2(v[j].x * r * gv.x, v[j].y * r * gv.y) | ((unsigned long long)pk2(v[j].z * r * gv.z, v[j].w * r * gv.w) << 32); }
}
__device__ __forceinline__ void p0_prologue(Frame& F) {
    LAS float* scr = (LAS float*)(F.lds + RING_OFF + F.wave * 16384);
    const int gw = F.vcu * NWAVES + F.wave, NGW = F.G * NWAVES;
    bf16* Win_t = (bf16*)(F.ws + WS_WIN); bf16* Wab_t = (bf16*)(F.ws + WS_WAB); bf16* Wout_t = (bf16*)(F.ws + WS_WOUT); bf16* Wpool_t = (bf16*)(F.ws + WS_WPOOL);
    bf16* W1_t = (bf16*)(F.ws + WS_W1); bf16* W2_t = (bf16*)(F.ws + WS_W2);
    constexpr int I_W1 = 32 * 16 * 64, I_W2 = 32 * 16 * 32, I_IN = 16 * 139, I_OUT = 16 * 32, I_WA = 8 * 32, I_WB = 8 * 32, I_POOL = 32;
    constexpr int NITEMS = I_W1 + I_W2 + I_IN + I_OUT + I_WA + I_WB + I_POOL;
    for (int it = gw; it < NITEMS; it += NGW) {
        int r = it;
        if (r < I_W1) { const int e = r >> 10, rr = r & 1023; tr_item<1>(F.in[14] + (size_t)e * 1024 * 2048, 2048, W1_t + (size_t)e * 2048 * 1024, 1024, 0, scr, rr >> 6, rr & 63, F.lane); continue; } r -= I_W1;
        if (r < I_W2) { const int e = r >> 9, rr = r & 511; tr_item<2>(F.in[16] + (size_t)e * 1024 * 1024, 1024, W2_t + (size_t)e * 1024 * 1024, 1024, 0, scr, rr >> 5, rr & 31, F.lane); continue; } r -= I_W2;
        if (r < I_IN) { tr_item<0>(F.in[2], NIN, Win_t, 1024, 0, scr, r / 139, r % 139, F.lane); continue; } r -= I_IN;
        if (r < I_OUT) { tr_item<2>(F.in[10], 1024, Wout_t, 1024, 0, scr, r >> 5, r & 31, F.lane); continue; } r -= I_OUT;
        if (r < I_WA) { tr_item<4>(F.in[8], 1024, Wab_t, 1024, 0, scr, r >> 5, r & 31, F.lane); continue; } r -= I_WA;
        if (r < I_WB) { tr_item<5>(F.in[9], 1024, Wab_t, 1024, 512, scr, r >> 5, r & 31, F.lane); continue; } r -= I_WB;
        { const int g = r >> 3, rr = r & 7; tr_item<2>(F.in[5] + (size_t)g * 128 * 128, 128, Wpool_t + (size_t)(128 * g) * 512, 512, 128 * g, scr, rr >> 2, rr & 3, F.lane); }
    }
    const int gt = F.vcu * (NWAVES * 64) + F.tid, NGT = F.G * NWAVES * 64; const v4u z = {0u, 0u, 0u, 0u};
    for (int i = gt; i < 2048 * 64; i += NGT) { const int row = i >> 6, ch = i & 63; *(GAS v4u*)(Wab_t + (size_t)row * 1024 + (((row & 255) < 128) ? 512 : 0) + ch * 8) = z; }
    for (int i = gt; i < 512 * 64; i += NGT) { const int row = i >> 6, ch = i & 63; if ((ch >> 4) != (row >> 7)) *(GAS v4u*)(Wpool_t + (size_t)row * 512 + ch * 8) = z; }
    for (int i = gt; i < 188 * 128; i += NGT) { const int row = 1860 + (i >> 7), ch = i & 127; *(GAS v4u*)(Win_t + (size_t)row * 1024 + ch * 8) = z; }
    bf16* H = (bf16*)(F.ws + WS_H);
    for (int m = gw; m < M; m += NGW) rms_row_to_bf16(F.in[0] + (size_t)m * 1024, F.in[1], H + (size_t)m * 1024, F.lane);
}
__device__ __forceinline__ void qknorm_rows(Frame& F) {
    const int gw = F.vcu * NWAVES + F.wave, NGW = F.G * NWAVES, lane = F.lane;
    bf16* Q = (bf16*)(F.ws + WS_Q); bf16* K = (bf16*)(F.ws + WS_K);
    const int d0 = (lane & 7) * 8;
    float gq[8], gk[8];
#pragma unroll
    for (int j = 0; j < 8; ++j) { gq[j] = F.in[3][d0 + j] * attn_body::C2; gk[j] = F.in[4][d0 + j]; }
    for (int m = gw; m < 2 * M; m += NGW) {
        const bool isq = m < M; bf16* p = (isq ? Q + (size_t)m * 512 : K + (size_t)(m - M) * 512) + lane * 8;
        const v4u w = *(const GAS v4u*)p; float x[8] = {bflo(w.x), bfhi(w.x), bflo(w.y), bfhi(w.y), bflo(w.z), bfhi(w.z), bflo(w.w), bfhi(w.w)};
        float s = 0.f;
#pragma unroll
        for (int j = 0; j < 8; ++j) s += x[j] * x[j];
        s += __shfl_xor(s, 1); s += __shfl_xor(s, 2); s += __shfl_xor(s, 4);
        const float r = 1.0f / sqrtf(s * (1.f / 64.f) + EPS);
#pragma unroll
        for (int j = 0; j < 8; ++j) x[j] = x[j] * r * (isq ? gq[j] : gk[j]);
        v4u o; o.x = pk2(x[0], x[1]); o.y = pk2(x[2], x[3]); o.z = pk2(x[4], x[5]); o.w = pk2(x[6], x[7]);
        *(GAS v4u*)p = o;
    }
}
__device__ __forceinline__ void pool_diff_rows(Frame& F) {
    const int gw = F.vcu * NWAVES + F.wave, NGW = F.G * NWAVES, lane = F.lane;
    const bf16* U = (const bf16*)(F.ws + WS_U); bf16* Dd = (bf16*)(F.ws + WS_DIFF);
    const int win = 2 << (lane >> 4);
    for (int m = gw; m < M; m += NGW) {
        const int t = m & (SEQ - 1); const int cnt = (t + 1 < win) ? t + 1 : win;
        float a[8] = {0.f, 0.f, 0.f, 0.f, 0.f, 0.f, 0.f, 0.f}, self[8];
        for (int j = 0; j < cnt; ++j) { const v4u w = *(const GAS v4u*)(U + (size_t)(m - j) * 512 + lane * 8);
            const float x[8] = {bflo(w.x), bfhi(w.x), bflo(w.y), bfhi(w.y), bflo(w.z), bfhi(w.z), bflo(w.w), bfhi(w.w)};
#pragma unroll
            for (int i = 0; i < 8; ++i) { a[i] += x[i]; if (j == 0) self[i] = x[i]; } }
        const float inv = 1.0f / (float)cnt; v4u o;
        o.x = pk2(a[0] * inv - self[0], a[1] * inv - self[1]); o.y = pk2(a[2] * inv - self[2], a[3] * inv - self[3]);
        o.z = pk2(a[4] * inv - self[4], a[5] * inv - self[5]); o.w = pk2(a[6] * inv - self[6], a[7] * inv - self[7]);
        *(GAS v4u*)(Dd + (size_t)m * 512 + lane * 8) = o;
    }
}
__device__ __forceinline__ int tk_fidx(int q) { return (((q >> 3) * 2 + (q & 1)) * 4) + ((q & 7) >> 1); }
template <int PASS> __device__ __forceinline__ void topk_pass(const bf16x8 (&af)[4][4], const bf16* IKb, int nb, LAS unsigned* hist, const LAS f32x4* wl4, const LAS v4u* pfx4, int wave, int lane) {
    const int hi = lane >> 5, n32 = lane & 31;
    LAS unsigned* GT = hist; LAS unsigned* EQ = hist + 32 * 257;
    for (int blk = wave; blk < nb; blk += 8) {
        bf16x8 bfr[4]; const bf16* kp = IKb + (size_t)(32 * blk + n32) * 64 + 8 * hi;
#pragma unroll
        for (int kk = 0; kk < 4; ++kk) bfr[kk] = *(const GAS bf16x8*)(kp + 16 * kk);
#pragma unroll
        for (int qg = 0; qg < 4; ++qg) {
            f32x16 acc = {};
#pragma unroll
            for (int kk = 0; kk < 4; ++kk) acc = __builtin_amdgcn_mfma_f32_32x32x16_bf16(af[qg][kk], bfr[kk], acc, 0, 0, 0);
            const v4u pf = pfx4[qg * 2 + hi];
            unsigned long long bg[4], be[4]; unsigned long long anye = 0ull;
#pragma unroll
            for (int jj = 0; jj < 4; ++jj) {
                const f32x4 w = wl4[(qg * 2 + hi) * 4 + jj];
                float s = w[0] * fmaxf(acc[4 * jj + 0], 0.f); s = fmaf(w[1], fmaxf(acc[4 * jj + 1], 0.f), s); s = fmaf(w[2], fmaxf(acc[4 * jj + 2], 0.f), s); s = fmaf(w[3], fmaxf(acc[4 * jj + 3], 0.f), s);
                const unsigned u = __float_as_uint(s), key = u ^ ((unsigned)((int)u >> 31) | 0x80000000u);
                LAS unsigned* hq = hist + (8 * qg + 2 * jj + hi) * 1024;
                if (PASS == 0) { const unsigned bin = key >> 21; __hip_atomic_fetch_add(hq + (bin >> 1), 1u << ((bin & 1u) * 16u), __ATOMIC_RELAXED, __HIP_MEMORY_SCOPE_WORKGROUP); }
                if (PASS == 1) { if ((key >> 21) == pf[jj]) { const unsigned bin = (key >> 10) & 0x7ffu; __hip_atomic_fetch_add(hq + (bin >> 1), 1u << ((bin & 1u) * 16u), __ATOMIC_RELAXED, __HIP_MEMORY_SCOPE_WORKGROUP); } }
                if (PASS == 2) { if ((key >> 10) == pf[jj]) { const unsigned bin = key & 0x3ffu; __hip_atomic_fetch_add(hq + (bin >> 1), 1u << ((bin & 1u) * 16u), __ATOMIC_RELAXED, __HIP_MEMORY_SCOPE_WORKGROUP); } }
                if (PASS == 3) { bg[jj] = __ballot(key > pf[jj]); be[jj] = __ballot(key == pf[jj]); anye |= be[jj]; }
            }
            if (PASS == 3) {
                unsigned vg = 0u, ve = 0u;
#pragma unroll
                for (int jj = 0; jj < 4; ++jj) { vg = (lane == 2 * jj) ? (unsigned)bg[jj] : vg; vg = (lane == 2 * jj + 1) ? (unsigned)(bg[jj] >> 32) : vg;
                                                 ve = (lane == 2 * jj) ? (unsigned)be[jj] : ve; ve = (lane == 2 * jj + 1) ? (unsigned)(be[jj] >> 32) : ve; }
                if (lane < 8) { GT[(8 * qg + lane) * 257 + blk] = vg; if (anye != 0ull) EQ[(8 * qg + lane) * 257 + blk] = ve; }
            }
        }
    }
}
template <int PASS> __device__ __forceinline__ void topk_scan(LAS unsigned* hist, LAS unsigned* pfx, LAS unsigned* need, LAS unsigned* neq, int wave, int lane) {
    constexpr int DW = (PASS == 2) ? 512 : 1024, PER = DW / 64, BITS = (PASS == 2) ? 10 : 11;
    for (int qq = 0; qq < 4; ++qq) {
        const int q = 4 * wave + qq; LAS unsigned* hq = hist + q * 1024; const int base = DW - (lane + 1) * PER;
        unsigned d[PER];
#pragma unroll
        for (int i = 0; i < PER / 4; ++i) { const v4u v = *(const LAS v4u*)(hq + base + 4 * i); d[4 * i] = v.x; d[4 * i + 1] = v.y; d[4 * i + 2] = v.z; d[4 * i + 3] = v.w; *(LAS v4u*)(hq + base + 4 * i) = (v4u){0u, 0u, 0u, 0u}; }
        unsigned s = 0u;
#pragma unroll
        for (int i = 0; i < PER; ++i) s += (d[i] & 0xffffu) + (d[i] >> 16);
        unsigned inc = s;
#pragma unroll
        for (int o = 1; o < 64; o <<= 1) { const unsigned v = __shfl_up(inc, o); if (lane >= o) inc += v; }
        const unsigned nd = need[q];
        const unsigned long long bal = __ballot(inc >= nd);
        const int Ls = __builtin_amdgcn_readfirstlane(bal ? (int)__ffsll((long long)bal) - 1 : 63);
        unsigned run = inc - s, fbin = 0u, fneed = 1u, fcnt = 1u; bool found = false;
#pragma unroll
        for (int i = PER - 1; i >= 0; --i) {
            const unsigned chi = d[i] >> 16, clo = d[i] & 0xffffu;
            if (!found && run + chi >= nd) { found = true; fbin = 2u * (unsigned)(base + i) + 1u; fneed = nd - run; fcnt = chi; } run += chi;
            if (!found && run + clo >= nd) { found = true; fbin = 2u * (unsigned)(base + i); fneed = nd - run; fcnt = clo; } run += clo;
        }
        fbin = (unsigned)__builtin_amdgcn_readlane((int)fbin, Ls); fneed = (unsigned)__builtin_amdgcn_readlane((int)fneed, Ls); fcnt = (unsigned)__builtin_amdgcn_readlane((int)fcnt, Ls);
        if (lane == 0) { const int fi = tk_fidx(q); pfx[fi] = (PASS == 0) ? fbin : ((pfx[fi] << BITS) | fbin); need[q] = fneed; neq[q] = fcnt; }
    }
}
__device__ __forceinline__ void topk_unit(Frame& F, int b, int c, int half) {
    const bf16* IQ = (const bf16*)(F.ws + WS_IQ); const bf16* IK = (const bf16*)(F.ws + WS_IK); const float* IW = (const float*)(F.ws + WS_IW);
    unsigned long long* MK = (unsigned long long*)(F.ws + WS_MASK);
    LAS unsigned* hist = (LAS unsigned*)(F.lds + RING_OFF);
    LAS unsigned* GT = hist; LAS unsigned* EQ = hist + 32 * 257;
    LAS float* wl = (LAS float*)(F.lds + XTRA_OFF);
    LAS unsigned* pfx = (LAS unsigned*)(F.lds + XTRA_OFF + 512);
    LAS unsigned* need = pfx + 32; LAS unsigned* neq = need + 32;
    const int tid = F.tid, lane = F.lane, wave = F.wave;
    const int t0 = 64 * c + 32 * half, L = 64 * (c + 1), nb = L / 32; const size_t tokb = (size_t)b * SEQ;
#pragma unroll
    for (int i = 0; i < 16; ++i) ((LAS v4u*)hist)[tid + 512 * i] = (v4u){0u, 0u, 0u, 0u};
    if (tid < 128) { const int q = tid >> 2, hd = tid & 3; wl[tk_fidx(q) * 4 + hd] = IW[(tokb + t0 + q) * 4 + hd] * 0.0625f; }
    if (tid < 32) { pfx[tid] = 0u; need[tid] = (unsigned)TOPK; neq[tid] = 0u; }
    __syncthreads();
    if (L > TOPK) {
        bf16x8 af[4][4];
#pragma unroll
        for (int qg = 0; qg < 4; ++qg)
#pragma unroll
            for (int kk = 0; kk < 4; ++kk) af[qg][kk] = *(const GAS bf16x8*)(IQ + (tokb + t0 + 8 * qg) * 256 + (lane & 31) * 64 + 16 * kk + 8 * (lane >> 5));
        const bf16* IKb = IK + tokb * 64; const LAS f32x4* wl4 = (const LAS f32x4*)wl; const LAS v4u* pfx4 = (const LAS v4u*)pfx;
        topk_pass<0>(af, IKb, nb, hist, wl4, pfx4, wave, lane); __syncthreads(); topk_scan<0>(hist, pfx, need, neq, wave, lane); __syncthreads();
        topk_pass<1>(af, IKb, nb, hist, wl4, pfx4, wave, lane); __syncthreads(); topk_scan<1>(hist, pfx, need, neq, wave, lane); __syncthreads();
        topk_pass<2>(af, IKb, nb, hist, wl4, pfx4, wave, lane); __syncthreads(); topk_scan<2>(hist, pfx, need, neq, wave, lane); __syncthreads();
        topk_pass<3>(af, IKb, nb, hist, wl4, pfx4, wave, lane); __syncthreads();
        for (int qq = 0; qq < 4; ++qq) {
            const int q = 4 * wave + qq; const unsigned nd = need[q], ne = neq[q];
            if (nd < ne) { LAS unsigned* eqr = EQ + q * 257; unsigned w[4], pc = 0u;
#pragma unroll
                for (int i = 0; i < 4; ++i) { w[i] = eqr[4 * lane + i]; pc += (unsigned)__builtin_popcount(w[i]); }
                unsigned inc = pc;
#pragma unroll
                for (int o = 1; o < 64; o <<= 1) { const unsigned v = __shfl_up(inc, o); if (lane >= o) inc += v; }
                unsigned before = inc - pc;
#pragma unroll
                for (int i = 0; i < 4; ++i) { const unsigned p = (unsigned)__builtin_popcount(w[i]); const int take = (int)nd - (int)before;
                    if (take <= 0) w[i] = 0u; else if (take < (int)p) { unsigned x = w[i], r = 0u; for (int k = 0; k < take; ++k) { const unsigned lsb = x & (0u - x); r |= lsb; x ^= lsb; } w[i] = r; }
                    before += p; eqr[4 * lane + i] = w[i]; } }
        }
        __syncthreads();
    }
    const int ntile = 4 * (c / 4 + 1);
    for (int idx = tid; idx < 32 * ntile; idx += NWAVES * 64) { const int q = idx & 31, t = idx >> 5; unsigned w0, w1;
        if (L <= TOPK) { w0 = (2 * t < nb) ? 0xffffffffu : 0u; w1 = (2 * t + 1 < nb) ? 0xffffffffu : 0u; }
        else { w0 = GT[q * 257 + 2 * t] | EQ[q * 257 + 2 * t]; w1 = GT[q * 257 + 2 * t + 1] | EQ[q * 257 + 2 * t + 1]; }
        MK[((size_t)b * 128 + t) * SEQ + t0 + q] = (unsigned long long)w0 | ((unsigned long long)w1 << 32); }
    __syncthreads();
}
__device__ __forceinline__ void router_phase(Frame& F) {
    LAS float* tab = (LAS float*)(F.lds + RING_OFF);
    LAS unsigned* lc = (LAS unsigned*)(F.lds + XTRA_OFF);
    LAS unsigned* basep = lc + 32;
    LAS unsigned* rec_e = basep + 32; LAS unsigned* rec_r = rec_e + 256; LAS float* rec_w = (LAS float*)(rec_r + 256);
    const int tid = F.tid, lane = F.lane, wave = F.wave;
    const float* x1 = F.out; const float* g2 = F.in[11]; const float* rw = F.in[12]; const float* rb = F.in[13];
    bf16* H2 = (bf16*)(F.ws + WS_H2); int* TOKE = (int*)(F.ws + WS_TOKE); int* TOKP = TOKE + M * 4; float* TOKW = (float*)(TOKP + M * 4);
    for (int i = tid; i < 1024 * 8; i += NWAVES * 64) { const int k = i >> 3, ch = i & 7; const int slot = ((k & 255) >> 2) + 64 * (4 * (k >> 8) + (k & 3));
        *(LAS f32x4*)(tab + slot * 36 + 4 * ch) = *(const GAS f32x4*)(rw + (size_t)k * 32 + 4 * ch); }
    if (tid < 32) lc[tid] = 0u;
    __syncthreads();
    for (int tb = blockIdx.x; tb < M / 64; tb += F.G) {
        for (int ti = 0; ti < 8; ++ti) {
            const int tl = wave * 8 + ti; const size_t t = (size_t)tb * 64 + tl;
            const GAS f32x4* xr = (const GAS f32x4*)(x1 + t * 1024) + lane; const GAS f32x4* gr = (const GAS f32x4*)g2 + lane;
            f32x4 v[4]; float ss = 0.f;
#pragma unroll
            for (int j = 0; j < 4; ++j) { v[j] = xr[64 * j]; ss += (v[j].x * v[j].x + v[j].y * v[j].y) + (v[j].z * v[j].z + v[j].w * v[j].w); }
            const float r = 1.0f / sqrtf(wave_sum(ss) * (1.f / 1024.f) + EPS);
            GAS unsigned long long* o8 = (GAS unsigned long long*)(H2 + t * 1024) + lane;
#pragma unroll
            for (int j = 0; j < 4; ++j) { const f32x4 gv = gr[64 * j]; v[j] = v[j] * r * gv; o8[64 * j] = (unsigned long long)pk2(v[j].x, v[j].y) | ((unsigned long long)pk2(v[j].z, v[j].w) << 32); }
            float acc[32];
#pragma unroll
            for (int e = 0; e < 32; ++e) acc[e] = 0.f;
#pragma unroll
            for (int m = 0; m < 16; ++m) { const float xk = v[m >> 2][m & 3]; const LAS f32x4* row = (const LAS f32x4*)(tab + (lane + 64 * m) * 36);
#pragma unroll
                for (int ch = 0; ch < 8; ++ch) { const f32x4 wv = row[ch]; acc[4 * ch] = fmaf(xk, wv.x, acc[4 * ch]); acc[4 * ch + 1] = fmaf(xk, wv.y, acc[4 * ch + 1]); acc[4 * ch + 2] = fmaf(xk, wv.z, acc[4 * ch + 2]); acc[4 * ch + 3] = fmaf(xk, wv.w, acc[4 * ch + 3]); } }
#pragma unroll
            for (int st = 0; st < 5; ++st) { const int o = 32 >> st, nkeep = 16 >> st; const bool up = (lane & o) != 0;
#pragma unroll
                for (int i = 0; i < nkeep; ++i) { const float keep = up ? acc[i + nkeep] : acc[i], send = up ? acc[i] : acc[i + nkeep]; acc[i] = keep + __shfl_xor(send, o); } }
            float val = acc[0] + __shfl_xor(acc[0], 1);
            const int e = lane >> 1; val += rb[e];
            int se[4]; float sv[4];
#pragma unroll
            for (int rr = 0; rr < 4; ++rr) { float bv = val; int be = e;
#pragma unroll
                for (int o = 1; o < 64; o <<= 1) { const float ov = __shfl_xor(bv, o); const int oe = __shfl_xor(be, o); if (ov > bv || (ov == bv && oe < be)) { bv = ov; be = oe; } }
                se[rr] = be; sv[rr] = bv; if (e == be) val = -INFINITY; }
            const float p1 = __expf(sv[1] - sv[0]), p2 = __expf(sv[2] - sv[0]), p3 = __expf(sv[3] - sv[0]); const float inv = 1.0f / (1.0f + p1 + p2 + p3);
            if (lane < 4) { const int me = lane == 0 ? se[0] : lane == 1 ? se[1] : lane == 2 ? se[2] : se[3]; const float mw = (lane == 0 ? 1.0f : lane == 1 ? p1 : lane == 2 ? p2 : p3) * inv;
                const unsigned rk = __hip_atomic_fetch_add(lc + me, 1u, __ATOMIC_RELAXED, __HIP_MEMORY_SCOPE_WORKGROUP);
                rec_e[tl * 4 + lane] = (unsigned)me; rec_r[tl * 4 + lane] = rk; rec_w[tl * 4 + lane] = mw; }
        }
        __syncthreads();
        if (tid < 32) basep[tid] = __hip_atomic_fetch_add(F.ctl + CW_CNT + tid, lc[tid], RLX_AGENT);
        __syncthreads();
        if (tid < 256) { const size_t p = (size_t)tb * 256 + tid; const unsigned me = rec_e[tid]; TOKE[p] = (int)me; TOKP[p] = (int)(basep[me] + rec_r[tid]); TOKW[p] = rec_w[tid]; }
        __syncthreads();
        if (tid < 32) lc[tid] = 0u;
        __syncthreads();
    }
}
__device__ __forceinline__ void moe_tables(Frame& F, LAS unsigned*& tpre, LAS unsigned*& cntl) {
    cntl = (LAS unsigned*)(F.lds + XTRA_OFF + 8192); tpre = cntl + 32;
    if (F.tid < 32) cntl[F.tid] = __hip_atomic_load(F.ctl + CW_CNT + F.tid, RLX_AGENT);
    __syncthreads();
    if (F.tid == 0) { unsigned a = 0u; for (int e = 0; e < 32; ++e) { tpre[e] = a; a += (cntl[e] + 255u) >> 8; } tpre[32] = a; }
    __syncthreads();
}
__device__ __forceinline__ LAS unsigned* moe_build_units(Frame& F, const LAS unsigned* tpre, int NT) {
    LAS unsigned* list = (LAS unsigned*)(F.lds + XTRA_OFF + 8192 + 512);
    if (F.tid < 24) { unsigned w = 0xffffffffu; const int U = (int)tpre[32] * NT; const long Lg = (long)F.tid * F.G + blockIdx.x;
        if (F.tid < 20 && Lg < U) { int wg = (int)Lg; { const int q = U / 8, r = U % 8, xcd = wg % 8, off = wg / 8; wg = (xcd < r ? xcd * (q + 1) : r * (q + 1) + (xcd - r) * q) + off; }
            int e = 0; while (e < 31 && wg >= (int)tpre[e + 1] * NT) ++e;
            const int rr = wg - (int)tpre[e] * NT, mt = (int)(tpre[e + 1] - tpre[e]); const int n = rr / mt, m = rr % mt;
            w = (unsigned)(tpre[e] + m) | ((unsigned)(e * NT + n) << 16); }
        list[F.tid] = w; }
    __syncthreads();
    return list;
}
__device__ __forceinline__ void gather_phase(Frame& F) {
    LAS unsigned* tpre; LAS unsigned* cntl; moe_tables(F, tpre, cntl);
    const int gw = F.vcu * NWAVES + F.wave, NGW = F.G * NWAVES, lane = F.lane;
    const bf16* H2 = (const bf16*)(F.ws + WS_H2); bf16* XP = (bf16*)(F.ws + WS_XP); float* ROWW = (float*)(F.ws + WS_ROWW);
    const int* TOKE = (const int*)(F.ws + WS_TOKE); const int* TOKP = TOKE + M * 4; const float* TOKW = (const float*)(TOKP + M * 4); int* TOKR = (int*)(TOKW + M * 4);
    for (int p = gw; p < M * 4; p += NGW) { const int e = TOKE[p]; const int row = (int)tpre[e] * 256 + TOKP[p];
        const GAS v4u* src = (const GAS v4u*)(H2 + (size_t)(p >> 2) * 1024); GAS v4u* dst = (GAS v4u*)(XP + (size_t)row * 1024);
        const v4u a = src[lane], bq = src[lane + 64]; dst[lane] = a; dst[lane + 64] = bq;
        if (lane == 0) { TOKR[p] = row; ROWW[row] = TOKW[p]; } }
    for (int i = gw; i < 32 * 256; i += NGW) { const int e = i >> 8; const int row = (int)tpre[e] * 256 + (int)cntl[e] + (i & 255);
        if (row < (int)tpre[e + 1] * 256) { GAS v4u* dst = (GAS v4u*)(XP + (size_t)row * 1024); dst[lane] = (v4u){0u, 0u, 0u, 0u}; dst[lane + 64] = (v4u){0u, 0u, 0u, 0u}; if (lane == 0) ROWW[row] = 0.f; } }
}
__device__ __forceinline__ void combine_phase(Frame& F) {
    const int gw = F.vcu * NWAVES + F.wave, NGW = F.G * NWAVES, lane = F.lane;
    const bf16* Y = (const bf16*)(F.ws + WS_XP); const int* TOKR = (const int*)(F.ws + WS_TOKE) + 3 * M * 4;
    for (int t = gw; t < M; t += NGW) {
        GAS f32x4* o = (GAS f32x4*)(F.out + (size_t)t * 1024) + lane; f32x4 v[4];
#pragma unroll
        for (int j = 0; j < 4; ++j) v[j] = o[64 * j];
#pragma unroll
        for (int s = 0; s < 4; ++s) { const int row = TOKR[t * 4 + s]; const GAS v2u* y = (const GAS v2u*)(Y + (size_t)row * 1024) + lane;
#pragma unroll
            for (int j = 0; j < 4; ++j) { const v2u w = y[64 * j]; v[j].x += bflo(w.x); v[j].y += bfhi(w.x); v[j].z += bflo(w.y); v[j].w += bfhi(w.y); } }
#pragma unroll
        for (int j = 0; j < 4; ++j) o[64 * j] = v[j];
    }
}
struct Args { const float* in[18]; float* out; unsigned char* ws; int ph_lo, ph_hi; };
static_assert(sizeof(Args) == 18 * 8 + 8 + 8 + 8, "Args has no padding bytes");
__global__ void __launch_bounds__(NWAVES * 64, 2) mk_fwd(Args args) {
    extern __shared__ __attribute__((aligned(16))) unsigned char lds[];
    Frame F;
    F.lds = (LAS unsigned char*)lds;
    F.MISC = (volatile LAS unsigned*)(F.lds + MISC_OFF);
    F.tid = threadIdx.x; F.lane = F.tid & 63; F.wave = __builtin_amdgcn_readfirstlane(F.tid >> 6);
    F.G = gridDim.x; { const int bx = blockIdx.x; F.vcu = (F.G % 8 == 0) ? (bx % 8) * (F.G / 8) + bx / 8 : bx; }
    F.ws = args.ws; F.ctl = (gu32*)(args.ws + WS_CTL); F.out = args.out;
#pragma unroll
    for (int i = 0; i < 18; ++i) F.in[i] = args.in[i];
    for (int u = F.tid; u < (LDS_BYTES - LDSCTL_OFF) / 4; u += NWAVES * 64) ((LAS unsigned*)(F.lds + LDSCTL_OFF))[u] = 0u;
    __syncthreads();
    XcdBarrier bar; bar.bar = (unsigned*)(F.ctl + CW_BAR); bar.x = 0; bar.st = nullptr;
    if (!MK_SPLIT) bar = xcd_barrier_post((unsigned*)(F.ctl + CW_BAR), F.MISC + 8);
#define GRID_BAR() do { if (MK_SPLIT) { if (F.tid == 0) __hip_atomic_store(F.ctl + CW_TMO, 0xBADBA0u, RLX_AGENT); } else { xcd_barrier(bar); } } while (0)
    const int lo = args.ph_lo, hi = args.ph_hi;
#define IN(k) (lo <= (k) && (k) < hi)
#define BOTH(k) (IN(k) && IN((k) + 1))
    constexpr bool AL = true, SP = true;
    if (IN(0)) { p0_prologue(F); if (BOTH(0)) GRID_BAR(); }
    if (IN(1)) {
        pg8::Gemm g{(const bf16*)(F.ws + WS_H), (const bf16*)(F.ws + WS_WIN), M, NINP, DMODEL}; pg8::StaticOrder S; S.init(M, NINP, F.G, (int)blockIdx.x);
        pg8::EpiInProj E{F.ws};
        pg8::gemm_phase<pg8::EpiInProj, pg8::StaticOrder, AL, SP>(F.lds + RING_OFF, g, S, E);
        if (BOTH(1)) GRID_BAR();
    }
    if (IN(2)) {
        qknorm_rows(F); pool_diff_rows(F);
        for (int v = F.vcu; v < 256; v += F.G) { const int b = v >> 7, half = (v >> 6) & 1, cc = v & 63; topk_unit(F, b, 127 - cc, half); topk_unit(F, b, cc, half); }
        if (BOTH(2)) GRID_BAR();
    }
    if (IN(3)) {
        { pg8::Gemm g{(const bf16*)(F.ws + WS_DIFF), (const bf16*)(F.ws + WS_WPOOL), M, DPOOL, DPOOL}; pg8::StaticOrder S; S.init(M, DPOOL, F.G, (int)blockIdx.x);
          pg8::EpiPool E{(bf16*)(F.ws + WS_YAP), F.in[6], F.in[7]};
          pg8::gemm_phase<pg8::EpiPool, pg8::StaticOrder, AL, SP>(F.lds + RING_OFF, g, S, E); }
        const float cshift = attn_body::C2 * 64.0f * wave_max(fabsf(F.in[3][F.lane])) * wave_max(fabsf(F.in[4][F.lane]));
        for (int v = F.vcu; v < 256; v += F.G) { const int bh = v >> 4, s = v & 15;
            for (int i = 0; i < 2; ++i) attn_body::attn_unit(bh >> 3, bh & 7, i == 0 ? 31 - s : s, (const attn_body::bf16*)(F.ws + WS_Q), (const attn_body::bf16*)(F.ws + WS_K), (const attn_body::bf16*)(F.ws + WS_V),
                                                             (attn_body::bf16*)(F.ws + WS_YAP), (const unsigned long long*)(F.ws + WS_MASK), cshift, (char*)lds + RING_OFF); }
        if (BOTH(3)) GRID_BAR();
    }
    if (IN(4)) {
        pg8::Gemm g{(const bf16*)(F.ws + WS_YAP), (const bf16*)(F.ws + WS_WAB), M, 2048, DMODEL}; pg8::StaticOrder S; S.init(M, 2048, F.G, (int)blockIdx.x);
        pg8::EpiMerge E{(const bf16*)(F.ws + WS_GA), (const bf16*)(F.ws + WS_GB), (bf16*)(F.ws + WS_MERGED)};
        pg8::gemm_phase<pg8::EpiMerge, pg8::StaticOrder, AL, SP>(F.lds + RING_OFF, g, S, E);
        if (BOTH(4)) GRID_BAR();
    }
    if (IN(5)) {
        pg8::Gemm g{(const bf16*)(F.ws + WS_MERGED), (const bf16*)(F.ws + WS_WOUT), M, DMODEL, DMODEL}; pg8::StaticOrder S; S.init(M, DMODEL, F.G, (int)blockIdx.x);
        pg8::EpiResF32 E{F.in[0], F.out};
        pg8::gemm_phase<pg8::EpiResF32, pg8::StaticOrder, AL, SP>(F.lds + RING_OFF, g, S, E);
        if (BOTH(5)) GRID_BAR();
    }
    if (IN(6)) { router_phase(F); if (BOTH(6)) GRID_BAR(); }
    if (IN(7)) { gather_phase(F); if (BOTH(7)) GRID_BAR(); }
    if (IN(8)) {
        LAS unsigned* tpre; LAS unsigned* cntl; moe_tables(F, tpre, cntl);
        pg8::ListOrder S{moe_build_units(F, tpre, 8)};
        pg8::Gemm g{(const bf16*)(F.ws + WS_XP), (const bf16*)(F.ws + WS_W1), MPAD, NEXP * 2048, DMODEL};
        pg8::EpiSwiglu E{F.in[15], (bf16*)(F.ws + WS_ACT)};
        pg8::gemm_phase<pg8::EpiSwiglu, pg8::ListOrder, AL, SP>(F.lds + RING_OFF, g, S, E);
        if (BOTH(8)) GRID_BAR();
    }
    if (IN(9)) {
        LAS unsigned* tpre; LAS unsigned* cntl; moe_tables(F, tpre, cntl);
        pg8::ListOrder S{moe_build_units(F, tpre, 4)};
        pg8::Gemm g{(const bf16*)(F.ws + WS_ACT), (const bf16*)(F.ws + WS_W2), MPAD, NEXP * 1024, DEXP};
        pg8::EpiDown E{F.in[17], (const float*)(F.ws + WS_ROWW), (bf16*)(F.ws + WS_XP)};
        pg8::gemm_phase<pg8::EpiDown, pg8::ListOrder, AL, SP>(F.lds + RING_OFF, g, S, E);
        if (BOTH(9)) GRID_BAR();
    }
    if (IN(10)) { combine_phase(F); }
#undef IN
#undef BOTH
}

extern "C" void kernel_launch(void* const* d_in, const int* in_sizes, int n_in, void* d_out, int out_size, void* d_ws, size_t ws_size, hipStream_t stream) {
    static int grid = 0;
    if (grid == 0) {
        if (n_in != 18 || in_sizes[0] != M * DMODEL || out_size != M * DMODEL || ws_size < WS_END) { fprintf(stderr, "kernel_launch: built for 18 inputs, x/out of %d floats, >= %zu bytes of workspace; got n_in %d, in0 %d, out %d, ws %zu; nothing launched\n", M * DMODEL, (size_t)WS_END, n_in, n_in > 0 ? in_sizes[0] : -1, out_size, ws_size); grid = -1; return; }
        int dev = 0, cus = 0, per_cu = 0;
        if (hipGetDevice(&dev) != hipSuccess || hipDeviceGetAttribute(&cus, hipDeviceAttributeMultiprocessorCount, dev) != hipSuccess) { fprintf(stderr, "kernel_launch: hipGetDevice / hipDeviceGetAttribute failed; nothing launched\n"); grid = -1; return; }
        if (hipFuncSetAttribute((const void*)mk_fwd, hipFuncAttributeMaxDynamicSharedMemorySize, LDS_BYTES) != hipSuccess) { fprintf(stderr, "kernel_launch: hipFuncSetAttribute failed; nothing launched\n"); grid = -1; return; }
        if (hipOccupancyMaxActiveBlocksPerMultiprocessor(&per_cu, (const void*)mk_fwd, NWAVES * 64, LDS_BYTES) != hipSuccess || per_cu < 1) { fprintf(stderr, "kernel_launch: occupancy query reports %d workgroups per CU; nothing launched\n", per_cu); (void)hipGetLastError(); grid = -1; return; }
        (void)hipGetLastError();
        grid = cus;
    }
    if (grid < 0) return;
    if (hipMemsetAsync((char*)d_ws + WS_CTL, 0, CTL_ZERO_BYTES, stream) != hipSuccess) { fprintf(stderr, "kernel_launch: hipMemsetAsync of the control words failed; nothing launched\n"); return; }
    Args a{};
    for (int i = 0; i < 18; ++i) a.in[i] = (const float*)d_in[i];
    a.out = (float*)d_out; a.ws = (unsigned char*)d_ws;
    const int nl = MK_SPLIT ? N_PHASES : 1;
    for (int li = 0; li < nl; ++li) {
        a.ph_lo = MK_SPLIT ? li : 0; a.ph_hi = MK_SPLIT ? li + 1 : N_PHASES;
        hipLaunchKernelGGL(mk_fwd, dim3(grid), dim3(NWAVES * 64), LDS_BYTES, stream, a);
        const hipError_t le = hipPeekAtLastError();
        if (le != hipSuccess) { fprintf(stderr, "kernel_launch: launch %d failed: %s (grid %d x %d threads, %d B LDS)\n", li, hipGetErrorName(le), grid, NWAVES * 64, LDS_BYTES); break; }
    }
}
```

```cpp
#define MK_SPLIT 0
#include <hip/hip_runtime.h>
#include <hip/hip_bf16.h>
#include <cstdio>
#include <cstdint>
#include <cmath>
constexpr int NWAVES = 8;
#ifndef MK_SPLIT
#define MK_SPLIT 0
#endif
constexpr int N_PHASES = 11;
#ifndef REP_PHASE
#define REP_PHASE -1
#endif

constexpr int BATCH = 2, SEQ = 8192, DMODEL = 1024, M = BATCH * SEQ;
constexpr int DATT = 512, HD = 64, NH = 8, NIH = 4, IDIM = 64, TOPK = 256, DPOOL = 512, NEXP = 32, TOPE = 4, DEXP = 1024;
constexpr int NIN = 4420;
constexpr int NINP = 4608;
constexpr float EPS = 1e-6f;
constexpr int MP_TILES = 288, MPAD = MP_TILES * 256;

constexpr size_t MiB = 1u << 20;
constexpr size_t WS_CTL = 0, CTL_ZERO_BYTES = 1 * MiB;
constexpr size_t WS_WIN = 2 * MiB;
constexpr size_t WS_WAB = 12 * MiB;
constexpr size_t WS_WOUT = 16 * MiB;
constexpr size_t WS_WPOOL = 18 * MiB;
constexpr size_t WS_W1 = 20 * MiB;
constexpr size_t WS_W2 = 148 * MiB;
constexpr size_t WS_H = 212 * MiB;
constexpr size_t WS_Q = 244 * MiB, WS_K = 260 * MiB, WS_V = 276 * MiB;
constexpr size_t WS_IQ = 292 * MiB;
constexpr size_t WS_IK = 300 * MiB;
constexpr size_t WS_IW = 302 * MiB;
constexpr size_t WS_U = 303 * MiB;
constexpr size_t WS_DIFF = 319 * MiB;
constexpr size_t WS_GA = 335 * MiB, WS_GB = 367 * MiB;
constexpr size_t WS_MASK = 399 * MiB;
constexpr size_t WS_YAP = 415 * MiB;
constexpr size_t WS_MERGED = 447 * MiB;
constexpr size_t WS_H2 = 479 * MiB;
constexpr size_t WS_TOKE = 511 * MiB;
constexpr size_t WS_ROWW = 512 * MiB;
constexpr size_t WS_XP = 514 * MiB;
constexpr size_t WS_ACT = 658 * MiB;
constexpr size_t WS_END = 802 * MiB;

constexpr int CW_TMO = 0, CW_CODE = 1;
constexpr int CW_CNT = 64;
constexpr int CW_BAR = 4096;

constexpr int RING_OFF = 0, RING_BYTES = 147456;
constexpr int LDSCTL_OFF = RING_BYTES, MISC_OFF = LDSCTL_OFF + 320;
constexpr int XTRA_OFF = LDSCTL_OFF + 1024;
constexpr int LDS_BYTES = 163840;
static_assert(XTRA_OFF + 14336 <= LDS_BYTES, "LDS map");

#define GAS __attribute__((address_space(1)))
#define LAS __attribute__((address_space(3)))
typedef unsigned short bf16;
typedef unsigned v4u __attribute__((ext_vector_type(4)));
typedef unsigned v2u __attribute__((ext_vector_type(2)));
typedef float f32x4 __attribute__((ext_vector_type(4)));
typedef short bf16x8 __attribute__((ext_vector_type(8)));
typedef float f32x16 __attribute__((ext_vector_type(16)));
typedef GAS unsigned gu32;
#define RLX_AGENT __ATOMIC_RELAXED, __HIP_MEMORY_SCOPE_AGENT
#define LDS_WAIT() asm volatile("s_waitcnt lgkmcnt(0)" ::: "memory")
#define VM_WAIT() asm volatile("s_waitcnt vmcnt(0)" ::: "memory")
__device__ __forceinline__ unsigned f2bf(float f) { unsigned u = __builtin_bit_cast(unsigned, f); return (u + 0x7fffu + ((u >> 16) & 1u)) >> 16; }
__device__ __forceinline__ unsigned pk2(float lo, float hi) { return f2bf(lo) | (f2bf(hi) << 16); }
__device__ __forceinline__ float bflo(unsigned w) { return __uint_as_float(w << 16); }
__device__ __forceinline__ float bfhi(unsigned w) { return __uint_as_float(w & 0xffff0000u); }
namespace pg8 {
#define PG8_LAS __attribute__((address_space(3)))
typedef unsigned short bf16_t;
typedef short bf16x8 __attribute__((ext_vector_type(8)));
typedef float f32x4 __attribute__((ext_vector_type(4)));
typedef unsigned u32x4 __attribute__((ext_vector_type(4)));
constexpr int BM = 256, BK = 64, HALF = 128, HTB = HALF * BK * 2  , STAGE_BYTES = 8 * HTB, NXCD = 8, WGM = 8;

__host__ __device__ __forceinline__ int lds_byte(int r, int c) { const int st = (r >> 4) * 2 + (c >> 5), rr = r & 15, cc = c & 31, ob = rr * 64 + cc * 2; return st * 1024 + (ob ^ (((ob >> 9) & 1) << 5)); }
__host__ __device__ __forceinline__ void stage_rc(int b, int& R, int& C) { const int st = b / 1024, sb = b % 1024, swz = sb ^ (((sb >> 9) & 1) << 5); R = (st >> 1) * 16 + swz / 64; C = (st & 1) * 32 + (swz % 64) / 2; }
__host__ __device__ __forceinline__ int perm32(int rho) { const int n = rho >> 4, i = rho & 15; return 8 * (i >> 2) + 4 * n + (i & 3); }

struct Unit { int pm, pn; };
struct Gemm { const bf16_t* A; const bf16_t* Bt; int M, N, K; };

struct StaticOrder {
    int nM, nN, nwg, G, c;
    __host__ __device__ void init(int M, int N, int G_, int c_) { nM = M / BM; nN = N / BM; nwg = nM * nN; G = G_; c = c_; }
    __host__ __device__ bool next(int i, Unit& u) const {
        const long L = (long)i * G + c; if (L >= nwg) return false;
        int wgid = (int)L; { const int q = nwg / NXCD, r = nwg % NXCD, xcd = wgid % NXCD, off = wgid / NXCD; wgid = (xcd < r ? xcd * (q + 1) : r * (q + 1) + (xcd - r) * q) + off; }
        const int nig = WGM * nN, gid = wgid / nig, fm = gid * WGM, gsz = (nM - fm) < WGM ? (nM - fm) : WGM;
        u.pm = fm + ((wgid % nig) % gsz); u.pn = (wgid % nig) / gsz; return true;
    }
    __device__ __forceinline__ void a_ready(const Unit&) const {}
    __device__ __forceinline__ void done(const Unit&) const {}
};
__device__ __forceinline__ unsigned cvt_pk_bf16(float lo, float hi) { unsigned r; asm volatile("v_cvt_pk_bf16_f32 %0, %1, %2" : "=v"(r) : "v"(lo), "v"(hi)); return r; }
typedef float f32x2 __attribute__((ext_vector_type(2)));
typedef unsigned u32x2 __attribute__((ext_vector_type(2)));
__device__ __forceinline__ float sigmoidf_fast(float x) { return __builtin_amdgcn_rcpf(1.0f + __builtin_amdgcn_exp2f(-1.4426950408889634f * x)); }
__device__ __forceinline__ float bf_lo(unsigned w) { return __uint_as_float(w << 16); }
__device__ __forceinline__ float bf_hi(unsigned w) { return __uint_as_float(w & 0xffff0000u); }

struct EpiInProj {
    static constexpr bool PERM = true, AFTER_DRAIN = false;
    unsigned char* ws;
    static constexpr unsigned oq = (unsigned)WS_Q, ok = (unsigned)WS_K, ov = (unsigned)WS_V, oiq = (unsigned)WS_IQ, oik = (unsigned)WS_IK, ou = (unsigned)WS_U, oga = (unsigned)WS_GA, ogb = (unsigned)WS_GB, oiw = (unsigned)WS_IW;
    __device__ __forceinline__ void operator()(const f32x4 (&acc)[2][2][4][2], const Unit& un, int wr, int wc, int fr, int fq) const {
        const int pn = un.pn, row0 = un.pm * BM + wr * 64 + fr;
        if (pn == 7) {
#pragma unroll
            for (int ai = 0; ai < 2; ++ai)
#pragma unroll
                for (int m = 0; m < 4; ++m) { const size_t row = (size_t)(row0 + ai * HALF + m * 16);
                    const f32x4 v0 = acc[ai][0][m][0], v1 = acc[ai][0][m][1];
                    if (wc < 2) { u32x4 w; w.x = cvt_pk_bf16(v0[0], v0[1]); w.y = cvt_pk_bf16(v0[2], v0[3]); w.z = cvt_pk_bf16(v1[0], v1[1]); w.w = cvt_pk_bf16(v1[2], v1[3]);
                        *(u32x4*)((bf16_t*)(ws + oik) + (row >> 5) * 2048 + (2 * wc + (fq >> 1)) * 512 + ((fq & 1) * 32 + (row & 31)) * 8) = w; }
                    else if (wc == 2 && fq == 0) { *(f32x4*)((float*)(ws + oiw) + row * 4) = v0; } }
            return;
        }
        unsigned boff; int ldc, colt; bool sig = false;
        if (pn < 6) { boff = pn < 2 ? oq : (pn < 4 ? ok : ov); ldc = 512; colt = (pn & 1) * 256; }
        else if (pn == 6) { boff = oiq; ldc = 256; colt = 0; }
        else if (pn < 10) { boff = ou; ldc = 512; colt = (pn - 8) * 256; }
        else { sig = true; boff = pn < 14 ? oga : ogb; ldc = 1024; colt = ((pn - 10) & 3) * 256; }
        bf16_t* base = (bf16_t*)(ws + boff);
        const int col0 = colt + wc * 32 + 8 * fq;
#pragma unroll
        for (int ai = 0; ai < 2; ++ai)
#pragma unroll
            for (int m = 0; m < 4; ++m) { bf16_t* rowp = base + (size_t)(row0 + ai * HALF + m * 16) * ldc + col0;
#pragma unroll
                for (int bj = 0; bj < 2; ++bj) { f32x4 v0 = acc[ai][bj][m][0], v1 = acc[ai][bj][m][1];
                    if (sig) {
#pragma unroll
                        for (int j = 0; j < 4; ++j) { v0[j] = sigmoidf_fast(v0[j]); v1[j] = sigmoidf_fast(v1[j]); } }
                    u32x4 w; w.x = cvt_pk_bf16(v0[0], v0[1]); w.y = cvt_pk_bf16(v0[2], v0[3]); w.z = cvt_pk_bf16(v1[0], v1[1]); w.w = cvt_pk_bf16(v1[2], v1[3]);
                    *(u32x4*)(rowp + bj * HALF) = w; } }
    }
};
struct EpiPool {
    static constexpr bool PERM = true, AFTER_DRAIN = false;
    bf16_t* yap; const float* pb; const float* ps;
    __device__ __forceinline__ void operator()(const f32x4 (&acc)[2][2][4][2], const Unit& un, int wr, int wc, int fr, int fq) const {
        const int row0 = un.pm * BM + wr * 64 + fr, col0 = un.pn * BM + wc * 32 + 8 * fq;
        f32x4 bv[2][2], sv[2][2];
#pragma unroll
        for (int bj = 0; bj < 2; ++bj)
#pragma unroll
            for (int n = 0; n < 2; ++n) { bv[bj][n] = *(const f32x4*)(pb + col0 + bj * HALF + 4 * n); sv[bj][n] = *(const f32x4*)(ps + col0 + bj * HALF + 4 * n); }
#pragma unroll
        for (int ai = 0; ai < 2; ++ai)
#pragma unroll
            for (int m = 0; m < 4; ++m) { bf16_t* rowp = yap + (size_t)(row0 + ai * HALF + m * 16) * 1024 + 512 + col0;
#pragma unroll
                for (int bj = 0; bj < 2; ++bj) { const f32x4 v0 = (acc[ai][bj][m][0] + bv[bj][0]) * sv[bj][0], v1 = (acc[ai][bj][m][1] + bv[bj][1]) * sv[bj][1];
                    u32x4 w; w.x = cvt_pk_bf16(v0[0], v0[1]); w.y = cvt_pk_bf16(v0[2], v0[3]); w.z = cvt_pk_bf16(v1[0], v1[1]); w.w = cvt_pk_bf16(v1[2], v1[3]);
                    *(u32x4*)(rowp + bj * HALF) = w; } }
    }
};
struct EpiMerge {
    static constexpr bool PERM = true, AFTER_DRAIN = false;
    const bf16_t *gA, *gB; bf16_t* merged;
    __device__ __forceinline__ void operator()(const f32x4 (&acc)[2][2][4][2], const Unit& un, int wr, int wc, int fr, int fq) const {
        const int row0 = un.pm * BM + wr * 64 + fr, col0 = un.pn * HALF + wc * 32 + 8 * fq;
#pragma unroll
        for (int ai = 0; ai < 2; ++ai)
#pragma unroll
            for (int m = 0; m < 4; ++m) { const size_t off = (size_t)(row0 + ai * HALF + m * 16) * 1024 + col0;
                const u32x4 a = *(const u32x4*)(gA + off), b = *(const u32x4*)(gB + off);
                const f32x4 p0 = acc[ai][0][m][0], p1 = acc[ai][0][m][1], r0 = acc[ai][1][m][0], r1 = acc[ai][1][m][1];
                u32x4 w;
                w.x = cvt_pk_bf16(bf_lo(a.x) * p0[0] + bf_lo(b.x) * r0[0], bf_hi(a.x) * p0[1] + bf_hi(b.x) * r0[1]);
                w.y = cvt_pk_bf16(bf_lo(a.y) * p0[2] + bf_lo(b.y) * r0[2], bf_hi(a.y) * p0[3] + bf_hi(b.y) * r0[3]);
                w.z = cvt_pk_bf16(bf_lo(a.z) * p1[0] + bf_lo(b.z) * r1[0], bf_hi(a.z) * p1[1] + bf_hi(b.z) * r1[1]);
                w.w = cvt_pk_bf16(bf_lo(a.w) * p1[2] + bf_lo(b.w) * r1[2], bf_hi(a.w) * p1[3] + bf_hi(b.w) * r1[3]);
                *(u32x4*)(merged + off) = w; }
    }
};
struct EpiResF32 {
    static constexpr bool PERM = false, AFTER_DRAIN = false;
    const float* base; float* C;
    __device__ __forceinline__ void operator()(const f32x4 (&acc)[2][2][4][2], const Unit& un, int wr, int wc, int fr, int fq) const {
        const int row0 = un.pm * BM + wr * 64 + fr, col0 = un.pn * BM + wc * 32 + 4 * fq;
#pragma unroll
        for (int ai = 0; ai < 2; ++ai)
#pragma unroll
            for (int m = 0; m < 4; ++m) { const size_t off = (size_t)(row0 + ai * HALF + m * 16) * 1024 + col0;
#pragma unroll
                for (int bj = 0; bj < 2; ++bj)
#pragma unroll
                    for (int n = 0; n < 2; ++n) *(f32x4*)(C + off + bj * HALF + n * 16) = *(const f32x4*)(base + off + bj * HALF + n * 16) + acc[ai][bj][m][n]; }
    }
};
struct EpiSwiglu {
    static constexpr bool PERM = true, AFTER_DRAIN = false;
    const float* b1; bf16_t* act;
    __device__ __forceinline__ void operator()(const f32x4 (&acc)[2][2][4][2], const Unit& un, int wr, int wc, int fr, int fq) const {
        const int e = un.pn >> 3, n8 = un.pn & 7, row0 = un.pm * BM + wr * 64 + fr, col0 = n8 * HALF + wc * 32 + 8 * fq;
        const float* bp = b1 + (size_t)e * 2048 + col0;
        const f32x4 bg0 = *(const f32x4*)(bp), bg1 = *(const f32x4*)(bp + 4), bl0 = *(const f32x4*)(bp + 1024), bl1 = *(const f32x4*)(bp + 1028);
#pragma unroll
        for (int ai = 0; ai < 2; ++ai)
#pragma unroll
            for (int m = 0; m < 4; ++m) {
                f32x4 g0 = acc[ai][0][m][0] + bg0, g1 = acc[ai][0][m][1] + bg1, l0 = acc[ai][1][m][0] + bl0, l1 = acc[ai][1][m][1] + bl1, o0, o1;
#pragma unroll
                for (int j = 0; j < 4; ++j) {
                    const float ga = fminf(g0[j], 7.0f), gb = fminf(g1[j], 7.0f);
                    const float la = fminf(fmaxf(l0[j], -7.0f), 7.0f), lb = fminf(fmaxf(l1[j], -7.0f), 7.0f);
                    o0[j] = (la + 1.0f) * ga * sigmoidf_fast(1.702f * ga); o1[j] = (lb + 1.0f) * gb * sigmoidf_fast(1.702f * gb); }
                u32x4 w; w.x = cvt_pk_bf16(o0[0], o0[1]); w.y = cvt_pk_bf16(o0[2], o0[3]); w.z = cvt_pk_bf16(o1[0], o1[1]); w.w = cvt_pk_bf16(o1[2], o1[3]);
                *(u32x4*)(act + (size_t)(row0 + ai * HALF + m * 16) * 1024 + col0) = w; }
    }
};
struct EpiDown {
    static constexpr bool PERM = true, AFTER_DRAIN = false;
    const float* b2; const float* roww; bf16_t* Y;
    __device__ __forceinline__ void operator()(const f32x4 (&acc)[2][2][4][2], const Unit& un, int wr, int wc, int fr, int fq) const {
        const int e = un.pn >> 2, n4 = un.pn & 3, row0 = un.pm * BM + wr * 64 + fr, col0 = n4 * BM + wc * 32 + 8 * fq;
        const float* bp = b2 + (size_t)e * 1024 + col0;
        f32x4 bv[2][2];
#pragma unroll
        for (int bj = 0; bj < 2; ++bj)
#pragma unroll
            for (int n = 0; n < 2; ++n) bv[bj][n] = *(const f32x4*)(bp + bj * HALF + 4 * n);
#pragma unroll
        for (int ai = 0; ai < 2; ++ai)
#pragma unroll
            for (int m = 0; m < 4; ++m) { const int row = row0 + ai * HALF + m * 16; const float rw = roww[row];
#pragma unroll
                for (int bj = 0; bj < 2; ++bj) { const f32x4 v0 = (acc[ai][bj][m][0] + bv[bj][0]) * rw, v1 = (acc[ai][bj][m][1] + bv[bj][1]) * rw;
                    u32x4 w; w.x = cvt_pk_bf16(v0[0], v0[1]); w.y = cvt_pk_bf16(v0[2], v0[3]); w.z = cvt_pk_bf16(v1[0], v1[1]); w.w = cvt_pk_bf16(v1[2], v1[3]);
                    *(u32x4*)(Y + (size_t)row * 1024 + col0 + bj * HALF) = w; } }
    }
};
struct ListOrder {
    const PG8_LAS unsigned* list;
    __device__ __forceinline__ bool next(int i, Unit& u) const { const unsigned w = (unsigned)__builtin_amdgcn_readfirstlane((int)list[i]); if (w == 0xffffffffu) return false; u.pm = (int)(w & 0xffffu); u.pn = (int)(w >> 16); return true; }
    __device__ __forceinline__ void a_ready(const Unit&) const {}
    __device__ __forceinline__ void done(const Unit&) const {}
};
template <class Epi, class Sched, bool ALIGN_EPI = false, bool SP2 = false>
__device__ __forceinline__ void gemm_phase(PG8_LAS unsigned char* lds, const Gemm g, const Sched& S, const Epi& E) {
    const int tid = threadIdx.x, wid = __builtin_amdgcn_readfirstlane(tid >> 6), lane = tid & 63, wr = wid >> 2, wc = wid & 3, fr = lane & 15, fq = lane >> 4;
    const int K = g.K, nt = K / BK;
    unsigned voffA[2], voffB[2];
#pragma unroll
    for (int i = 0; i < 2; ++i) { int R, C; stage_rc(tid * 16 + i * 8192, R, C); const int Rb = Epi::PERM ? ((R & ~31) + perm32(R & 31)) : R;
        voffA[i] = (unsigned)(R * K + C) * 2u; voffB[i] = (unsigned)(Rb * K + C) * 2u; }
    const size_t kstep = (size_t)(BK * 2);
    const size_t hstep = (size_t)HALF * K * 2;
    const size_t tstep = 2 * hstep;
    const unsigned ldsw = (unsigned)wid * 1024u;
    const int aoff = lds_byte(wr * 64 + fr, fq * 8), boff = lds_byte(wc * 32 + fr, fq * 8);
#define PG8_SA(b, h) (((b) * 2 + (h)) * HTB)
#define PG8_SB(b, h) ((4 + (b) * 2 + (h)) * HTB)
#define PG8_STAGE(bufoff, gbase, voff) do { _Pragma("unroll") for (int _i = 0; _i < 2; ++_i) \
        __builtin_amdgcn_global_load_lds((const unsigned*)((const char*)(gbase) + (voff)[_i]), (PG8_LAS unsigned*)(lds + (bufoff) + ldsw + _i * 8192), 16, 0, 0); } while (0)
#define PG8_LDA(dst, b, h) do { _Pragma("unroll") for (int m = 0; m < 4; ++m) _Pragma("unroll") for (int k = 0; k < 2; ++k) dst[m][k] = *(const PG8_LAS bf16x8*)(lds + PG8_SA(b, h) + aoff + m * 2048 + k * 1024); } while (0)
#define PG8_LDB(dst, b, h) do { _Pragma("unroll") for (int n = 0; n < 2; ++n) _Pragma("unroll") for (int k = 0; k < 2; ++k) dst[n][k] = *(const PG8_LAS bf16x8*)(lds + PG8_SB(b, h) + boff + n * 2048 + k * 1024); } while (0)
#define PG8_MMA(ai, bj, At, Bt) do { __builtin_amdgcn_s_setprio(1); _Pragma("unroll") for (int m = 0; m < 4; ++m) _Pragma("unroll") for (int n = 0; n < 2; ++n) _Pragma("unroll") for (int k = 0; k < 2; ++k) \
        acc[ai][bj][m][n] = __builtin_amdgcn_mfma_f32_16x16x32_bf16(Bt[n][k], At[m][k], acc[ai][bj][m][n], 0, 0, 0); __builtin_amdgcn_s_setprio(0); } while (0)
#define PG8_WAIT_V(n) asm volatile("s_waitcnt vmcnt(" #n ")" ::: "memory")
#define PG8_WAIT_L(n) asm volatile("s_waitcnt lgkmcnt(" #n ")" ::: "memory")
#define PG8_BAR __builtin_amdgcn_s_barrier()
#define PG8_SCHED __builtin_amdgcn_sched_barrier(0)
    Unit cur, nxt; int ui = 0;
    if (!S.next(0, cur)) return;
    f32x4 acc[2][2][4][2];
#pragma unroll
    for (int a = 0; a < 2; ++a)
#pragma unroll
        for (int b = 0; b < 2; ++b)
#pragma unroll
            for (int m = 0; m < 4; ++m)
#pragma unroll
                for (int n = 0; n < 2; ++n) acc[a][b][m][n] = (f32x4){0.f, 0.f, 0.f, 0.f};
    bf16x8 At[4][2], B0[2][2], B1[2][2];
    const char* cA = (const char*)g.A + (size_t)cur.pm * tstep; const char* cB = (const char*)g.Bt + (size_t)cur.pn * tstep;
    S.a_ready(cur);
    if constexpr (SP2) {
        PG8_STAGE(PG8_SB(0, 0), cB, voffB); PG8_STAGE(PG8_SB(0, 1), cB + hstep, voffB); PG8_STAGE(PG8_SA(0, 0), cA, voffA); PG8_STAGE(PG8_SA(0, 1), cA + hstep, voffA);
        if (wr == 1) PG8_BAR;
        PG8_WAIT_V(2); PG8_BAR;
        PG8_STAGE(PG8_SB(1, 0), cB + kstep, voffB); PG8_STAGE(PG8_SA(1, 0), cA + kstep, voffA); PG8_STAGE(PG8_SB(1, 1), cB + hstep + kstep, voffB);
        PG8_WAIT_V(6); PG8_BAR;
    } else {
        PG8_STAGE(PG8_SB(0, 0), cB, voffB); PG8_STAGE(PG8_SA(0, 0), cA, voffA); PG8_STAGE(PG8_SB(0, 1), cB + hstep, voffB); PG8_STAGE(PG8_SA(0, 1), cA + hstep, voffA);
        if (wr == 1) PG8_BAR;
        PG8_WAIT_V(4); PG8_BAR;
        PG8_STAGE(PG8_SB(1, 0), cB + kstep, voffB); PG8_STAGE(PG8_SA(1, 0), cA + kstep, voffA); PG8_STAGE(PG8_SB(1, 1), cB + hstep + kstep, voffB);
        PG8_WAIT_V(6); PG8_BAR;
    }
    for (;;) {
        const bool has_next = S.next(ui + 1, nxt);
        const char* nA = has_next ? (const char*)g.A + (size_t)nxt.pm * tstep : cA; const char* nB = has_next ? (const char*)g.Bt + (size_t)nxt.pn * tstep : cB;
        for (int t = 0; t < nt; t += 2) {
            const bool last = (t == nt - 2);
            const char* a1 = cA + (size_t)(t + 1) * kstep;
            const char* a2 = last ? nA : cA + (size_t)(t + 2) * kstep; const char* b2 = last ? nB : cB + (size_t)(t + 2) * kstep;
            const char* a3 = a2 + kstep; const char* b3 = b2 + kstep;
            if (last && has_next) S.a_ready(nxt);
            if constexpr (SP2) {
            PG8_LDB(B0, 0, 0); PG8_LDB(B1, 0, 1); PG8_SCHED; PG8_LDA(At, 0, 0); PG8_STAGE(PG8_SA(1, 1), a1 + hstep, voffA);
            PG8_WAIT_V(8); PG8_WAIT_L(0); PG8_BAR; PG8_MMA(0, 0, At, B0); PG8_MMA(0, 1, At, B1); PG8_BAR; PG8_SCHED;
            PG8_LDA(At, 0, 1); PG8_STAGE(PG8_SB(0, 0), b2, voffB); PG8_STAGE(PG8_SB(0, 1), b2 + hstep, voffB); PG8_STAGE(PG8_SA(0, 0), a2, voffA);
            PG8_WAIT_V(8); PG8_WAIT_L(0); PG8_BAR; PG8_MMA(1, 0, At, B0); PG8_MMA(1, 1, At, B1); PG8_BAR; PG8_SCHED;
            PG8_LDB(B0, 1, 0); PG8_LDB(B1, 1, 1); PG8_SCHED; PG8_LDA(At, 1, 0); PG8_STAGE(PG8_SA(0, 1), a2 + hstep, voffA);
            PG8_WAIT_V(8); PG8_WAIT_L(0); PG8_BAR; PG8_MMA(0, 0, At, B0); PG8_MMA(0, 1, At, B1); PG8_BAR; PG8_SCHED;
            PG8_LDA(At, 1, 1); PG8_STAGE(PG8_SB(1, 0), b3, voffB); PG8_STAGE(PG8_SB(1, 1), b3 + hstep, voffB); PG8_STAGE(PG8_SA(1, 0), a3, voffA);
            PG8_WAIT_V(8); PG8_WAIT_L(0); PG8_BAR; PG8_MMA(1, 0, At, B0); PG8_MMA(1, 1, At, B1); PG8_BAR; PG8_SCHED;
            } else {
            PG8_LDB(B0, 0, 0); PG8_SCHED; PG8_LDA(At, 0, 0); PG8_STAGE(PG8_SA(1, 1), a1 + hstep, voffA);
            PG8_WAIT_L(8); PG8_BAR; PG8_WAIT_L(0); PG8_MMA(0, 0, At, B0); PG8_BAR; PG8_SCHED;
            PG8_LDB(B1, 0, 1); PG8_STAGE(PG8_SB(0, 0), b2, voffB);
            PG8_BAR; PG8_WAIT_L(0); PG8_MMA(0, 1, At, B1); PG8_BAR;
            PG8_LDA(At, 0, 1); PG8_STAGE(PG8_SA(0, 0), a2, voffA);
            PG8_BAR; PG8_WAIT_L(0); PG8_MMA(1, 0, At, B0); PG8_BAR; PG8_SCHED;
            PG8_STAGE(PG8_SB(0, 1), b2 + hstep, voffB);
            PG8_WAIT_V(6); PG8_BAR; PG8_MMA(1, 1, At, B1); PG8_BAR;
            PG8_LDB(B0, 1, 0); PG8_SCHED; PG8_LDA(At, 1, 0); PG8_STAGE(PG8_SA(0, 1), a2 + hstep, voffA);
            PG8_WAIT_L(8); PG8_BAR; PG8_WAIT_L(0); PG8_MMA(0, 0, At, B0); PG8_BAR; PG8_SCHED;
            PG8_LDB(B1, 1, 1); PG8_STAGE(PG8_SB(1, 0), b3, voffB);
            PG8_BAR; PG8_WAIT_L(0); PG8_MMA(0, 1, At, B1); PG8_BAR;
            PG8_LDA(At, 1, 1); PG8_STAGE(PG8_SA(1, 0), a3, voffA);
            PG8_BAR; PG8_WAIT_L(0); PG8_MMA(1, 0, At, B0); PG8_BAR; PG8_SCHED;
            PG8_STAGE(PG8_SB(1, 1), b3 + hstep, voffB);
            PG8_WAIT_V(6); PG8_BAR; PG8_MMA(1, 1, At, B1); PG8_BAR;
            }
        }
        if constexpr (ALIGN_EPI) { if (wr == 0) PG8_BAR; }
        if constexpr (!Epi::AFTER_DRAIN) { E(acc, cur, wr, wc, fr, fq); S.done(cur); }
        if (!has_next) break;
#pragma unroll
        for (int a = 0; a < 2; ++a)
#pragma unroll
            for (int b = 0; b < 2; ++b)
#pragma unroll
                for (int m = 0; m < 4; ++m)
#pragma unroll
                    for (int n = 0; n < 2; ++n) acc[a][b][m][n] = (f32x4){0.f, 0.f, 0.f, 0.f};
        cur = nxt; cA = nA; cB = nB; ++ui;
        if constexpr (ALIGN_EPI) { if (wr == 1) PG8_BAR; }
    }
    PG8_WAIT_V(0);
    if constexpr (!ALIGN_EPI) { if (wr == 0) PG8_BAR; }
    PG8_BAR;
    if constexpr (Epi::AFTER_DRAIN) { E.fused(acc, cur, wr, wc, fr, fq, lds, wid, lane); S.done(cur); }
#undef PG8_SA
#undef PG8_SB
#undef PG8_STAGE
#undef PG8_LDA
#undef PG8_LDB
#undef PG8_MMA
#undef PG8_WAIT_V
#undef PG8_WAIT_L
#undef PG8_BAR
#undef PG8_SCHED
}
}
namespace attn_body {
using bf16=__hip_bfloat16;
using bf16x8=__attribute__((ext_vector_type(8)))short;
using s16x4=__attribute__((ext_vector_type(4)))short;
using f32x16=__attribute__((ext_vector_type(16)))float;
using u32x4=__attribute__((ext_vector_type(4)))unsigned;
constexpr int BATCH=2,NHEAD=8,SEQ=8192,D=64,DM=NHEAD*D,OPITCH=1024;
constexpr int NW=8,QBLK=32,QB=QBLK*NW,KVBLK=64,NQB=SEQ/QB;
__device__ __forceinline__ int crow(int r,int hi){return (r&3)+8*(r>>2)+4*hi;}
#define SBAR() __builtin_amdgcn_sched_barrier(0)
constexpr int NSLOT=3, SLOTB=8192;
constexpr int LDS_K=0, LDS_V=NSLOT*SLOTB, LDS_WS=2*NSLOT*SLOTB, LDS_OST=LDS_WS+NW*64*4, LDS_BYTES=LDS_OST+NW*4096;
constexpr float C2=0.125f*1.4426950408889634f;
__device__ __forceinline__ void glds16(const void*gsrc,unsigned lds_dst){unsigned keep;
  asm volatile("s_mov_b32 %0, m0\n\ts_mov_b32 m0, %2\n\ts_nop 0\n\tglobal_load_lds_dwordx4 %1, off\n\ts_mov_b32 m0, %0":"=&s"(keep):"v"(gsrc),"s"(lds_dst):"memory");}
__device__ __forceinline__ unsigned long long gld8(const unsigned long long*sbase,unsigned voff){unsigned long long r; asm volatile("global_load_dwordx2 %0, %1, %2":"=&v"(r):"v"(voff),"s"(sbase):"memory"); return r;}
typedef float f32x2_t __attribute__((ext_vector_type(2))); typedef __bf16 bf16x2_t __attribute__((ext_vector_type(2)));
__device__ __forceinline__ unsigned cvtpk_s(float lo,float hi){f32x2_t v={lo,hi};bf16x2_t b=__builtin_convertvector(v,bf16x2_t);return __builtin_bit_cast(unsigned,b);}

__device__ __forceinline__ void qkt(f32x16&p0,f32x16&p1,const char*Kslot,const bf16x8*qr,int r32,int hi){
  const f32x16 negm=f32x16{};
  const char*kb=Kslot+hi*1024+r32*16;
  #pragma unroll
  for(int d0=0;d0<4;++d0){
    const bf16x8 b0=*reinterpret_cast<const bf16x8*>(kb+d0*2048);
    const bf16x8 b1=*reinterpret_cast<const bf16x8*>(kb+d0*2048+512);
    if(d0==0){p0=__builtin_amdgcn_mfma_f32_32x32x16_bf16(b0,qr[0],negm,0,0,0);p1=__builtin_amdgcn_mfma_f32_32x32x16_bf16(b1,qr[0],negm,0,0,0);}
    else{p0=__builtin_amdgcn_mfma_f32_32x32x16_bf16(b0,qr[d0],p0,0,0,0);p1=__builtin_amdgcn_mfma_f32_32x32x16_bf16(b1,qr[d0],p1,0,0,0);}}
}
typedef __attribute__((address_space(3))) const char* lds_cptr;
typedef short v4i16_t __attribute__((ext_vector_type(4)));
__device__ __forceinline__ void kload8(bf16x8*kf,lds_cptr kp){
  kf[0]=*(const __attribute__((address_space(3))) bf16x8*)(kp);      kf[1]=*(const __attribute__((address_space(3))) bf16x8*)(kp+512);
  kf[2]=*(const __attribute__((address_space(3))) bf16x8*)(kp+2048); kf[3]=*(const __attribute__((address_space(3))) bf16x8*)(kp+2560);
  kf[4]=*(const __attribute__((address_space(3))) bf16x8*)(kp+4096); kf[5]=*(const __attribute__((address_space(3))) bf16x8*)(kp+4608);
  kf[6]=*(const __attribute__((address_space(3))) bf16x8*)(kp+6144); kf[7]=*(const __attribute__((address_space(3))) bf16x8*)(kp+6656);
}
__device__ __forceinline__ void kload2(bf16x8*kf,lds_cptr kp,int j){ kf[2*j]=*(const __attribute__((address_space(3))) bf16x8*)(kp+j*2048); kf[2*j+1]=*(const __attribute__((address_space(3))) bf16x8*)(kp+j*2048+512); }
__device__ __forceinline__ s16x4 vtr(lds_cptr p){ return __builtin_bit_cast(s16x4,__builtin_amdgcn_ds_read_tr16_b64_v4i16((__attribute__((address_space(3))) v4i16_t*)p)); }
__device__ __forceinline__ void pv(f32x16*o,int vb,bf16x8 pa0,bf16x8 pa1,bf16x8 pa2,bf16x8 pa3){
  #pragma unroll
  for(int d0=0;d0<2;++d0){s16x4 lo[4],hi[4];
    #pragma unroll
    for(int ks=0;ks<4;++ks){
      asm volatile("ds_read_b64_tr_b16 %0,%1 offset:%c2":"=&v"(lo[ks]):"v"(vb),"i"(d0*4096+ks*1024):"memory");
      asm volatile("ds_read_b64_tr_b16 %0,%1 offset:%c2":"=&v"(hi[ks]):"v"(vb),"i"(d0*4096+ks*1024+512):"memory");}
    asm volatile("s_waitcnt lgkmcnt(0)":::"memory");SBAR();
    #define PK(k) (bf16x8){lo[k][0],lo[k][1],lo[k][2],lo[k][3],hi[k][0],hi[k][1],hi[k][2],hi[k][3]}
    o[d0]=__builtin_amdgcn_mfma_f32_32x32x16_bf16(pa0,PK(0),o[d0],0,0,0);
    o[d0]=__builtin_amdgcn_mfma_f32_32x32x16_bf16(pa1,PK(1),o[d0],0,0,0);
    o[d0]=__builtin_amdgcn_mfma_f32_32x32x16_bf16(pa2,PK(2),o[d0],0,0,0);
    o[d0]=__builtin_amdgcn_mfma_f32_32x32x16_bf16(pa3,PK(3),o[d0],0,0,0);
    #undef PK
  }
}
#define MSK(v,w,r) __uint_as_float(__float_as_uint(v)&(unsigned)__builtin_amdgcn_sbfe((int)(w),((r)&3)+8*((r)>>2),1))

__device__ __forceinline__ void attn_unit(int b,int h,int qb,const bf16*Q,const bf16*__restrict__ K,const bf16*__restrict__ V,bf16*O,const unsigned long long*MK,float cshift,char*shm){
  const int tid=threadIdx.x,lane=tid&63,r32=lane&31,hi=lane>>5; const int wid=__builtin_amdgcn_readfirstlane(tid>>6);
  const long rowbase=(long)b*SEQ; const int q0=qb*QB;
  const bf16*Qw=Q+(rowbase+q0+wid*QBLK)*DM+h*D;
  const bf16*Kh=K+rowbase*DM+h*D,*Vh=V+rowbase*DM+h*D;
  const unsigned lds0=(unsigned)(uintptr_t)shm;
  float*wsf=(float*)(shm+LDS_WS)+wid*64;
  const bf16*ksrc=Kh+(long)lane*DM+wid*8;
  const bf16*vsrc=Vh+(long)(16*(wid&3)+(lane>>2))*DM+(wid>>2)*32+(lane&3)*8;
  const unsigned kdst=lds0+LDS_K+wid*1024, vdst=lds0+LDS_V+wid*1024;
  #define DMA_K(t,slot) glds16(ksrc+(long)(t)*KVBLK*DM,(unsigned)__builtin_amdgcn_readfirstlane(kdst+(slot)))
  #define DMA_V(t,slot) glds16(vsrc+(long)(t)*KVBLK*DM,(unsigned)__builtin_amdgcn_readfirstlane(vdst+(slot)))
  const int vb0=(int)(lds0+LDS_V)+((lane>>4)&1)*32+(lane&3)*8+(4*hi+((lane&15)>>2))*64;
  const char*Kbase=shm+LDS_K; bf16x8 kf[8];
  const lds_cptr shm3=(lds_cptr)shm; const lds_cptr kp0=shm3+LDS_K+hi*1024+r32*16; const lds_cptr vp0=shm3+LDS_V+((lane>>4)&1)*32+(lane&3)*8+(4*hi+((lane&15)>>2))*64;
  const int NT=(q0+QB)/KVBLK;
  const unsigned long long*mbase=MK+(size_t)b*(SEQ/KVBLK)*SEQ; const unsigned moff=(unsigned)(q0+wid*QBLK+r32)*8u;
  DMA_K(0,0);DMA_V(0,0);DMA_K(1,SLOTB);
  bf16x8 qr[4];
  #pragma unroll
  for(int d0=0;d0<4;++d0)qr[d0]=*reinterpret_cast<const bf16x8*>(&Qw[(long)r32*DM+d0*16+hi*8]);
  unsigned long long mC=gld8(mbase,moff), mN=gld8(mbase+SEQ,moff);
  float l_reg=0.f;f32x16 o[2];o[0]=f32x16{};o[1]=f32x16{};const f32x16 negm=f32x16{};
  (void)cshift;
  #define WAIT_BAR(N) asm volatile("s_waitcnt vmcnt(" #N ") lgkmcnt(0)\n\ts_barrier":"+v"(mN),"+v"(mC)::"memory")
  f32x16 pA0,pA1,pB0,pB1;
  int sl_prev=0,sl_cur=0,sl_next=SLOTB;
  #define ROT() do{sl_prev=sl_cur;sl_cur=sl_next;sl_next=(sl_next==(NSLOT-1)*SLOTB)?0:sl_next+SLOTB;}while(0)
  DMA_K(2,2*SLOTB);
  WAIT_BAR(3);
  qkt(pA0,pA1,Kbase,qr,r32,hi);asm volatile("s_nop 15\n\ts_nop 7":"+v"(pA0),"+v"(pA1));
  _Pragma("unroll") for(int r=0;r<16;++r){pA0[r]=__builtin_amdgcn_exp2f(pA0[r]);pA1[r]=__builtin_amdgcn_exp2f(pA1[r]);}
  WAIT_BAR(0);
  { const unsigned ma_=(unsigned)mC>>(4*hi), mb_=(unsigned)(mC>>32)>>(4*hi);
    _Pragma("unroll") for(int r=0;r<16;++r){pA0[r]=MSK(pA0[r],ma_,r);pA1[r]=MSK(pA1[r],mb_,r);} }
  DMA_K(3,0);DMA_V(1,SLOTB);
  ROT();
  kload8(kf,kp0+sl_cur);
  WAIT_BAR(2);
  s16x4 vlo[8],vhi[8]; u32x4 pw0,pw1,pw2,pw3;
  #define PKW(P,B) cvtpk_s(P[B],P[B+1])
  #define PAF(k) __builtin_bit_cast(bf16x8,pw##k)
  #define VFR(i) (bf16x8){vlo[i][0],vlo[i][1],vlo[i][2],vlo[i][3],vhi[i][0],vhi[i][1],vhi[i][2],vhi[i][3]}
  #define PIN(x) asm volatile("":"+v"(x))
  #define GAPA(MF,A0,A1,A2,A3,W0,W1,PW) do{ MF; sacc+=A0; sacc+=A1; sacc+=A2; sacc+=A3; PIN(sacc); W0; W1; PIN(PW); SBAR(); }while(0)
  #define EX(v) __builtin_amdgcn_exp2f(v)
  #define GAPB(MF,X,B,W) do{ MF; X[B]=MSK(EX(X[B]),W,B); X[B+1]=MSK(EX(X[B+1]),W,B+1); X[B+2]=MSK(EX(X[B+2]),W,B+2); X[B+3]=MSK(EX(X[B+3]),W,B+3); PIN(X); SBAR(); }while(0)
  #define VRD(i) do{ vlo[i]=vtr(vp_+(((i)>>2)*4096+((i)&3)*1024)); vhi[i]=vtr(vp_+(((i)>>2)*4096+((i)&3)*1024+512)); }while(0)
  #define KRD(G,j) do{ if(G){ kload2(kf,kp0+sl_next,j); SBAR(); } }while(0)
  #define STEP(C0,C1,P0,P1,t,GK,GV,GL) do{ SBAR(); \
    const unsigned ma_=(unsigned)mN>>(4*hi), mb_=(unsigned)(mN>>32)>>(4*hi); \
    if((t)+1<NT){ mN=gld8(mbase+(size_t)((t)+1)*SEQ,moff); } \
    const lds_cptr vp_=vp0+sl_prev; \
    VRD(0); SBAR(); float sacc=(P0[0]+P0[1]); \
    GAPA(C0=__builtin_amdgcn_mfma_f32_32x32x16_bf16(kf[0],qr[0],negm,0,0,0), P0[2],P0[3],P0[4],P0[5],     pw0[0]=PKW(P0,0), pw0[1]=PKW(P0,2), pw0); \
    VRD(4); SBAR(); GAPA(C1=__builtin_amdgcn_mfma_f32_32x32x16_bf16(kf[1],qr[0],negm,0,0,0), P0[6],P0[7],P0[8],P0[9],     pw0[2]=PKW(P0,4), pw0[3]=PKW(P0,6), pw0); \
    VRD(1); SBAR(); GAPA(C0=__builtin_amdgcn_mfma_f32_32x32x16_bf16(kf[2],qr[1],C0,0,0,0),   P0[10],P0[11],P0[12],P0[13], pw1[0]=PKW(P0,8), pw1[1]=PKW(P0,10), pw1); \
    VRD(5); SBAR(); GAPA(C1=__builtin_amdgcn_mfma_f32_32x32x16_bf16(kf[3],qr[1],C1,0,0,0),   P0[14],P0[15],P1[0],P1[1],   pw1[2]=PKW(P0,12),pw1[3]=PKW(P0,14), pw1); \
    VRD(2); SBAR(); GAPA(C0=__builtin_amdgcn_mfma_f32_32x32x16_bf16(kf[4],qr[2],C0,0,0,0),   P1[2],P1[3],P1[4],P1[5],     pw2[0]=PKW(P1,0), pw2[1]=PKW(P1,2), pw2); \
    VRD(6); SBAR(); GAPA(C1=__builtin_amdgcn_mfma_f32_32x32x16_bf16(kf[5],qr[2],C1,0,0,0),   P1[6],P1[7],P1[8],P1[9],     pw2[2]=PKW(P1,4), pw2[3]=PKW(P1,6), pw2); \
    VRD(3); SBAR(); GAPA(C0=__builtin_amdgcn_mfma_f32_32x32x16_bf16(kf[6],qr[3],C0,0,0,0),   P1[10],P1[11],P1[12],P1[13], pw3[0]=PKW(P1,8), pw3[1]=PKW(P1,10), pw3); \
    VRD(7); SBAR(); GAPA(C1=__builtin_amdgcn_mfma_f32_32x32x16_bf16(kf[7],qr[3],C1,0,0,0),   P1[14],P1[15],0.f,0.f,       pw3[2]=PKW(P1,12),pw3[3]=PKW(P1,14), pw3); \
    l_reg+=sacc; \
    if(GK){DMA_K((t)+3,sl_cur);} if(GV){DMA_V((t)+1,sl_next);} \
    SBAR(); \
    GAPB(o[0]=__builtin_amdgcn_mfma_f32_32x32x16_bf16(PAF(0),VFR(0),o[0],0,0,0), C0,0,ma_); \
    GAPB(o[1]=__builtin_amdgcn_mfma_f32_32x32x16_bf16(PAF(0),VFR(4),o[1],0,0,0), C0,4,ma_); \
    KRD(GL,0); GAPB(o[0]=__builtin_amdgcn_mfma_f32_32x32x16_bf16(PAF(1),VFR(1),o[0],0,0,0), C0,8,ma_); \
    KRD(GL,1); GAPB(o[1]=__builtin_amdgcn_mfma_f32_32x32x16_bf16(PAF(1),VFR(5),o[1],0,0,0), C0,12,ma_); \
    KRD(GL,2); GAPB(o[0]=__builtin_amdgcn_mfma_f32_32x32x16_bf16(PAF(2),VFR(2),o[0],0,0,0), C1,0,mb_); \
    KRD(GL,3); GAPB(o[1]=__builtin_amdgcn_mfma_f32_32x32x16_bf16(PAF(2),VFR(6),o[1],0,0,0), C1,4,mb_); \
    GAPB(o[0]=__builtin_amdgcn_mfma_f32_32x32x16_bf16(PAF(3),VFR(3),o[0],0,0,0), C1,8,mb_); \
    GAPB(o[1]=__builtin_amdgcn_mfma_f32_32x32x16_bf16(PAF(3),VFR(7),o[1],0,0,0), C1,12,mb_); \
    }while(0)
  int t=1;
  for(;t+5<NT;t+=2){
    STEP(pB0,pB1,pA0,pA1,t,true,true,true);     WAIT_BAR(2); ROT();
    STEP(pA0,pA1,pB0,pB1,t+1,true,true,true);   WAIT_BAR(2); ROT();
  }
  #define ENDW(tt) do{ if((tt)+3<NT){WAIT_BAR(2);} else if((tt)+2<NT){WAIT_BAR(1);} else {WAIT_BAR(0);} }while(0)
  for(;t+1<NT;t+=2){
    STEP(pB0,pB1,pA0,pA1,t,(t+3<NT),(t+1<NT),(t+1<NT));       ENDW(t);   ROT();
    STEP(pA0,pA1,pB0,pB1,t+1,(t+4<NT),(t+2<NT),(t+2<NT));     ENDW(t+1); ROT();
  }
  STEP(pB0,pB1,pA0,pA1,NT-1,false,false,false);
  { float sacc=pB0[0]+pB0[1]; _Pragma("unroll") for(int r=2;r<16;++r)sacc+=pB0[r]; _Pragma("unroll") for(int r=0;r<16;++r)sacc+=pB1[r]; l_reg+=sacc;
    pw0=(u32x4){PKW(pB0,0),PKW(pB0,2),PKW(pB0,4),PKW(pB0,6)};pw1=(u32x4){PKW(pB0,8),PKW(pB0,10),PKW(pB0,12),PKW(pB0,14)};pw2=(u32x4){PKW(pB1,0),PKW(pB1,2),PKW(pB1,4),PKW(pB1,6)};pw3=(u32x4){PKW(pB1,8),PKW(pB1,10),PKW(pB1,12),PKW(pB1,14)};
    SBAR(); pv(o,vb0+sl_cur,PAF(0),PAF(1),PAF(2),PAF(3)); }
  #undef PKW
  #undef PAF
  #undef VFR
  #undef PIN
  #undef GAPA
  #undef GAPB
  #undef EX
  #undef VRD
  #undef KRD
  #undef STEP
  #undef ENDW
  {auto rr=__builtin_amdgcn_permlane32_swap(__float_as_uint(l_reg),__float_as_uint(l_reg),false,false);l_reg=__uint_as_float(rr[0])+__uint_as_float(rr[1]);}
  if(hi==0)wsf[32+r32]=l_reg;asm volatile("s_waitcnt lgkmcnt(0)":::"memory");
  float rli[16];
  #pragma unroll
  for(int r=0;r<16;++r)rli[r]=__builtin_amdgcn_rcpf(wsf[32+crow(r,hi)]);
  bf16*Ow=O+(rowbase+q0+wid*QBLK)*OPITCH+h*D;
  { bf16*stg=(bf16*)(shm+LDS_OST)+wid*2048;
    #pragma unroll
    for(int r=0;r<16;++r){const int orow=crow(r,hi);
      #pragma unroll
      for(int d0=0;d0<2;++d0)stg[orow*64+d0*32+r32]=__float2bfloat16(o[d0][r]*rli[r]);}
    asm volatile("s_waitcnt lgkmcnt(0)":::"memory");
    #pragma unroll
    for(int i=0;i<4;++i){const int row=i*8+(lane>>3),ch=lane&7; const u32x4 v=*(const u32x4*)(stg+row*64+ch*8); *(u32x4*)(Ow+(long)row*OPITCH+ch*8)=v;} }
  asm volatile("s_waitcnt lgkmcnt(0)\n\ts_barrier":::"memory");
  #undef DMA_K
  #undef DMA_V
  #undef ROT
  #undef WAIT_BAR
}
#undef MSK
constexpr int ATTN_LDS_BYTES=LDS_BYTES;
#undef SBAR
}
#define XB_TMO      128
#define XB_XCNT(j)  (256  + 64 * (j))
#define XB_XSUB(j)  (1280 + 64 * (j))
#define XB_XGEN(j)  (2304 + 64 * (j))
#define XB_TOP      3328
#define XB_TOPGEN   3392
#define XCD_BAR_WORDS 3456
#define XB_SPIN_CAP (1u << 18)

__device__ __forceinline__ unsigned xb_ld(unsigned* p)              { return __hip_atomic_load(p, __ATOMIC_RELAXED, __HIP_MEMORY_SCOPE_AGENT); }
__device__ __forceinline__ unsigned xb_add(unsigned* p, unsigned v) { return __hip_atomic_fetch_add(p, v, __ATOMIC_RELAXED, __HIP_MEMORY_SCOPE_AGENT); }
__device__ __forceinline__ unsigned xb_xcc_id() { return (unsigned)__builtin_amdgcn_s_getreg((3 << 11) | 20) & 0xFu; }
#define XB_SPIN(cond, bar) do { unsigned _sp = 0; while (cond) { __builtin_amdgcn_s_sleep(1); \
    if ((++_sp & 255u) == 0u) { if (xb_ld(&(bar)[XB_TMO])) break; if (_sp > XB_SPIN_CAP) { atomicAdd(&(bar)[XB_TMO], 1u); break; } } } } while (0)

struct XcdBarrier {
    unsigned* bar; unsigned x;
    volatile LAS unsigned* st;
};

__device__ __forceinline__ XcdBarrier xcd_barrier_post(unsigned* bar, volatile LAS unsigned* st) {
    XcdBarrier b; b.bar = bar; b.x = xb_xcc_id(); b.st = st;
    if (threadIdx.x == 0) (void)xb_add(&bar[XB_XCNT(b.x)], 1u);
    return b;
}
__device__ __forceinline__ void xcd_barrier_complete(unsigned* bar, unsigned x, unsigned& nloc, unsigned& nx) {
    const unsigned G = gridDim.x * gridDim.y * gridDim.z;
    unsigned sum, cnt, mine, sp = 0u;
    for (;;) {
        sum = 0u; cnt = 0u; mine = 0u;
#pragma unroll
        for (unsigned j = 0; j < 16; ++j) { const unsigned c = xb_ld(&bar[XB_XCNT(j)]); sum += c; cnt += (c > 0u) ? 1u : 0u; mine = (j == x) ? c : mine; }
        if (sum == G) break;
        __builtin_amdgcn_s_sleep(1);
        if ((++sp & 255u) == 0u) { if (xb_ld(&bar[XB_TMO])) break; if (sp > XB_SPIN_CAP) { atomicAdd(&bar[XB_TMO], 1u); break; } }
    }
    nloc = mine > 0u ? mine : 1u; nx = cnt > 0u ? cnt : 1u;
}

__device__ __forceinline__ void xcd_barrier(const XcdBarrier& b) {
    asm volatile("s_waitcnt vmcnt(0)" ::: "memory");
    __syncthreads();
    if (threadIdx.x == 0) {
        unsigned* bar = b.bar;
        __builtin_amdgcn_s_waitcnt(0);
        unsigned nloc = b.st[0], nx = b.st[1];
        if (nloc == 0u) { xcd_barrier_complete(bar, b.x, nloc, nx); b.st[0] = nloc; b.st[1] = nx; }
        const unsigned old = xb_add(&bar[XB_XSUB(b.x)], 1u);
        const unsigned gen = old / nloc;
        if (old + 1u == (gen + 1u) * nloc) {
            __builtin_amdgcn_fence(__ATOMIC_RELEASE, "agent");
            asm volatile("s_waitcnt vmcnt(0)" ::: "memory");
            const unsigned og = xb_add(&bar[XB_TOP], 1u);
            const unsigned tg = og / nx;
            if (og + 1u == (tg + 1u) * nx) xb_add(&bar[XB_TOPGEN], 1u);
            else XB_SPIN(xb_ld(&bar[XB_TOPGEN]) == tg, bar);
            __builtin_amdgcn_fence(__ATOMIC_ACQUIRE, "agent");
            xb_add(&bar[XB_XGEN(b.x)], 1u);
            asm volatile("s_waitcnt vmcnt(0)" ::: "memory");
        } else {
            XB_SPIN(xb_ld(&bar[XB_XGEN(b.x)]) == gen, bar);
            __builtin_amdgcn_fence(__ATOMIC_ACQUIRE, "agent");
            asm volatile("s_waitcnt vmcnt(0)" ::: "memory");
        }
    }
    __syncthreads();
}
struct Frame {
    LAS unsigned char* lds;
    volatile LAS unsigned* MISC;
    gu32* ctl;
    int tid, lane, wave;
    int vcu, G;
    unsigned char* ws;
    const float* in[18]; float* out;
};
__device__ __forceinline__ float wave_sum(float v) {
#pragma unroll
    for (int o = 1; o < 64; o <<= 1) v += __shfl_xor(v, o);
    return v;
}
__device__ __forceinline__ float wave_max(float v) {
#pragma unroll
    for (int o = 1; o < 64; o <<= 1) v = fmaxf(v, __shfl_xor(v, o));
    return v;
}
template <int MODE> __device__ __forceinline__ int tr_row(int n) {
    if (MODE == 0) return n < 1860 ? n : n + 188;
    if (MODE == 1) return n < 1024 ? 256 * (n >> 7) + (n & 127) : 256 * ((n - 1024) >> 7) + 128 + ((n - 1024) & 127);
    if (MODE == 4) return 256 * (n >> 7) + (n & 127);
    if (MODE == 5) return 256 * (n >> 7) + 128 + (n & 127);
    return n;
}
template <int MODE> __device__ __forceinline__ void tr_item(const float* W, int N, bf16* WT, int ldt, int koff, LAS float* scr, int kb, int nb, int lane) {
    const int k0 = 64 * kb, n0 = 32 * nb; const bool colok = (n0 + (lane & 31)) < N;
#pragma unroll 8
    for (int i = 0; i < 32; ++i) { const int kk = 2 * i + (lane >> 5); scr[kk * 33 + (lane & 31)] = colok ? W[(size_t)(k0 + kk) * N + n0 + (lane & 31)] : 0.f; }
    LDS_WAIT(); asm volatile("" ::: "memory");
    const int c = lane & 7;
#pragma unroll
    for (int j = 0; j < 4; ++j) { const int n = (lane >> 3) + 8 * j; const LAS float* s = scr + (8 * c) * 33 + n;
        v4u o; o.x = pk2(s[0 * 33], s[1 * 33]); o.y = pk2(s[2 * 33], s[3 * 33]); o.z = pk2(s[4 * 33], s[5 * 33]); o.w = pk2(s[6 * 33], s[7 * 33]);
        if (n0 + n < N) *(GAS v4u*)(WT + (size_t)tr_row<MODE>(n0 + n) * ldt + koff + k0 + 8 * c) = o; }
    LDS_WAIT(); asm volatile("" ::: "memory");
}
__device__ __forceinline__ void rms_row_to_bf16(const float* xrow, const float* g, bf16* orow, int lane) {
    const GAS f32x4* xr = (const GAS f32x4*)xrow + lane; const GAS f32x4* gr = (const GAS f32x4*)g + lane;
    f32x4 v[4]; float s = 0.f;
#pragma unroll
    for (int j = 0; j < 4; ++j) { v[j] = xr[64 * j]; s += (v[j].x * v[j].x + v[j].y * v[j].y) + (v[j].z * v[j].z + v[j].w * v[j].w); }
    const float r = 1.0f / sqrtf(wave_sum(s) * (1.f / 1024.f) + EPS);
    GAS unsigned long long* o8 = (GAS unsigned long long*)orow + lane;
#pragma unroll
    for (int j = 0; j < 4; ++j) { const f32x4 gv = gr[64 * j]; o8[64 * j] = (unsigned long long)pk2(v[j].x * r * gv.x, v[j].y * r * gv.y) | ((unsigned long long)pk2(v[j].z * r * gv.z, v[j].w * r * gv.w) << 32); }
}
__device__ __forceinline__ void p0_prologue(Frame& F) {
    LAS float* scr = (LAS float*)(F.lds + RING_OFF + F.wave * 16384);
    const int gw = F.vcu * NWAVES + F.wave, NGW = F.G * NWAVES;
    bf16* Win_t = (bf16*)(F.ws + WS_WIN); bf16* Wab_t = (bf16*)(F.ws + WS_WAB); bf16* Wout_t = (bf16*)(F.ws + WS_WOUT); bf16* Wpool_t = (bf16*)(F.ws + WS_WPOOL);
    bf16* W1_t = (bf16*)(F.ws + WS_W1); bf16* W2_t = (bf16*)(F.ws + WS_W2);
    constexpr int I_W1 = 32 * 16 * 64, I_W2 = 32 * 16 * 32, I_IN = 16 * 139, I_OUT = 16 * 32, I_WA = 8 * 32, I_WB = 8 * 32, I_POOL = 32;
    constexpr int NITEMS = I_W1 + I_W2 + I_IN + I_OUT + I_WA + I_WB + I_POOL;
    for (int it = gw; it < NITEMS; it += NGW) {
        int r = it;
        if (r < I_W1) { const int e = r >> 10, rr = r & 1023; tr_item<1>(F.in[14] + (size_t)e * 1024 * 2048, 2048, W1_t + (size_t)e * 2048 * 1024, 1024, 0, scr, rr >> 6, rr & 63, F.lane); continue; } r -= I_W1;
        if (r < I_W2) { const int e = r >> 9, rr = r & 511; tr_item<2>(F.in[16] + (size_t)e * 1024 * 1024, 1024, W2_t + (size_t)e * 1024 * 1024, 1024, 0, scr, rr >> 5, rr & 31, F.lane); continue; } r -= I_W2;
        if (r < I_IN) { tr_item<0>(F.in[2], NIN, Win_t, 1024, 0, scr, r / 139, r % 139, F.lane); continue; } r -= I_IN;
        if (r < I_OUT) { tr_item<2>(F.in[10], 1024, Wout_t, 1024, 0, scr, r >> 5, r & 31, F.lane); continue; } r -= I_OUT;
        if (r < I_WA) { tr_item<4>(F.in[8], 1024, Wab_t, 1024, 0, scr, r >> 5, r & 31, F.lane); continue; } r -= I_WA;
        if (r < I_WB) { tr_item<5>(F.in[9], 1024, Wab_t, 1024, 512, scr, r >> 5, r & 31, F.lane); continue; } r -= I_WB;
        { const int g = r >> 3, rr = r & 7; tr_item<2>(F.in[5] + (size_t)g * 128 * 128, 128, Wpool_t + (size_t)(128 * g) * 512, 512, 128 * g, scr, rr >> 2, rr & 3, F.lane); }
    }
    const int gt = F.vcu * (NWAVES * 64) + F.tid, NGT = F.G * NWAVES * 64; const v4u z = {0u, 0u, 0u, 0u};
    for (int i = gt; i < 2048 * 64; i += NGT) { const int row = i >> 6, ch = i & 63; *(GAS v4u*)(Wab_t + (size_t)row * 1024 + (((row & 255) < 128) ? 512 : 0) + ch * 8) = z; }
    for (int i = gt; i < 512 * 64; i += NGT) { const int row = i >> 6, ch = i & 63; if ((ch >> 4) != (row >> 7)) *(GAS v4u*)(Wpool_t + (size_t)row * 512 + ch * 8) = z; }
    for (int i = gt; i < 188 * 128; i += NGT) { const int row = 1860 + (i >> 7), ch = i & 127; *(GAS v4u*)(Win_t + (size_t)row * 1024 + ch * 8) = z; }
    bf16* H = (bf16*)(F.ws + WS_H);
    for (int m = gw; m < M; m += NGW) rms_row_to_bf16(F.in[0] + (size_t)m * 1024, F.in[1], H + (size_t)m * 1024, F.lane);
}
__device__ __forceinline__ void qknorm_rows(Frame& F, bool dry = false) {
    const int gw = F.vcu * NWAVES + F.wave, NGW = F.G * NWAVES, lane = F.lane;
    bf16* Q = (bf16*)(F.ws + WS_Q); bf16* K = (bf16*)(F.ws + WS_K);
    const int d0 = (lane & 7) * 8;
    float gq[8], gk[8];
#pragma unroll
    for (int j = 0; j < 8; ++j) { gq[j] = F.in[3][d0 + j] * attn_body::C2; gk[j] = F.in[4][d0 + j]; }
    for (int m0 = gw; m0 < 2 * M; m0 += 4 * NGW) {
        v4u w[4]; bf16* p[4]; bool isq[4];
#pragma unroll
        for (int u = 0; u < 4; ++u) { const int m = m0 + u * NGW; isq[u] = m < M; p[u] = (isq[u] ? Q + (size_t)m * 512 : K + (size_t)(m - M) * 512) + lane * 8; w[u] = (m < 2 * M) ? *(const GAS v4u*)p[u] : (v4u){0u, 0u, 0u, 0u}; }
#pragma unroll
        for (int u = 0; u < 4; ++u) { if (m0 + u * NGW >= 2 * M) break;
            float x[8] = {bflo(w[u].x), bfhi(w[u].x), bflo(w[u].y), bfhi(w[u].y), bflo(w[u].z), bfhi(w[u].z), bflo(w[u].w), bfhi(w[u].w)};
            float s = 0.f;
#pragma unroll
            for (int j = 0; j < 8; ++j) s += x[j] * x[j];
            s += __shfl_xor(s, 1); s += __shfl_xor(s, 2); s += __shfl_xor(s, 4);
            const float r = 1.0f / sqrtf(s * (1.f / 64.f) + EPS);
#pragma unroll
            for (int j = 0; j < 8; ++j) x[j] = x[j] * r * (isq[u] ? gq[j] : gk[j]);
            v4u o; o.x = pk2(x[0], x[1]); o.y = pk2(x[2], x[3]); o.z = pk2(x[4], x[5]); o.w = pk2(x[6], x[7]);
            *(GAS v4u*)p[u] = dry ? w[u] : o; }
    }
}
__device__ __forceinline__ void pool_diff_rows(Frame& F) {
    const int gw = F.vcu * NWAVES + F.wave, NGW = F.G * NWAVES, lane = F.lane;
    const bf16* U = (const bf16*)(F.ws + WS_U); bf16* Dd = (bf16*)(F.ws + WS_DIFF);
    const int win = 2 << (lane >> 4);
    for (int m = gw; m < M; m += NGW) {
        const int t = m & (SEQ - 1); const int cnt = (t + 1 < win) ? t + 1 : win;
        v4u w[16];
#pragma unroll
        for (int j = 0; j < 16; ++j) w[j] = (j < cnt) ? *(const GAS v4u*)(U + (size_t)(m - j) * 512 + lane * 8) : (v4u){0u, 0u, 0u, 0u};
        float a[8] = {0.f, 0.f, 0.f, 0.f, 0.f, 0.f, 0.f, 0.f};
#pragma unroll
        for (int j = 0; j < 16; ++j) { a[0] += bflo(w[j].x); a[1] += bfhi(w[j].x); a[2] += bflo(w[j].y); a[3] += bfhi(w[j].y); a[4] += bflo(w[j].z); a[5] += bfhi(w[j].z); a[6] += bflo(w[j].w); a[7] += bfhi(w[j].w); }
        const float inv = 1.0f / (float)cnt; v4u o;
        o.x = pk2(a[0] * inv - bflo(w[0].x), a[1] * inv - bfhi(w[0].x)); o.y = pk2(a[2] * inv - bflo(w[0].y), a[3] * inv - bfhi(w[0].y));
        o.z = pk2(a[4] * inv - bflo(w[0].z), a[5] * inv - bfhi(w[0].z)); o.w = pk2(a[6] * inv - bflo(w[0].w), a[7] * inv - bfhi(w[0].w));
        *(GAS v4u*)(Dd + (size_t)m * 512 + lane * 8) = o;
    }
}
__device__ __forceinline__ int tk_fidx(int q) { return (((q >> 3) * 2 + (q & 1)) * 4) + ((q & 7) >> 1); }
__device__ __forceinline__ float relu_f(float x) { const int b = __builtin_bit_cast(int, x); return __builtin_bit_cast(float, b > 0 ? b : 0); }
__device__ __forceinline__ unsigned wave_incl_scan(unsigned v, int lane) {
    v += (unsigned)__builtin_amdgcn_update_dpp(0, (int)v, 0x111, 0xf, 0xf, false);
    v += (unsigned)__builtin_amdgcn_update_dpp(0, (int)v, 0x112, 0xf, 0xf, false);
    v += (unsigned)__builtin_amdgcn_update_dpp(0, (int)v, 0x114, 0xf, 0xf, false);
    v += (unsigned)__builtin_amdgcn_update_dpp(0, (int)v, 0x118, 0xf, 0xf, false);
    const unsigned t0 = (unsigned)__builtin_amdgcn_readlane((int)v, 15), t1 = (unsigned)__builtin_amdgcn_readlane((int)v, 31), t2 = (unsigned)__builtin_amdgcn_readlane((int)v, 47);
    return v + (lane >= 16 ? t0 : 0u) + (lane >= 32 ? t1 : 0u) + (lane >= 48 ? t2 : 0u);
}
template <bool BINS32, bool FINAL, int BITS> __device__ __forceinline__ void topk_scan(LAS unsigned* hist, LAS unsigned* pfx, LAS unsigned* lbnd, LAS unsigned* need, LAS unsigned* neq, int wave, int lane) {
    for (int qq = 0; qq < 4; ++qq) {
        const int q = 4 * wave + qq; LAS unsigned* hq = hist + q * 1024; const int base = 1024 - (lane + 1) * 16;
        unsigned d[16];
#pragma unroll
        for (int i = 0; i < 4; ++i) { const v4u v = *(const LAS v4u*)(hq + base + 4 * i); d[4 * i] = v.x; d[4 * i + 1] = v.y; d[4 * i + 2] = v.z; d[4 * i + 3] = v.w;
            if (FINAL) *(LAS v4u*)(hq + base + 4 * i) = (v4u){0u, 0u, 0u, 0u}; }
        unsigned s = 0u;
#pragma unroll
        for (int i = 0; i < 16; ++i) s += BINS32 ? d[i] : ((d[i] & 0xffffu) + (d[i] >> 16));
        const unsigned inc = wave_incl_scan(s, lane);
        const unsigned nd = FINAL ? need[q] : (unsigned)TOPK;
        const unsigned long long bal = __ballot(inc >= nd);
        if (!FINAL && bal == 0ull) continue;
        const int Ls = __builtin_amdgcn_readfirstlane(bal ? (int)__ffsll((long long)bal) - 1 : 63);
        unsigned run = inc - s, fpos = 0u, fneed = 1u, fcnt = 1u; bool found = false;
#pragma unroll
        for (int i = 15; i >= 0; --i) {
            if (BINS32) { const unsigned c = d[i]; if (!found && run + c >= nd) { found = true; fpos = (unsigned)i; fneed = nd - run; fcnt = c; } run += c; }
            else { const unsigned chi = d[i] >> 16, clo = d[i] & 0xffffu;
                if (!found && run + chi >= nd) { found = true; fpos = 2u * i + 1u; fneed = nd - run; fcnt = chi; } run += chi;
                if (!found && run + clo >= nd) { found = true; fpos = 2u * i; fneed = nd - run; fcnt = clo; } run += clo; }
        }
        unsigned fbin = (BINS32 ? (unsigned)base : 2u * (unsigned)base) + fpos;
        fbin = (unsigned)__builtin_amdgcn_readlane((int)fbin, Ls); fneed = (unsigned)__builtin_amdgcn_readlane((int)fneed, Ls); fcnt = (unsigned)__builtin_amdgcn_readlane((int)fcnt, Ls);
        if (lane == 0) { const int fi = tk_fidx(q);
            if (FINAL) { pfx[fi] = BINS32 ? fbin : ((pfx[fi] << BITS) | fbin); need[q] = fneed; neq[q] = fcnt; } else lbnd[fi] = fbin; }
    }
}
template <int PASS> __device__ __forceinline__ void topk_pass(const bf16x8 (&af)[4][4], const LAS f32x4* wl4, const bf16* IKb, int nb, LAS unsigned* hist, LAS unsigned* pfx, LAS unsigned* lbnd, LAS unsigned* need, LAS unsigned* neq, int wave, int lane) {
    const int hi = lane >> 5, n32 = lane & 31;
    LAS unsigned* GT = hist; LAS unsigned* EQ = hist + 32 * 257;
    const bf16* kp0 = IKb + (size_t)lane * 8;
    bf16x8 bc[4], bn[4]; unsigned dummy = 0u;
    if (wave < nb) {
#pragma unroll
        for (int kk = 0; kk < 4; ++kk) bn[kk] = *(const GAS bf16x8*)(kp0 + (size_t)wave * 2048 + 512 * kk); }
    int it = 0;
    for (int blk = wave; blk < nb; blk += 8, ++it) {
#pragma unroll
        for (int kk = 0; kk < 4; ++kk) bc[kk] = bn[kk];
        if (blk + 8 < nb) {
#pragma unroll
            for (int kk = 0; kk < 4; ++kk) bn[kk] = *(const GAS bf16x8*)(kp0 + (size_t)(blk + 8) * 2048 + 512 * kk); }
        const LAS v4u* pfl = (const LAS v4u*)(PASS == 0 ? lbnd : pfx);
        f32x4 wq[2][4]; v4u pfq[2];
#define TK_LDW(dst, qg) do { _Pragma("unroll") for (int jj = 0; jj < 4; ++jj) wq[dst][jj] = wl4[((qg) * 2 + hi) * 4 + jj]; pfq[dst] = pfl[(qg) * 2 + hi]; } while (0)
        TK_LDW(0, 0);
        f32x16 acc[2];
#define TK_MMA(dst, qg) do { dst = f32x16{}; _Pragma("unroll") for (int kk = 0; kk < 4; ++kk) dst = __builtin_amdgcn_mfma_f32_32x32x16_bf16(af[qg][kk], bc[kk], dst, 0, 0, 0); } while (0)
        TK_MMA(acc[0], 0);
#pragma unroll
        for (int qg = 0; qg < 4; ++qg) {
            if (qg < 3) { TK_MMA(acc[(qg + 1) & 1], qg + 1); TK_LDW((qg + 1) & 1, qg + 1); }
            const f32x16& a = acc[qg & 1]; const v4u pfv = pfq[qg & 1];
            if (PASS == 4) { dummy ^= __float_as_uint(a[0]) ^ __float_as_uint(a[5]) ^ pfv[0] ^ __float_as_uint(wq[qg & 1][0][0]); continue; }
            unsigned long long bg[4], be[4]; unsigned long long anye = 0ull;
#define TK_PIN4(x) asm volatile("" : "+v"(x[0]), "+v"(x[1]), "+v"(x[2]), "+v"(x[3]))
            float sc[4], r0[4], r1[4], r2[4], r3[4]; unsigned key[4], sg[4];
#pragma unroll
            for (int jj = 0; jj < 4; ++jj) { r0[jj] = relu_f(a[4 * jj + 0]); r1[jj] = relu_f(a[4 * jj + 1]); r2[jj] = relu_f(a[4 * jj + 2]); r3[jj] = relu_f(a[4 * jj + 3]); }
            TK_PIN4(r0); TK_PIN4(r1); TK_PIN4(r2); TK_PIN4(r3);
#pragma unroll
            for (int jj = 0; jj < 4; ++jj) sc[jj] = fmaf(wq[qg & 1][jj][0], r0[jj], 0.f);
            TK_PIN4(sc);
#pragma unroll
            for (int jj = 0; jj < 4; ++jj) sc[jj] = fmaf(wq[qg & 1][jj][1], r1[jj], sc[jj]);
            TK_PIN4(sc);
#pragma unroll
            for (int jj = 0; jj < 4; ++jj) sc[jj] = fmaf(wq[qg & 1][jj][2], r2[jj], sc[jj]);
            TK_PIN4(sc);
#pragma unroll
            for (int jj = 0; jj < 4; ++jj) sc[jj] = fmaf(wq[qg & 1][jj][3], r3[jj], sc[jj]);
            TK_PIN4(sc);
#pragma unroll
            for (int jj = 0; jj < 4; ++jj) sg[jj] = (unsigned)((int)__float_as_uint(sc[jj]) >> 31) | 0x80000000u;
            TK_PIN4(sg);
#pragma unroll
            for (int jj = 0; jj < 4; ++jj) key[jj] = __float_as_uint(sc[jj]) ^ sg[jj];
            TK_PIN4(key);
#undef TK_PIN4
            LAS unsigned* hq0 = hist + (8 * qg + hi) * 1024;
            if (PASS == 0) {
#pragma unroll
                for (int jj = 0; jj < 4; ++jj) { const unsigned bin = key[jj] >> 22; if (bin >= pfv[jj]) __hip_atomic_fetch_add(hq0 + jj * 2048 + bin, 1u, __ATOMIC_RELAXED, __HIP_MEMORY_SCOPE_WORKGROUP); } }
            if (PASS == 1) {
#pragma unroll
                for (int jj = 0; jj < 4; ++jj) { if ((key[jj] >> 22) == pfv[jj]) { const unsigned bin = (key[jj] >> 11) & 0x7ffu; __hip_atomic_fetch_add(hq0 + jj * 2048 + (bin >> 1), 1u << ((bin & 1u) * 16u), __ATOMIC_RELAXED, __HIP_MEMORY_SCOPE_WORKGROUP); } } }
            if (PASS == 2) {
#pragma unroll
                for (int jj = 0; jj < 4; ++jj) { if ((key[jj] >> 11) == pfv[jj]) { const unsigned bin = key[jj] & 0x7ffu; __hip_atomic_fetch_add(hq0 + jj * 2048 + (bin >> 1), 1u << ((bin & 1u) * 16u), __ATOMIC_RELAXED, __HIP_MEMORY_SCOPE_WORKGROUP); } } }
            if (PASS == 3) {
#pragma unroll
                for (int jj = 0; jj < 4; ++jj) { bg[jj] = __ballot(key[jj] > pfv[jj]); be[jj] = __ballot(key[jj] == pfv[jj]); anye |= be[jj]; } }
            if (PASS == 3) {
                unsigned vg = 0u, ve = 0u;
#pragma unroll
                for (int jj = 0; jj < 4; ++jj) { vg = (lane == 2 * jj) ? (unsigned)bg[jj] : vg; vg = (lane == 2 * jj + 1) ? (unsigned)(bg[jj] >> 32) : vg;
                                                 ve = (lane == 2 * jj) ? (unsigned)be[jj] : ve; ve = (lane == 2 * jj + 1) ? (unsigned)(be[jj] >> 32) : ve; }
                if (lane < 8) { GT[(8 * qg + lane) * 257 + blk] = vg; if (anye != 0ull) EQ[(8 * qg + lane) * 257 + blk] = ve; }
            }
        }
#undef TK_MMA
#undef TK_LDW
        if (PASS == 4 && it == 1000000) neq[32 + lane] = dummy;
        if (PASS == 0 && (it == 1 || it == 3 || it == 7 || it == 15)) topk_scan<true, false, 10>(hist, pfx, lbnd, need, neq, wave, lane);
    }
}
__device__ __forceinline__ void topk_unit(Frame& F, int b, int c, int half) {
    const bf16* IQ = (const bf16*)(F.ws + WS_IQ); const bf16* IK = (const bf16*)(F.ws + WS_IK); const float* IW = (const float*)(F.ws + WS_IW);
    unsigned long long* MK = (unsigned long long*)(F.ws + WS_MASK);
    LAS unsigned* hist = (LAS unsigned*)(F.lds + RING_OFF);
    LAS unsigned* GT = hist; LAS unsigned* EQ = hist + 32 * 257;
    LAS unsigned* pfx = (LAS unsigned*)(F.lds + XTRA_OFF);
    LAS unsigned* lbnd = pfx + 32;
    LAS unsigned* need = lbnd + 32; LAS unsigned* neq = need + 32;
    LAS float* wl = (LAS float*)(neq + 32);
    const int tid = F.tid, lane = F.lane, wave = F.wave;
    const int t0 = 64 * c + 32 * half, L = 64 * (c + 1), nb = L / 32; const size_t tokb = (size_t)b * SEQ;
#pragma unroll
    for (int i = 0; i < 16; ++i) ((LAS v4u*)hist)[tid + 512 * i] = (v4u){0u, 0u, 0u, 0u};
    if (tid < 32) { pfx[tid] = 0u; lbnd[tid] = 0u; need[tid] = (unsigned)TOPK; neq[tid] = 0u; }
    if (tid < 128) { const int q = tid >> 2, hd = tid & 3; wl[tk_fidx(q) * 4 + hd] = IW[(tokb + t0 + q) * 4 + hd] * 0.0625f; }
    __syncthreads();
    if (L > TOPK) {
        bf16x8 af[4][4]; const LAS f32x4* wr = (const LAS f32x4*)wl;
#pragma unroll
        for (int qg = 0; qg < 4; ++qg)
#pragma unroll
            for (int kk = 0; kk < 4; ++kk) af[qg][kk] = *(const GAS bf16x8*)(IQ + (tokb + t0 + 8 * qg) * 256 + (lane & 31) * 64 + 16 * kk + 8 * (lane >> 5));
        const bf16* IKb = IK + tokb * 64;
        topk_pass<0>(af, wr, IKb, nb, hist, pfx, lbnd, need, neq, wave, lane); __syncthreads(); topk_scan<true, true, 10>(hist, pfx, lbnd, need, neq, wave, lane); __syncthreads();
        topk_pass<1>(af, wr, IKb, nb, hist, pfx, lbnd, need, neq, wave, lane); __syncthreads(); topk_scan<false, true, 11>(hist, pfx, lbnd, need, neq, wave, lane); __syncthreads();
        topk_pass<2>(af, wr, IKb, nb, hist, pfx, lbnd, need, neq, wave, lane); __syncthreads(); topk_scan<false, true, 11>(hist, pfx, lbnd, need, neq, wave, lane); __syncthreads();
        for (int rep_ = 0; rep_ < ((REP_PHASE) == 20 ? 2 : 1); ++rep_) topk_pass<3>(af, wr, IKb, nb, hist, pfx, lbnd, need, neq, wave, lane);
        if ((REP_PHASE) == 21) topk_pass<4>(af, wr, IKb, nb, hist, pfx, lbnd, need, neq, wave, lane);
        __syncthreads();
        for (int qq = 0; qq < 4; ++qq) {
            const int q = 4 * wave + qq; const unsigned nd = need[q], ne = neq[q];
            if (nd < ne) { LAS unsigned* eqr = EQ + q * 257; unsigned w[4], pc = 0u;
#pragma unroll
                for (int i = 0; i < 4; ++i) { w[i] = eqr[4 * lane + i]; pc += (unsigned)__builtin_popcount(w[i]); }
                const unsigned inc = wave_incl_scan(pc, lane);
                unsigned before = inc - pc;
#pragma unroll
                for (int i = 0; i < 4; ++i) { const unsigned p = (unsigned)__builtin_popcount(w[i]); const int take = (int)nd - (int)before;
                    if (take <= 0) w[i] = 0u; else if (take < (int)p) { unsigned x = w[i], r = 0u; for (int k = 0; k < take; ++k) { const unsigned lsb = x & (0u - x); r |= lsb; x ^= lsb; } w[i] = r; }
                    before += p; eqr[4 * lane + i] = w[i]; } }
        }
        __syncthreads();
    }
    const int ntile = 4 * (c / 4 + 1);
    for (int idx = tid; idx < 32 * ntile; idx += NWAVES * 64) { const int q = idx & 31, t = idx >> 5; unsigned w0, w1;
        if (L <= TOPK) { w0 = (2 * t < nb) ? 0xffffffffu : 0u; w1 = (2 * t + 1 < nb) ? 0xffffffffu : 0u; }
        else { w0 = GT[q * 257 + 2 * t] | EQ[q * 257 + 2 * t]; w1 = GT[q * 257 + 2 * t + 1] | EQ[q * 257 + 2 * t + 1]; }
        MK[((size_t)b * 128 + t) * SEQ + t0 + q] = (unsigned long long)w0 | ((unsigned long long)w1 << 32); }
    __syncthreads();
}
typedef float f32x16r __attribute__((ext_vector_type(16)));
__device__ __forceinline__ void router_phase(Frame& F, bool dry = false) {
    LAS float* tab = (LAS float*)(F.lds + RING_OFF);
    LAS float* xch = (LAS float*)(F.lds + RING_OFF + 131072);
    LAS float* ssq = (LAS float*)(F.lds + XTRA_OFF);
    LAS float* rs = ssq + 512;
    LAS unsigned* lc = (LAS unsigned*)(rs + 64);
    LAS unsigned* basep = lc + 32;
    LAS unsigned* rec_e = basep + 32; LAS unsigned* rec_r = rec_e + 256; LAS float* rec_w = (LAS float*)(rec_r + 256);
    const int tid = F.tid, lane = F.lane, wave = F.wave, m32 = lane & 31, kh = lane >> 5, tile = wave >> 2, kq = wave & 3;
    const float* x1 = F.out; const float* g2 = F.in[11]; const float* rw = F.in[12]; const float* rb = F.in[13];
    bf16* H2 = (bf16*)(F.ws + WS_H2); int* TOKE = (int*)(F.ws + WS_TOKE); int* TOKP = TOKE + M * 4; float* TOKW = (float*)(TOKP + M * 4);
    for (int i0 = tid; i0 < 1024 * 8; i0 += 4 * NWAVES * 64) { f32x4 v[4]; float g[4];
#pragma unroll
        for (int u = 0; u < 4; ++u) { const int i = i0 + u * NWAVES * 64; v[u] = *(const GAS f32x4*)(rw + (size_t)(i >> 3) * 32 + 4 * (i & 7)); g[u] = g2[i >> 3]; }
#pragma unroll
        for (int u = 0; u < 4; ++u) { const int i = i0 + u * NWAVES * 64, k = i >> 3, n0 = 4 * (i & 7); LAS float* d = tab + ((k >> 2) * 32 + n0) * 4 + (k & 3);
            d[0] = v[u].x * g[u]; d[4] = v[u].y * g[u]; d[8] = v[u].z * g[u]; d[12] = v[u].w * g[u]; } }
    if (tid < 32) lc[tid] = 0u;
    __syncthreads();
    for (int tb = blockIdx.x; tb < M / 64; tb += F.G) {
        {
            const size_t tok = (size_t)tb * 64 + tile * 32 + m32; const GAS f32x4* xr = (const GAS f32x4*)(x1 + tok * 1024) + 64 * kq + kh;
            const LAS f32x4* br = (const LAS f32x4*)tab + (size_t)(64 * kq + kh) * 32 + m32;
            f32x16r acc = {}; float ss = 0.f;
#pragma unroll 1
            for (int j0 = 0; j0 < 32; j0 += 8) { f32x4 xv[8];
#pragma unroll
                for (int u = 0; u < 8; ++u) xv[u] = xr[2 * (j0 + u)];
#pragma unroll
                for (int u = 0; u < 8; ++u) { const f32x4 bv = br[2 * (j0 + u) * 32]; const f32x4 x4 = xv[u];
                    ss += (x4.x * x4.x + x4.y * x4.y) + (x4.z * x4.z + x4.w * x4.w);
                    acc = __builtin_amdgcn_mfma_f32_32x32x2f32(x4.x, bv.x, acc, 0, 0, 0); acc = __builtin_amdgcn_mfma_f32_32x32x2f32(x4.y, bv.y, acc, 0, 0, 0);
                    acc = __builtin_amdgcn_mfma_f32_32x32x2f32(x4.z, bv.z, acc, 0, 0, 0); acc = __builtin_amdgcn_mfma_f32_32x32x2f32(x4.w, bv.w, acc, 0, 0, 0); } }
            ssq[(tile * 4 + kq) * 64 + lane] = ss;
            LAS float* xw = xch + ((tile * 2 + (kq >> 1)) * 16) * 64 + lane;
            if (kq & 1) {
#pragma unroll
                for (int r = 0; r < 16; ++r) xw[r * 64] = acc[r]; }
            __syncthreads();
            if (!(kq & 1)) {
#pragma unroll
                for (int r = 0; r < 16; ++r) acc[r] += xw[r * 64]; }
            if (tid < 64) { float q = 0.f;
#pragma unroll
                for (int u = 0; u < 4; ++u) q += ssq[((tid >> 5) * 4 + u) * 64 + (tid & 31)] + ssq[((tid >> 5) * 4 + u) * 64 + 32 + (tid & 31)];
                rs[tid] = 1.0f / sqrtf(q * (1.f / 1024.f) + EPS); }
            __syncthreads();
            LAS float* xw2 = xch + ((tile * 2) * 16) * 64 + lane;
            if (kq == 2) {
#pragma unroll
                for (int r = 0; r < 16; ++r) xw2[r * 64] = acc[r]; }
            __syncthreads();
            if (kq == 0) {
#pragma unroll
                for (int r = 0; r < 16; ++r) acc[r] += xw2[r * 64]; }
            __syncthreads();
            if (kq == 0) { const float bias = rb[m32];
#pragma unroll
                for (int r = 0; r < 16; ++r) { const int tk = (r & 3) + 8 * (r >> 2) + 4 * kh; xch[(tile * 32 + tk) * 33 + m32] = acc[r] * rs[tile * 32 + tk] + bias; } }
            __syncthreads();
        }
        if (tid < 64) {
            const LAS float* lg = xch + tid * 33; float bv[4] = {-INFINITY, -INFINITY, -INFINITY, -INFINITY}; int be[4] = {0, 0, 0, 0};
#pragma unroll
            for (int n = 0; n < 32; ++n) { float v = lg[n]; int e = n;
#pragma unroll
                for (int s2 = 0; s2 < 4; ++s2) { if (v > bv[s2]) { const float tv = bv[s2]; const int te = be[s2]; bv[s2] = v; be[s2] = e; v = tv; e = te; } } }
            const float p1 = __expf(bv[1] - bv[0]), p2 = __expf(bv[2] - bv[0]), p3 = __expf(bv[3] - bv[0]); const float inv = 1.0f / (1.0f + p1 + p2 + p3);
            const float pw[4] = {inv, p1 * inv, p2 * inv, p3 * inv};
            if (!dry) {
#pragma unroll
            for (int s2 = 0; s2 < 4; ++s2) { const unsigned rk = __hip_atomic_fetch_add(lc + be[s2], 1u, __ATOMIC_RELAXED, __HIP_MEMORY_SCOPE_WORKGROUP);
                rec_e[tid * 4 + s2] = (unsigned)be[s2]; rec_r[tid * 4 + s2] = rk; rec_w[tid * 4 + s2] = pw[s2]; } }
        }
        { const GAS f32x4* gr = (const GAS f32x4*)g2 + lane; f32x4 gv[4];
#pragma unroll
          for (int j = 0; j < 4; ++j) gv[j] = gr[64 * j];
          for (int h = 0; h < 2; ++h) { f32x4 v[4][4];
#pragma unroll
            for (int u = 0; u < 4; ++u) { const size_t t = (size_t)tb * 64 + wave * 8 + h * 4 + u; const GAS f32x4* xr = (const GAS f32x4*)(x1 + t * 1024) + lane;
#pragma unroll
                for (int j = 0; j < 4; ++j) v[u][j] = xr[64 * j]; }
#pragma unroll
            for (int u = 0; u < 4; ++u) { const int tl = wave * 8 + h * 4 + u; const size_t t = (size_t)tb * 64 + tl; const float r = rs[tl]; GAS unsigned long long* o8 = (GAS unsigned long long*)(H2 + t * 1024) + lane;
#pragma unroll
                for (int j = 0; j < 4; ++j) { const f32x4 y = v[u][j] * r * gv[j]; o8[64 * j] = (unsigned long long)pk2(y.x, y.y) | ((unsigned long long)pk2(y.z, y.w) << 32); } } } }
        __syncthreads();
        if (tid < 32) basep[tid] = __hip_atomic_fetch_add(F.ctl + CW_CNT + tid, lc[tid], RLX_AGENT);
        __syncthreads();
        if (tid < 256 && !dry) { const size_t p = (size_t)tb * 256 + tid; const unsigned me = rec_e[tid]; TOKE[p] = (int)me; TOKP[p] = (int)(basep[me] + rec_r[tid]); TOKW[p] = rec_w[tid]; }
        __syncthreads();
        if (tid < 32) lc[tid] = 0u;
        __syncthreads();
    }
}
__device__ __forceinline__ void moe_tables(Frame& F, LAS unsigned*& tpre, LAS unsigned*& cntl) {
    cntl = (LAS unsigned*)(F.lds + XTRA_OFF + 8192); tpre = cntl + 32;
    if (F.tid < 32) cntl[F.tid] = __hip_atomic_load(F.ctl + CW_CNT + F.tid, RLX_AGENT);
    __syncthreads();
    if (F.tid == 0) { unsigned a = 0u; for (int e = 0; e < 32; ++e) { tpre[e] = a; a += (cntl[e] + 255u) >> 8; } tpre[32] = a; }
    __syncthreads();
}
__device__ __forceinline__ LAS unsigned* moe_build_units(Frame& F, const LAS unsigned* tpre, int NT) {
    LAS unsigned* list = (LAS unsigned*)(F.lds + XTRA_OFF + 8192 + 512);
    if (F.tid < 24) { unsigned w = 0xffffffffu; const int U = (int)tpre[32] * NT; const long Lg = (long)F.tid * F.G + blockIdx.x;
        if (F.tid < 20 && Lg < U) { int wg = (int)Lg; { const int q = U / 8, r = U % 8, xcd = wg % 8, off = wg / 8; wg = (xcd < r ? xcd * (q + 1) : r * (q + 1) + (xcd - r) * q) + off; }
            int e = 0; while (e < 31 && wg >= (int)tpre[e + 1] * NT) ++e;
            const int rr = wg - (int)tpre[e] * NT, mt = (int)(tpre[e + 1] - tpre[e]); const int n = rr / mt, m = rr % mt;
            w = (unsigned)(tpre[e] + m) | ((unsigned)(e * NT + n) << 16); }
        list[F.tid] = w; }
    __syncthreads();
    return list;
}
__device__ __forceinline__ void gather_phase(Frame& F) {
    LAS unsigned* tpre; LAS unsigned* cntl; moe_tables(F, tpre, cntl);
    const int gw = F.vcu * NWAVES + F.wave, NGW = F.G * NWAVES, lane = F.lane;
    const bf16* H2 = (const bf16*)(F.ws + WS_H2); bf16* XP = (bf16*)(F.ws + WS_XP); float* ROWW = (float*)(F.ws + WS_ROWW);
    const int* TOKE = (const int*)(F.ws + WS_TOKE); const int* TOKP = TOKE + M * 4; const float* TOKW = (const float*)(TOKP + M * 4); int* TOKR = (int*)(TOKW + M * 4);
    for (int p0 = gw * 32; p0 < M * 4; p0 += NGW * 32) {
        const int p = p0 + (lane & 31); const int e = TOKE[p]; const int myrow = (int)tpre[e] * 256 + TOKP[p];
        if (lane < 32) { TOKR[p] = myrow; ROWW[myrow] = TOKW[p]; }
        for (int i = 0; i < 32; i += 4) { v4u a[4], bq[4]; int rw[4];
#pragma unroll
            for (int u = 0; u < 4; ++u) { rw[u] = __builtin_amdgcn_readlane(myrow, i + u); const GAS v4u* src = (const GAS v4u*)(H2 + (size_t)((p0 + i + u) >> 2) * 1024); a[u] = src[lane]; bq[u] = src[lane + 64]; }
#pragma unroll
            for (int u = 0; u < 4; ++u) { GAS v4u* dst = (GAS v4u*)(XP + (size_t)rw[u] * 1024); dst[lane] = a[u]; dst[lane + 64] = bq[u]; } }
    }
    for (int i = gw; i < 32 * 256; i += NGW) { const int e = i >> 8; const int row = (int)tpre[e] * 256 + (int)cntl[e] + (i & 255);
        if (row < (int)tpre[e + 1] * 256) { GAS v4u* dst = (GAS v4u*)(XP + (size_t)row * 1024); dst[lane] = (v4u){0u, 0u, 0u, 0u}; dst[lane + 64] = (v4u){0u, 0u, 0u, 0u}; if (lane == 0) ROWW[row] = 0.f; } }
}
__device__ __forceinline__ void combine_phase(Frame& F, bool dry = false) {
    const int gw = F.vcu * NWAVES + F.wave, NGW = F.G * NWAVES, lane = F.lane;
    const bf16* Y = (const bf16*)(F.ws + WS_XP); const int* TOKR = (const int*)(F.ws + WS_TOKE) + 3 * M * 4;
    for (int t = gw; t < M; t += NGW) {
        GAS f32x4* o = (GAS f32x4*)(F.out + (size_t)t * 1024) + lane; f32x4 v[4]; v2u y[4][4]; int row[4];
#pragma unroll
        for (int s = 0; s < 4; ++s) row[s] = TOKR[t * 4 + s];
#pragma unroll
        for (int j = 0; j < 4; ++j) v[j] = o[64 * j];
        const f32x4 v0[4] = {v[0], v[1], v[2], v[3]};
#pragma unroll
        for (int s = 0; s < 4; ++s) { const GAS v2u* yp = (const GAS v2u*)(Y + (size_t)row[s] * 1024) + lane;
#pragma unroll
            for (int j = 0; j < 4; ++j) y[s][j] = yp[64 * j]; }
#pragma unroll
        for (int s = 0; s < 4; ++s)
#pragma unroll
            for (int j = 0; j < 4; ++j) { v[j].x += bflo(y[s][j].x); v[j].y += bfhi(y[s][j].x); v[j].z += bflo(y[s][j].y); v[j].w += bfhi(y[s][j].y); }
#pragma unroll
        for (int j = 0; j < 4; ++j) o[64 * j] = (dry && v[j].x == v[j].x) ? v0[j] : v[j];
    }
}
struct Args { const float* in[18]; float* out; unsigned char* ws; int ph_lo, ph_hi; };
static_assert(sizeof(Args) == 18 * 8 + 8 + 8 + 8, "Args has no padding bytes");
__global__ void __launch_bounds__(NWAVES * 64, 2) mk_fwd(Args args) {
    extern __shared__ __attribute__((aligned(16))) unsigned char lds[];
    Frame F;
    F.lds = (LAS unsigned char*)lds;
    F.MISC = (volatile LAS unsigned*)(F.lds + MISC_OFF);
    F.tid = threadIdx.x; F.lane = F.tid & 63; F.wave = __builtin_amdgcn_readfirstlane(F.tid >> 6);
    F.G = gridDim.x; { const int bx = blockIdx.x; F.vcu = (F.G % 8 == 0) ? (bx % 8) * (F.G / 8) + bx / 8 : bx; }
    F.ws = args.ws; F.ctl = (gu32*)(args.ws + WS_CTL); F.out = args.out;
#pragma unroll
    for (int i = 0; i < 18; ++i) F.in[i] = args.in[i];
    for (int u = F.tid; u < (LDS_BYTES - LDSCTL_OFF) / 4; u += NWAVES * 64) ((LAS unsigned*)(F.lds + LDSCTL_OFF))[u] = 0u;
    __syncthreads();
    XcdBarrier bar; bar.bar = (unsigned*)(F.ctl + CW_BAR); bar.x = 0; bar.st = nullptr;
    if (!MK_SPLIT) bar = xcd_barrier_post((unsigned*)(F.ctl + CW_BAR), F.MISC + 8);
#define GRID_BAR() do { if (MK_SPLIT) { if (F.tid == 0) __hip_atomic_store(F.ctl + CW_TMO, 0xBADBA0u, RLX_AGENT); } else { xcd_barrier(bar); } } while (0)
    const int lo = args.ph_lo, hi = args.ph_hi;
#define IN(k) (lo <= (k) && (k) < hi)
#define BOTH(k) (IN(k) && IN((k) + 1))
    constexpr bool AL = true, SP = true;
#ifndef REP_PHASE
#define REP_PHASE -1
#endif
#define REPS(k) for (int rep_ = 0; rep_ < ((REP_PHASE) == (k) ? 2 : 1); ++rep_)
    if (IN(0)) { REPS(0) p0_prologue(F); if (BOTH(0)) GRID_BAR(); }
    if (IN(1)) {
        pg8::Gemm g{(const bf16*)(F.ws + WS_H), (const bf16*)(F.ws + WS_WIN), M, NINP, DMODEL}; pg8::StaticOrder S; S.init(M, NINP, F.G, (int)blockIdx.x);
        pg8::EpiInProj E{F.ws};
        REPS(1) pg8::gemm_phase<pg8::EpiInProj, pg8::StaticOrder, AL, SP>(F.lds + RING_OFF, g, S, E);
        if (BOTH(1)) GRID_BAR();
    }
    if (IN(2)) {
        if ((REP_PHASE) == 32) qknorm_rows(F, true);
        qknorm_rows(F); REPS(30) pool_diff_rows(F);
        REPS(2) for (int v = F.vcu; v < 256; v += F.G) { const int b = v >> 7, half = (v >> 6) & 1, cc = v & 63; for (int k = 0; k < 2; ++k) topk_unit(F, b, k ? cc : 127 - cc, half); }
        if (BOTH(2)) GRID_BAR();
    }
    if (IN(3)) {
        { pg8::Gemm g{(const bf16*)(F.ws + WS_DIFF), (const bf16*)(F.ws + WS_WPOOL), M, DPOOL, DPOOL}; pg8::StaticOrder S; S.init(M, DPOOL, F.G, (int)blockIdx.x);
          pg8::EpiPool E{(bf16*)(F.ws + WS_YAP), F.in[6], F.in[7]};
          REPS(31) pg8::gemm_phase<pg8::EpiPool, pg8::StaticOrder, AL, SP>(F.lds + RING_OFF, g, S, E); }
        const float cshift = attn_body::C2 * 64.0f * wave_max(fabsf(F.in[3][F.lane])) * wave_max(fabsf(F.in[4][F.lane]));
        REPS(3) for (int v = F.vcu; v < 256; v += F.G) { const int bh = v >> 4, s = v & 15;
            for (int i = 0; i < 2; ++i) attn_body::attn_unit(bh >> 3, bh & 7, i == 0 ? 31 - s : s, (const attn_body::bf16*)(F.ws + WS_Q), (const attn_body::bf16*)(F.ws + WS_K), (const attn_body::bf16*)(F.ws + WS_V),
                                                             (attn_body::bf16*)(F.ws + WS_YAP), (const unsigned long long*)(F.ws + WS_MASK), cshift, (char*)lds + RING_OFF); }
        if (BOTH(3)) GRID_BAR();
    }
    if (IN(4)) {
        pg8::Gemm g{(const bf16*)(F.ws + WS_YAP), (const bf16*)(F.ws + WS_WAB), M, 2048, DMODEL}; pg8::StaticOrder S; S.init(M, 2048, F.G, (int)blockIdx.x);
        pg8::EpiMerge E{(const bf16*)(F.ws + WS_GA), (const bf16*)(F.ws + WS_GB), (bf16*)(F.ws + WS_MERGED)};
        REPS(4) pg8::gemm_phase<pg8::EpiMerge, pg8::StaticOrder, AL, SP>(F.lds + RING_OFF, g, S, E);
        if (BOTH(4)) GRID_BAR();
    }
    if (IN(5)) {
        pg8::Gemm g{(const bf16*)(F.ws + WS_MERGED), (const bf16*)(F.ws + WS_WOUT), M, DMODEL, DMODEL}; pg8::StaticOrder S; S.init(M, DMODEL, F.G, (int)blockIdx.x);
        pg8::EpiResF32 E{F.in[0], F.out};
        REPS(5) pg8::gemm_phase<pg8::EpiResF32, pg8::StaticOrder, AL, SP>(F.lds + RING_OFF, g, S, E);
        if (BOTH(5)) GRID_BAR();
    }
    if (IN(6)) { if ((REP_PHASE) == 6) router_phase(F, true); router_phase(F); if (BOTH(6)) GRID_BAR(); }
    if (IN(7)) { REPS(7) gather_phase(F); if (BOTH(7)) GRID_BAR(); }
    if (IN(8)) {
        LAS unsigned* tpre; LAS unsigned* cntl; moe_tables(F, tpre, cntl);
        pg8::ListOrder S{moe_build_units(F, tpre, 8)};
        pg8::Gemm g{(const bf16*)(F.ws + WS_XP), (const bf16*)(F.ws + WS_W1), MPAD, NEXP * 2048, DMODEL};
        pg8::EpiSwiglu E{F.in[15], (bf16*)(F.ws + WS_ACT)};
        REPS(8) pg8::gemm_phase<pg8::EpiSwiglu, pg8::ListOrder, AL, SP>(F.lds + RING_OFF, g, S, E);
        if (BOTH(8)) GRID_BAR();
    }
    if (IN(9)) {
        LAS unsigned* tpre; LAS unsigned* cntl; moe_tables(F, tpre, cntl);
        pg8::ListOrder S{moe_build_units(F, tpre, 4)};
        pg8::Gemm g{(const bf16*)(F.ws + WS_ACT), (const bf16*)(F.ws + WS_W2), MPAD, NEXP * 1024, DEXP};
        pg8::EpiDown E{F.in[17], (const float*)(F.ws + WS_ROWW), (bf16*)(F.ws + WS_XP)};
        REPS(9) pg8::gemm_phase<pg8::EpiDown, pg8::ListOrder, AL, SP>(F.lds + RING_OFF, g, S, E);
        if (BOTH(9)) GRID_BAR();
    }
    if (IN(10)) { if ((REP_PHASE) == 10) combine_phase(F, true); combine_phase(F); }
#undef IN
#undef BOTH
}

extern "C" void kernel_launch(void* const* d_in, const int* in_sizes, int n_in, void* d_out, int out_size, void* d_ws, size_t ws_size, hipStream_t stream) {
    static int grid = 0;
    if (grid == 0) {
        if (n_in != 18 || in_sizes[0] != M * DMODEL || out_size != M * DMODEL || ws_size < WS_END) { fprintf(stderr, "kernel_launch: built for 18 inputs, x/out of %d floats, >= %zu bytes of workspace; got n_in %d, in0 %d, out %d, ws %zu; nothing launched\n", M * DMODEL, (size_t)WS_END, n_in, n_in > 0 ? in_sizes[0] : -1, out_size, ws_size); grid = -1; return; }
        int dev = 0, cus = 0, per_cu = 0;
        if (hipGetDevice(&dev) != hipSuccess || hipDeviceGetAttribute(&cus, hipDeviceAttributeMultiprocessorCount, dev) != hipSuccess) { fprintf(stderr, "kernel_launch: hipGetDevice / hipDeviceGetAttribute failed; nothing launched\n"); grid = -1; return; }
        if (hipFuncSetAttribute((const void*)mk_fwd, hipFuncAttributeMaxDynamicSharedMemorySize, LDS_BYTES) != hipSuccess) { fprintf(stderr, "kernel_launch: hipFuncSetAttribute failed; nothing launched\n"); grid = -1; return; }
        if (hipOccupancyMaxActiveBlocksPerMultiprocessor(&per_cu, (const void*)mk_fwd, NWAVES * 64, LDS_BYTES) != hipSuccess || per_cu < 1) { fprintf(stderr, "kernel_launch: occupancy query reports %d workgroups per CU; nothing launched\n", per_cu); (void)hipGetLastError(); grid = -1; return; }
        (void)hipGetLastError();
        grid = cus;
    }
    if (grid < 0) return;
    if (hipMemsetAsync((char*)d_ws + WS_CTL, 0, CTL_ZERO_BYTES, stream) != hipSuccess) { fprintf(stderr, "kernel_launch: hipMemsetAsync of the control words failed; nothing launched\n"); return; }
    Args a{};
    for (int i = 0; i < 18; ++i) a.in[i] = (const float*)d_in[i];
    a.out = (float*)d_out; a.ws = (unsigned char*)d_ws;
    const int nl = MK_SPLIT ? N_PHASES : 1;
    for (int li = 0; li < nl; ++li) {
        a.ph_lo = MK_SPLIT ? li : 0; a.ph_hi = MK_SPLIT ? li + 1 : N_PHASES;
        hipLaunchKernelGGL(mk_fwd, dim3(grid), dim3(NWAVES * 64), LDS_BYTES, stream, a);
        const hipError_t le = hipPeekAtLastError();
        if (le != hipSuccess) { fprintf(stderr, "kernel_launch: launch %d failed: %s (grid %d x %d threads, %d B LDS)\n", li, hipGetErrorName(le), grid, NWAVES * 64, LDS_BYTES); break; }
    }
}
```

```cpp
#define MK_SPLIT 0
#include <hip/hip_runtime.h>
#include <hip/hip_bf16.h>
#include <cstdio>
#include <cstdint>
#include <cmath>
constexpr int NWAVES = 8;
#ifndef MK_SPLIT
#define MK_SPLIT 0
#endif
constexpr int N_PHASES = 11;
#ifndef REP_PHASE
#define REP_PHASE -1
#endif

constexpr int BATCH = 2, SEQ = 8192, DMODEL = 1024, M = BATCH * SEQ;
constexpr int DATT = 512, HD = 64, NH = 8, NIH = 4, IDIM = 64, TOPK = 256, DPOOL = 512, NEXP = 32, TOPE = 4, DEXP = 1024;
constexpr int NIN = 4420;
constexpr int NINP = 4608;
constexpr float EPS = 1e-6f;
constexpr int MP_TILES = 288, MPAD = MP_TILES * 256;

constexpr size_t MiB = 1u << 20;
constexpr size_t WS_CTL = 0, CTL_ZERO_BYTES = 1 * MiB;
constexpr size_t WS_WIN = 2 * MiB;
constexpr size_t WS_WAB = 12 * MiB;
constexpr size_t WS_WOUT = 16 * MiB;
constexpr size_t WS_WPOOL = 18 * MiB;
constexpr size_t WS_W1 = 20 * MiB;
constexpr size_t WS_W2 = 148 * MiB;
constexpr size_t WS_H = 212 * MiB;
constexpr size_t WS_Q = 244 * MiB, WS_K = 260 * MiB, WS_V = 276 * MiB;
constexpr size_t WS_IQ = 292 * MiB;
constexpr size_t WS_IK = 300 * MiB;
constexpr size_t WS_IW = 302 * MiB;
constexpr size_t WS_U = 303 * MiB;
constexpr size_t WS_DIFF = 319 * MiB;
constexpr size_t WS_GA = 335 * MiB, WS_GB = 367 * MiB;
constexpr size_t WS_MASK = 399 * MiB;
constexpr size_t WS_YAP = 415 * MiB;
constexpr size_t WS_MERGED = 447 * MiB;
constexpr size_t WS_H2 = 479 * MiB;
constexpr size_t WS_TOKE = 511 * MiB;
constexpr size_t WS_ROWW = 512 * MiB;
constexpr size_t WS_XP = 514 * MiB;
constexpr size_t WS_ACT = 658 * MiB;
constexpr size_t WS_END = 802 * MiB;

constexpr int CW_TMO = 0, CW_CODE = 1;
constexpr int CW_CNT = 64;
constexpr int CW_BAR = 4096;

constexpr int RING_OFF = 0, RING_BYTES = 147456;
constexpr int LDSCTL_OFF = RING_BYTES, MISC_OFF = LDSCTL_OFF + 320;
constexpr int XTRA_OFF = LDSCTL_OFF + 1024;
constexpr int LDS_BYTES = 163840;
static_assert(XTRA_OFF + 14336 <= LDS_BYTES, "LDS map");

#define GAS __attribute__((address_space(1)))
#define LAS __attribute__((address_space(3)))
typedef unsigned short bf16;
typedef unsigned v4u __attribute__((ext_vector_type(4)));
typedef unsigned v2u __attribute__((ext_vector_type(2)));
typedef float f32x4 __attribute__((ext_vector_type(4)));
typedef short bf16x8 __attribute__((ext_vector_type(8)));
typedef float f32x16 __attribute__((ext_vector_type(16)));
typedef GAS unsigned gu32;
#define RLX_AGENT __ATOMIC_RELAXED, __HIP_MEMORY_SCOPE_AGENT
#define LDS_WAIT() asm volatile("s_waitcnt lgkmcnt(0)" ::: "memory")
#define VM_WAIT() asm volatile("s_waitcnt vmcnt(0)" ::: "memory")
__device__ __forceinline__ unsigned f2bf(float f) { unsigned u = __builtin_bit_cast(unsigned, f); return (u + 0x7fffu + ((u >> 16) & 1u)) >> 16; }
__device__ __forceinline__ unsigned pk2(float lo, float hi) { return f2bf(lo) | (f2bf(hi) << 16); }
__device__ __forceinline__ float bflo(unsigned w) { return __uint_as_float(w << 16); }
__device__ __forceinline__ float bfhi(unsigned w) { return __uint_as_float(w & 0xffff0000u); }
namespace pg8 {
#define PG8_LAS __attribute__((address_space(3)))
typedef unsigned short bf16_t;
typedef short bf16x8 __attribute__((ext_vector_type(8)));
typedef float f32x4 __attribute__((ext_vector_type(4)));
typedef unsigned u32x4 __attribute__((ext_vector_type(4)));
constexpr int BM = 256, BK = 64, HALF = 128, HTB = HALF * BK * 2  , STAGE_BYTES = 8 * HTB, NXCD = 8, WGM = 8;

__host__ __device__ __forceinline__ int lds_byte(int r, int c) { const int st = (r >> 4) * 2 + (c >> 5), rr = r & 15, cc = c & 31, ob = rr * 64 + cc * 2; return st * 1024 + (ob ^ (((ob >> 9) & 1) << 5)); }
__host__ __device__ __forceinline__ void stage_rc(int b, int& R, int& C) { const int st = b / 1024, sb = b % 1024, swz = sb ^ (((sb >> 9) & 1) << 5); R = (st >> 1) * 16 + swz / 64; C = (st & 1) * 32 + (swz % 64) / 2; }
__host__ __device__ __forceinline__ int perm32(int rho) { const int n = rho >> 4, i = rho & 15; return 8 * (i >> 2) + 4 * n + (i & 3); }

struct Unit { int pm, pn; };
struct Gemm { const bf16_t* A; const bf16_t* Bt; int M, N, K; };

struct StaticOrder {
    int nM, nN, nwg, G, c;
    __host__ __device__ void init(int M, int N, int G_, int c_) { nM = M / BM; nN = N / BM; nwg = nM * nN; G = G_; c = c_; }
    __host__ __device__ bool next(int i, Unit& u) const {
        const long L = (long)i * G + c; if (L >= nwg) return false;
        int wgid = (int)L; { const int q = nwg / NXCD, r = nwg % NXCD, xcd = wgid % NXCD, off = wgid / NXCD; wgid = (xcd < r ? xcd * (q + 1) : r * (q + 1) + (xcd - r) * q) + off; }
        const int nig = WGM * nN, gid = wgid / nig, fm = gid * WGM, gsz = (nM - fm) < WGM ? (nM - fm) : WGM;
        u.pm = fm + ((wgid % nig) % gsz); u.pn = (wgid % nig) / gsz; return true;
    }
    __device__ __forceinline__ void a_ready(const Unit&) const {}
    __device__ __forceinline__ void done(const Unit&) const {}
};
__device__ __forceinline__ unsigned cvt_pk_bf16(float lo, float hi) { unsigned r; asm volatile("v_cvt_pk_bf16_f32 %0, %1, %2" : "=v"(r) : "v"(lo), "v"(hi)); return r; }
typedef float f32x2 __attribute__((ext_vector_type(2)));
typedef unsigned u32x2 __attribute__((ext_vector_type(2)));
__device__ __forceinline__ float sigmoidf_fast(float x) { return __builtin_amdgcn_rcpf(1.0f + __builtin_amdgcn_exp2f(-1.4426950408889634f * x)); }
__device__ __forceinline__ float bf_lo(unsigned w) { return __uint_as_float(w << 16); }
__device__ __forceinline__ float bf_hi(unsigned w) { return __uint_as_float(w & 0xffff0000u); }

struct EpiInProj {
    static constexpr bool PERM = true, AFTER_DRAIN = false;
    unsigned char* ws;
    static constexpr unsigned oq = (unsigned)WS_Q, ok = (unsigned)WS_K, ov = (unsigned)WS_V, oiq = (unsigned)WS_IQ, oik = (unsigned)WS_IK, ou = (unsigned)WS_U, oga = (unsigned)WS_GA, ogb = (unsigned)WS_GB, oiw = (unsigned)WS_IW;
    __device__ __forceinline__ void operator()(const f32x4 (&acc)[2][2][4][2], const Unit& un, int wr, int wc, int fr, int fq) const {
        const int pn = un.pn, row0 = un.pm * BM + wr * 64 + fr;
        if (pn == 7) {
#pragma unroll
            for (int ai = 0; ai < 2; ++ai)
#pragma unroll
                for (int m = 0; m < 4; ++m) { const size_t row = (size_t)(row0 + ai * HALF + m * 16);
                    const f32x4 v0 = acc[ai][0][m][0], v1 = acc[ai][0][m][1];
                    if (wc < 2) { u32x4 w; w.x = cvt_pk_bf16(v0[0], v0[1]); w.y = cvt_pk_bf16(v0[2], v0[3]); w.z = cvt_pk_bf16(v1[0], v1[1]); w.w = cvt_pk_bf16(v1[2], v1[3]);
                        *(u32x4*)((bf16_t*)(ws + oik) + (row >> 5) * 2048 + (2 * wc + (fq >> 1)) * 512 + ((fq & 1) * 32 + (row & 31)) * 8) = w; }
                    else if (wc == 2 && fq == 0) { *(f32x4*)((float*)(ws + oiw) + row * 4) = v0; } }
            return;
        }
        unsigned boff; int ldc, colt; bool sig = false;
        if (pn < 6) { boff = pn < 2 ? oq : (pn < 4 ? ok : ov); ldc = 512; colt = (pn & 1) * 256; }
        else if (pn == 6) { boff = oiq; ldc = 256; colt = 0; }
        else if (pn < 10) { boff = ou; ldc = 512; colt = (pn - 8) * 256; }
        else { sig = true; boff = pn < 14 ? oga : ogb; ldc = 1024; colt = ((pn - 10) & 3) * 256; }
        bf16_t* base = (bf16_t*)(ws + boff);
        const int col0 = colt + wc * 32 + 8 * fq;
#pragma unroll
        for (int ai = 0; ai < 2; ++ai)
#pragma unroll
            for (int m = 0; m < 4; ++m) { bf16_t* rowp = base + (size_t)(row0 + ai * HALF + m * 16) * ldc + col0;
#pragma unroll
                for (int bj = 0; bj < 2; ++bj) { f32x4 v0 = acc[ai][bj][m][0], v1 = acc[ai][bj][m][1];
                    if (sig) {
#pragma unroll
                        for (int j = 0; j < 4; ++j) { v0[j] = sigmoidf_fast(v0[j]); v1[j] = sigmoidf_fast(v1[j]); } }
                    u32x4 w; w.x = cvt_pk_bf16(v0[0], v0[1]); w.y = cvt_pk_bf16(v0[2], v0[3]); w.z = cvt_pk_bf16(v1[0], v1[1]); w.w = cvt_pk_bf16(v1[2], v1[3]);
                    *(u32x4*)(rowp + bj * HALF) = w; } }
    }
};
struct EpiPool {
    static constexpr bool PERM = true, AFTER_DRAIN = false;
    bf16_t* yap; const float* pb; const float* ps;
    __device__ __forceinline__ void operator()(const f32x4 (&acc)[2][2][4][2], const Unit& un, int wr, int wc, int fr, int fq) const {
        const int row0 = un.pm * BM + wr * 64 + fr, col0 = un.pn * BM + wc * 32 + 8 * fq;
        f32x4 bv[2][2], sv[2][2];
#pragma unroll
        for (int bj = 0; bj < 2; ++bj)
#pragma unroll
            for (int n = 0; n < 2; ++n) { bv[bj][n] = *(const f32x4*)(pb + col0 + bj * HALF + 4 * n); sv[bj][n] = *(const f32x4*)(ps + col0 + bj * HALF + 4 * n); }
#pragma unroll
        for (int ai = 0; ai < 2; ++ai)
#pragma unroll
            for (int m = 0; m < 4; ++m) { bf16_t* rowp = yap + (size_t)(row0 + ai * HALF + m * 16) * 1024 + 512 + col0;
#pragma unroll
                for (int bj = 0; bj < 2; ++bj) { const f32x4 v0 = (acc[ai][bj][m][0] + bv[bj][0]) * sv[bj][0], v1 = (acc[ai][bj][m][1] + bv[bj][1]) * sv[bj][1];
                    u32x4 w; w.x = cvt_pk_bf16(v0[0], v0[1]); w.y = cvt_pk_bf16(v0[2], v0[3]); w.z = cvt_pk_bf16(v1[0], v1[1]); w.w = cvt_pk_bf16(v1[2], v1[3]);
                    *(u32x4*)(rowp + bj * HALF) = w; } }
    }
};
struct EpiMerge {
    static constexpr bool PERM = true, AFTER_DRAIN = false;
    const bf16_t *gA, *gB; bf16_t* merged;
    __device__ __forceinline__ void operator()(const f32x4 (&acc)[2][2][4][2], const Unit& un, int wr, int wc, int fr, int fq) const {
        const int row0 = un.pm * BM + wr * 64 + fr, col0 = un.pn * HALF + wc * 32 + 8 * fq;
#pragma unroll
        for (int ai = 0; ai < 2; ++ai)
#pragma unroll
            for (int m = 0; m < 4; ++m) { const size_t off = (size_t)(row0 + ai * HALF + m * 16) * 1024 + col0;
                const u32x4 a = *(const u32x4*)(gA + off), b = *(const u32x4*)(gB + off);
                const f32x4 p0 = acc[ai][0][m][0], p1 = acc[ai][0][m][1], r0 = acc[ai][1][m][0], r1 = acc[ai][1][m][1];
                u32x4 w;
                w.x = cvt_pk_bf16(bf_lo(a.x) * p0[0] + bf_lo(b.x) * r0[0], bf_hi(a.x) * p0[1] + bf_hi(b.x) * r0[1]);
                w.y = cvt_pk_bf16(bf_lo(a.y) * p0[2] + bf_lo(b.y) * r0[2], bf_hi(a.y) * p0[3] + bf_hi(b.y) * r0[3]);
                w.z = cvt_pk_bf16(bf_lo(a.z) * p1[0] + bf_lo(b.z) * r1[0], bf_hi(a.z) * p1[1] + bf_hi(b.z) * r1[1]);
                w.w = cvt_pk_bf16(bf_lo(a.w) * p1[2] + bf_lo(b.w) * r1[2], bf_hi(a.w) * p1[3] + bf_hi(b.w) * r1[3]);
                *(u32x4*)(merged + off) = w; }
    }
};
struct EpiResF32 {
    static constexpr bool PERM = false, AFTER_DRAIN = false;
    const float* base; float* C;
    __device__ __forceinline__ void operator()(const f32x4 (&acc)[2][2][4][2], const Unit& un, int wr, int wc, int fr, int fq) const {
        const int row0 = un.pm * BM + wr * 64 + fr, col0 = un.pn * BM + wc * 32 + 4 * fq;
#pragma unroll
        for (int ai = 0; ai < 2; ++ai)
#pragma unroll
            for (int m = 0; m < 4; ++m) { const size_t off = (size_t)(row0 + ai * HALF + m * 16) * 1024 + col0;
#pragma unroll
                for (int bj = 0; bj < 2; ++bj)
#pragma unroll
                    for (int n = 0; n < 2; ++n) *(f32x4*)(C + off + bj * HALF + n * 16) = *(const f32x4*)(base + off + bj * HALF + n * 16) + acc[ai][bj][m][n]; }
    }
};
struct EpiSwiglu {
    static constexpr bool PERM = true, AFTER_DRAIN = false;
    const float* b1; bf16_t* act;
    __device__ __forceinline__ void operator()(const f32x4 (&acc)[2][2][4][2], const Unit& un, int wr, int wc, int fr, int fq) const {
        const int e = un.pn >> 3, n8 = un.pn & 7, row0 = un.pm * BM + wr * 64 + fr, col0 = n8 * HALF + wc * 32 + 8 * fq;
        const float* bp = b1 + (size_t)e * 2048 + col0;
        const f32x4 bg0 = *(const f32x4*)(bp), bg1 = *(const f32x4*)(bp + 4), bl0 = *(const f32x4*)(bp + 1024), bl1 = *(const f32x4*)(bp + 1028);
#pragma unroll
        for (int ai = 0; ai < 2; ++ai)
#pragma unroll
            for (int m = 0; m < 4; ++m) {
                f32x4 g0 = acc[ai][0][m][0] + bg0, g1 = acc[ai][0][m][1] + bg1, l0 = acc[ai][1][m][0] + bl0, l1 = acc[ai][1][m][1] + bl1, o0, o1;
#pragma unroll
                for (int j = 0; j < 4; ++j) {
                    const float ga = fminf(g0[j], 7.0f), gb = fminf(g1[j], 7.0f);
                    const float la = fminf(fmaxf(l0[j], -7.0f), 7.0f), lb = fminf(fmaxf(l1[j], -7.0f), 7.0f);
                    o0[j] = (la + 1.0f) * ga * sigmoidf_fast(1.702f * ga); o1[j] = (lb + 1.0f) * gb * sigmoidf_fast(1.702f * gb); }
                u32x4 w; w.x = cvt_pk_bf16(o0[0], o0[1]); w.y = cvt_pk_bf16(o0[2], o0[3]); w.z = cvt_pk_bf16(o1[0], o1[1]); w.w = cvt_pk_bf16(o1[2], o1[3]);
                *(u32x4*)(act + (size_t)(row0 + ai * HALF + m * 16) * 1024 + col0) = w; }
    }
};
struct EpiDown {
    static constexpr bool PERM = true, AFTER_DRAIN = false;
    const float* b2; const float* roww; bf16_t* Y;
    __device__ __forceinline__ void operator()(const f32x4 (&acc)[2][2][4][2], const Unit& un, int wr, int wc, int fr, int fq) const {
        const int e = un.pn >> 2, n4 = un.pn & 3, row0 = un.pm * BM + wr * 64 + fr, col0 = n4 * BM + wc * 32 + 8 * fq;
        const float* bp = b2 + (size_t)e * 1024 + col0;
        f32x4 bv[2][2];
#pragma unroll
        for (int bj = 0; bj < 2; ++bj)
#pragma unroll
            for (int n = 0; n < 2; ++n) bv[bj][n] = *(const f32x4*)(bp + bj * HALF + 4 * n);
#pragma unroll
        for (int ai = 0; ai < 2; ++ai)
#pragma unroll
            for (int m = 0; m < 4; ++m) { const int row = row0 + ai * HALF + m * 16; const float rw = roww[row];
#pragma unroll
                for (int bj = 0; bj < 2; ++bj) { const f32x4 v0 = (acc[ai][bj][m][0] + bv[bj][0]) * rw, v1 = (acc[ai][bj][m][1] + bv[bj][1]) * rw;
                    u32x4 w; w.x = cvt_pk_bf16(v0[0], v0[1]); w.y = cvt_pk_bf16(v0[2], v0[3]); w.z = cvt_pk_bf16(v1[0], v1[1]); w.w = cvt_pk_bf16(v1[2], v1[3]);
                    *(u32x4*)(Y + (size_t)row * 1024 + col0 + bj * HALF) = w; } }
    }
};
struct ListOrder {
    const PG8_LAS unsigned* list;
    __device__ __forceinline__ bool next(int i, Unit& u) const { const unsigned w = (unsigned)__builtin_amdgcn_readfirstlane((int)list[i]); if (w == 0xffffffffu) return false; u.pm = (int)(w & 0xffffu); u.pn = (int)(w >> 16); return true; }
    __device__ __forceinline__ void a_ready(const Unit&) const {}
    __device__ __forceinline__ void done(const Unit&) const {}
};
template <class Epi, class Sched, bool ALIGN_EPI = false, bool SP2 = false>
__device__ __forceinline__ void gemm_phase(PG8_LAS unsigned char* lds, const Gemm g, const Sched& S, const Epi& E) {
    const int tid = threadIdx.x, wid = __builtin_amdgcn_readfirstlane(tid >> 6), lane = tid & 63, wr = wid >> 2, wc = wid & 3, fr = lane & 15, fq = lane >> 4;
    const int K = g.K, nt = K / BK;
    unsigned voffA[2], voffB[2];
#pragma unroll
    for (int i = 0; i < 2; ++i) { int R, C; stage_rc(tid * 16 + i * 8192, R, C); const int Rb = Epi::PERM ? ((R & ~31) + perm32(R & 31)) : R;
        voffA[i] = (unsigned)(R * K + C) * 2u; voffB[i] = (unsigned)(Rb * K + C) * 2u; }
    const size_t kstep = (size_t)(BK * 2);
    const size_t hstep = (size_t)HALF * K * 2;
    const size_t tstep = 2 * hstep;
    const unsigned ldsw = (unsigned)wid * 1024u;
    const int aoff = lds_byte(wr * 64 + fr, fq * 8), boff = lds_byte(wc * 32 + fr, fq * 8);
#define PG8_SA(b, h) (((b) * 2 + (h)) * HTB)
#define PG8_SB(b, h) ((4 + (b) * 2 + (h)) * HTB)
#define PG8_STAGE(bufoff, gbase, voff) do { _Pragma("unroll") for (int _i = 0; _i < 2; ++_i) \
        __builtin_amdgcn_global_load_lds((const unsigned*)((const char*)(gbase) + (voff)[_i]), (PG8_LAS unsigned*)(lds + (bufoff) + ldsw + _i * 8192), 16, 0, 0); } while (0)
#define PG8_LDA(dst, b, h) do { _Pragma("unroll") for (int m = 0; m < 4; ++m) _Pragma("unroll") for (int k = 0; k < 2; ++k) dst[m][k] = *(const PG8_LAS bf16x8*)(lds + PG8_SA(b, h) + aoff + m * 2048 + k * 1024); } while (0)
#define PG8_LDB(dst, b, h) do { _Pragma("unroll") for (int n = 0; n < 2; ++n) _Pragma("unroll") for (int k = 0; k < 2; ++k) dst[n][k] = *(const PG8_LAS bf16x8*)(lds + PG8_SB(b, h) + boff + n * 2048 + k * 1024); } while (0)
#define PG8_MMA(ai, bj, At, Bt) do { __builtin_amdgcn_s_setprio(1); _Pragma("unroll") for (int m = 0; m < 4; ++m) _Pragma("unroll") for (int n = 0; n < 2; ++n) _Pragma("unroll") for (int k = 0; k < 2; ++k) \
        acc[ai][bj][m][n] = __builtin_amdgcn_mfma_f32_16x16x32_bf16(Bt[n][k], At[m][k], acc[ai][bj][m][n], 0, 0, 0); __builtin_amdgcn_s_setprio(0); } while (0)
#define PG8_WAIT_V(n) asm volatile("s_waitcnt vmcnt(" #n ")" ::: "memory")
#define PG8_WAIT_L(n) asm volatile("s_waitcnt lgkmcnt(" #n ")" ::: "memory")
#define PG8_BAR __builtin_amdgcn_s_barrier()
#define PG8_SCHED __builtin_amdgcn_sched_barrier(0)
    Unit cur, nxt; int ui = 0;
    if (!S.next(0, cur)) return;
    f32x4 acc[2][2][4][2];
#pragma unroll
    for (int a = 0; a < 2; ++a)
#pragma unroll
        for (int b = 0; b < 2; ++b)
#pragma unroll
            for (int m = 0; m < 4; ++m)
#pragma unroll
                for (int n = 0; n < 2; ++n) acc[a][b][m][n] = (f32x4){0.f, 0.f, 0.f, 0.f};
    bf16x8 At[4][2], B0[2][2], B1[2][2];
    const char* cA = (const char*)g.A + (size_t)cur.pm * tstep; const char* cB = (const char*)g.Bt + (size_t)cur.pn * tstep;
    S.a_ready(cur);
    if constexpr (SP2) {
        PG8_STAGE(PG8_SB(0, 0), cB, voffB); PG8_STAGE(PG8_SB(0, 1), cB + hstep, voffB); PG8_STAGE(PG8_SA(0, 0), cA, voffA); PG8_STAGE(PG8_SA(0, 1), cA + hstep, voffA);
        if (wr == 1) PG8_BAR;
        PG8_WAIT_V(2); PG8_BAR;
        PG8_STAGE(PG8_SB(1, 0), cB + kstep, voffB); PG8_STAGE(PG8_SA(1, 0), cA + kstep, voffA); PG8_STAGE(PG8_SB(1, 1), cB + hstep + kstep, voffB);
        PG8_WAIT_V(6); PG8_BAR;
    } else {
        PG8_STAGE(PG8_SB(0, 0), cB, voffB); PG8_STAGE(PG8_SA(0, 0), cA, voffA); PG8_STAGE(PG8_SB(0, 1), cB + hstep, voffB); PG8_STAGE(PG8_SA(0, 1), cA + hstep, voffA);
        if (wr == 1) PG8_BAR;
        PG8_WAIT_V(4); PG8_BAR;
        PG8_STAGE(PG8_SB(1, 0), cB + kstep, voffB); PG8_STAGE(PG8_SA(1, 0), cA + kstep, voffA); PG8_STAGE(PG8_SB(1, 1), cB + hstep + kstep, voffB);
        PG8_WAIT_V(6); PG8_BAR;
    }
    for (;;) {
        const bool has_next = S.next(ui + 1, nxt);
        const char* nA = has_next ? (const char*)g.A + (size_t)nxt.pm * tstep : cA; const char* nB = has_next ? (const char*)g.Bt + (size_t)nxt.pn * tstep : cB;
        for (int t = 0; t < nt; t += 2) {
            const bool last = (t == nt - 2);
            const char* a1 = cA + (size_t)(t + 1) * kstep;
            const char* a2 = last ? nA : cA + (size_t)(t + 2) * kstep; const char* b2 = last ? nB : cB + (size_t)(t + 2) * kstep;
            const char* a3 = a2 + kstep; const char* b3 = b2 + kstep;
            if (last && has_next) S.a_ready(nxt);
            if constexpr (SP2) {
            PG8_LDB(B0, 0, 0); PG8_LDB(B1, 0, 1); PG8_SCHED; PG8_LDA(At, 0, 0); PG8_STAGE(PG8_SA(1, 1), a1 + hstep, voffA);
            PG8_WAIT_V(8); PG8_WAIT_L(0); PG8_BAR; PG8_MMA(0, 0, At, B0); PG8_MMA(0, 1, At, B1); PG8_BAR; PG8_SCHED;
            PG8_LDA(At, 0, 1); PG8_STAGE(PG8_SB(0, 0), b2, voffB); PG8_STAGE(PG8_SB(0, 1), b2 + hstep, voffB); PG8_STAGE(PG8_SA(0, 0), a2, voffA);
            PG8_WAIT_V(8); PG8_WAIT_L(0); PG8_BAR; PG8_MMA(1, 0, At, B0); PG8_MMA(1, 1, At, B1); PG8_BAR; PG8_SCHED;
            PG8_LDB(B0, 1, 0); PG8_LDB(B1, 1, 1); PG8_SCHED; PG8_LDA(At, 1, 0); PG8_STAGE(PG8_SA(0, 1), a2 + hstep, voffA);
            PG8_WAIT_V(8); PG8_WAIT_L(0); PG8_BAR; PG8_MMA(0, 0, At, B0); PG8_MMA(0, 1, At, B1); PG8_BAR; PG8_SCHED;
            PG8_LDA(At, 1, 1); PG8_STAGE(PG8_SB(1, 0), b3, voffB); PG8_STAGE(PG8_SB(1, 1), b3 + hstep, voffB); PG8_STAGE(PG8_SA(1, 0), a3, voffA);
            PG8_WAIT_V(8); PG8_WAIT_L(0); PG8_BAR; PG8_MMA(1, 0, At, B0); PG8_MMA(1, 1, At, B1); PG8_BAR; PG8_SCHED;
            } else {
            PG8_LDB(B0, 0, 0); PG8_SCHED; PG8_LDA(At, 0, 0); PG8_STAGE(PG8_SA(1, 1), a1 + hstep, voffA);
            PG8_WAIT_L(8); PG8_BAR; PG8_WAIT_L(0); PG8_MMA(0, 0, At, B0); PG8_BAR; PG8_SCHED;
            PG8_LDB(B1, 0, 1); PG8_STAGE(PG8_SB(0, 0), b2, voffB);
            PG8_BAR; PG8_WAIT_L(0); PG8_MMA(0, 1, At, B1); PG8_BAR;
            PG8_LDA(At, 0, 1); PG8_STAGE(PG8_SA(0, 0), a2, voffA);
            PG8_BAR; PG8_WAIT_L(0); PG8_MMA(1, 0, At, B0); PG8_BAR; PG8_SCHED;
            PG8_STAGE(PG8_SB(0, 1), b2 + hstep, voffB);
            PG8_WAIT_V(6); PG8_BAR; PG8_MMA(1, 1, At, B1); PG8_BAR;
            PG8_LDB(B0, 1, 0); PG8_SCHED; PG8_LDA(At, 1, 0); PG8_STAGE(PG8_SA(0, 1), a2 + hstep, voffA);
            PG8_WAIT_L(8); PG8_BAR; PG8_WAIT_L(0); PG8_MMA(0, 0, At, B0); PG8_BAR; PG8_SCHED;
            PG8_LDB(B1, 1, 1); PG8_STAGE(PG8_SB(1, 0), b3, voffB);
            PG8_BAR; PG8_WAIT_L(0); PG8_MMA(0, 1, At, B1); PG8_BAR;
            PG8_LDA(At, 1, 1); PG8_STAGE(PG8_SA(1, 0), a3, voffA);
            PG8_BAR; PG8_WAIT_L(0); PG8_MMA(1, 0, At, B0); PG8_BAR; PG8_SCHED;
            PG8_STAGE(PG8_SB(1, 1), b3 + hstep, voffB);
            PG8_WAIT_V(6); PG8_BAR; PG8_MMA(1, 1, At, B1); PG8_BAR;
            }
        }
        if constexpr (ALIGN_EPI) { if (wr == 0) PG8_BAR; }
        if constexpr (!Epi::AFTER_DRAIN) { E(acc, cur, wr, wc, fr, fq); S.done(cur); }
        if (!has_next) break;
#pragma unroll
        for (int a = 0; a < 2; ++a)
#pragma unroll
            for (int b = 0; b < 2; ++b)
#pragma unroll
                for (int m = 0; m < 4; ++m)
#pragma unroll
                    for (int n = 0; n < 2; ++n) acc[a][b][m][n] = (f32x4){0.f, 0.f, 0.f, 0.f};
        cur = nxt; cA = nA; cB = nB; ++ui;
        if constexpr (ALIGN_EPI) { if (wr == 1) PG8_BAR; }
    }
    PG8_WAIT_V(0);
    if constexpr (!ALIGN_EPI) { if (wr == 0) PG8_BAR; }
    PG8_BAR;
    if constexpr (Epi::AFTER_DRAIN) { E.fused(acc, cur, wr, wc, fr, fq, lds, wid, lane); S.done(cur); }
#undef PG8_SA
#undef PG8_SB
#undef PG8_STAGE
#undef PG8_LDA
#undef PG8_LDB
#undef PG8_MMA
#undef PG8_WAIT_V
#undef PG8_WAIT_L
#undef PG8_BAR
#undef PG8_SCHED
}
}
namespace attn_body {
using bf16=__hip_bfloat16;
using bf16x8=__attribute__((ext_vector_type(8)))short;
using s16x4=__attribute__((ext_vector_type(4)))short;
using f32x16=__attribute__((ext_vector_type(16)))float;
using u32x4=__attribute__((ext_vector_type(4)))unsigned;
constexpr int BATCH=2,NHEAD=8,SEQ=8192,D=64,DM=NHEAD*D,OPITCH=1024;
constexpr int NW=8,QBLK=32,QB=QBLK*NW,KVBLK=64,NQB=SEQ/QB;
__device__ __forceinline__ int crow(int r,int hi){return (r&3)+8*(r>>2)+4*hi;}
#define SBAR() __builtin_amdgcn_sched_barrier(0)
constexpr int NSLOT=3, SLOTB=8192;
constexpr int LDS_K=0, LDS_V=NSLOT*SLOTB, LDS_WS=2*NSLOT*SLOTB, LDS_OST=LDS_WS+NW*64*4, LDS_BYTES=LDS_OST+NW*4096;
constexpr float C2=0.125f*1.4426950408889634f;
__device__ __forceinline__ void glds16(const void*gsrc,unsigned lds_dst){unsigned keep;
  asm volatile("s_mov_b32 %0, m0\n\ts_mov_b32 m0, %2\n\ts_nop 0\n\tglobal_load_lds_dwordx4 %1, off\n\ts_mov_b32 m0, %0":"=&s"(keep):"v"(gsrc),"s"(lds_dst):"memory");}
__device__ __forceinline__ unsigned long long gld8(const unsigned long long*sbase,unsigned voff){unsigned long long r; asm volatile("global_load_dwordx2 %0, %1, %2":"=&v"(r):"v"(voff),"s"(sbase):"memory"); return r;}
typedef float f32x2_t __attribute__((ext_vector_type(2))); typedef __bf16 bf16x2_t __attribute__((ext_vector_type(2)));
__device__ __forceinline__ unsigned cvtpk_s(float lo,float hi){f32x2_t v={lo,hi};bf16x2_t b=__builtin_convertvector(v,bf16x2_t);return __builtin_bit_cast(unsigned,b);}

__device__ __forceinline__ void qkt(f32x16&p0,f32x16&p1,const char*Kslot,const bf16x8*qr,int r32,int hi){
  const f32x16 negm=f32x16{};
  const char*kb=Kslot+hi*1024+r32*16;
  #pragma unroll
  for(int d0=0;d0<4;++d0){
    const bf16x8 b0=*reinterpret_cast<const bf16x8*>(kb+d0*2048);
    const bf16x8 b1=*reinterpret_cast<const bf16x8*>(kb+d0*2048+512);
    if(d0==0){p0=__builtin_amdgcn_mfma_f32_32x32x16_bf16(b0,qr[0],negm,0,0,0);p1=__builtin_amdgcn_mfma_f32_32x32x16_bf16(b1,qr[0],negm,0,0,0);}
    else{p0=__builtin_amdgcn_mfma_f32_32x32x16_bf16(b0,qr[d0],p0,0,0,0);p1=__builtin_amdgcn_mfma_f32_32x32x16_bf16(b1,qr[d0],p1,0,0,0);}}
}
typedef __attribute__((address_space(3))) const char* lds_cptr;
typedef short v4i16_t __attribute__((ext_vector_type(4)));
__device__ __forceinline__ void kload8(bf16x8*kf,lds_cptr kp){
  kf[0]=*(const __attribute__((address_space(3))) bf16x8*)(kp);      kf[1]=*(const __attribute__((address_space(3))) bf16x8*)(kp+512);
  kf[2]=*(const __attribute__((address_space(3))) bf16x8*)(kp+2048); kf[3]=*(const __attribute__((address_space(3))) bf16x8*)(kp+2560);
  kf[4]=*(const __attribute__((address_space(3))) bf16x8*)(kp+4096); kf[5]=*(const __attribute__((address_space(3))) bf16x8*)(kp+4608);
  kf[6]=*(const __attribute__((address_space(3))) bf16x8*)(kp+6144); kf[7]=*(const __attribute__((address_space(3))) bf16x8*)(kp+6656);
}
__device__ __forceinline__ void kload2(bf16x8*kf,lds_cptr kp,int j){ kf[2*j]=*(const __attribute__((address_space(3))) bf16x8*)(kp+j*2048); kf[2*j+1]=*(const __attribute__((address_space(3))) bf16x8*)(kp+j*2048+512); }
__device__ __forceinline__ s16x4 vtr(lds_cptr p){ return __builtin_bit_cast(s16x4,__builtin_amdgcn_ds_read_tr16_b64_v4i16((__attribute__((address_space(3))) v4i16_t*)p)); }
__device__ __forceinline__ void pv(f32x16*o,int vb,bf16x8 pa0,bf16x8 pa1,bf16x8 pa2,bf16x8 pa3){
  #pragma unroll
  for(int d0=0;d0<2;++d0){s16x4 lo[4],hi[4];
    #pragma unroll
    for(int ks=0;ks<4;++ks){
      asm volatile("ds_read_b64_tr_b16 %0,%1 offset:%c2":"=&v"(lo[ks]):"v"(vb),"i"(d0*4096+ks*1024):"memory");
      asm volatile("ds_read_b64_tr_b16 %0,%1 offset:%c2":"=&v"(hi[ks]):"v"(vb),"i"(d0*4096+ks*1024+512):"memory");}
    asm volatile("s_waitcnt lgkmcnt(0)":::"memory");SBAR();
    #define PK(k) (bf16x8){lo[k][0],lo[k][1],lo[k][2],lo[k][3],hi[k][0],hi[k][1],hi[k][2],hi[k][3]}
    o[d0]=__builtin_amdgcn_mfma_f32_32x32x16_bf16(pa0,PK(0),o[d0],0,0,0);
    o[d0]=__builtin_amdgcn_mfma_f32_32x32x16_bf16(pa1,PK(1),o[d0],0,0,0);
    o[d0]=__builtin_amdgcn_mfma_f32_32x32x16_bf16(pa2,PK(2),o[d0],0,0,0);
    o[d0]=__builtin_amdgcn_mfma_f32_32x32x16_bf16(pa3,PK(3),o[d0],0,0,0);
    #undef PK
  }
}
#define MSK(v,w,r) __uint_as_float(__float_as_uint(v)&(unsigned)__builtin_amdgcn_sbfe((int)(w),((r)&3)+8*((r)>>2),1))

__device__ __forceinline__ void attn_unit(int b,int h,int qb,const bf16*Q,const bf16*__restrict__ K,const bf16*__restrict__ V,bf16*O,const unsigned long long*MK,float cshift,char*shm){
  const int tid=threadIdx.x,lane=tid&63,r32=lane&31,hi=lane>>5; const int wid=__builtin_amdgcn_readfirstlane(tid>>6);
  const long rowbase=(long)b*SEQ; const int q0=qb*QB;
  const bf16*Qw=Q+(rowbase+q0+wid*QBLK)*DM+h*D;
  const bf16*Kh=K+rowbase*DM+h*D,*Vh=V+rowbase*DM+h*D;
  const unsigned lds0=(unsigned)(uintptr_t)shm;
  float*wsf=(float*)(shm+LDS_WS)+wid*64;
  const bf16*ksrc=Kh+(long)lane*DM+wid*8;
  const bf16*vsrc=Vh+(long)(16*(wid&3)+(lane>>2))*DM+(wid>>2)*32+(lane&3)*8;
  const unsigned kdst=lds0+LDS_K+wid*1024, vdst=lds0+LDS_V+wid*1024;
  #define DMA_K(t,slot) glds16(ksrc+(long)(t)*KVBLK*DM,(unsigned)__builtin_amdgcn_readfirstlane(kdst+(slot)))
  #define DMA_V(t,slot) glds16(vsrc+(long)(t)*KVBLK*DM,(unsigned)__builtin_amdgcn_readfirstlane(vdst+(slot)))
  const int vb0=(int)(lds0+LDS_V)+((lane>>4)&1)*32+(lane&3)*8+(4*hi+((lane&15)>>2))*64;
  const char*Kbase=shm+LDS_K; bf16x8 kf[8];
  const lds_cptr shm3=(lds_cptr)shm; const lds_cptr kp0=shm3+LDS_K+hi*1024+r32*16; const lds_cptr vp0=shm3+LDS_V+((lane>>4)&1)*32+(lane&3)*8+(4*hi+((lane&15)>>2))*64;
  const int NT=(q0+QB)/KVBLK;
  const unsigned long long*mbase=MK+(size_t)b*(SEQ/KVBLK)*SEQ; const unsigned moff=(unsigned)(q0+wid*QBLK+r32)*8u;
  DMA_K(0,0);DMA_V(0,0);DMA_K(1,SLOTB);
  bf16x8 qr[4];
  #pragma unroll
  for(int d0=0;d0<4;++d0)qr[d0]=*reinterpret_cast<const bf16x8*>(&Qw[(long)r32*DM+d0*16+hi*8]);
  unsigned long long mC=gld8(mbase,moff), mN=gld8(mbase+SEQ,moff);
  float l_reg=0.f;f32x16 o[2];o[0]=f32x16{};o[1]=f32x16{};const f32x16 negm=f32x16{};
  (void)cshift;
  #define WAIT_BAR(N) asm volatile("s_waitcnt vmcnt(" #N ") lgkmcnt(0)\n\ts_barrier":"+v"(mN),"+v"(mC)::"memory")
  f32x16 pA0,pA1,pB0,pB1;
  int sl_prev=0,sl_cur=0,sl_next=SLOTB;
  #define ROT() do{sl_prev=sl_cur;sl_cur=sl_next;sl_next=(sl_next==(NSLOT-1)*SLOTB)?0:sl_next+SLOTB;}while(0)
  DMA_K(2,2*SLOTB);
  WAIT_BAR(3);
  qkt(pA0,pA1,Kbase,qr,r32,hi);asm volatile("s_nop 15\n\ts_nop 7":"+v"(pA0),"+v"(pA1));
  _Pragma("unroll") for(int r=0;r<16;++r){pA0[r]=__builtin_amdgcn_exp2f(pA0[r]);pA1[r]=__builtin_amdgcn_exp2f(pA1[r]);}
  WAIT_BAR(0);
  { const unsigned ma_=(unsigned)mC>>(4*hi), mb_=(unsigned)(mC>>32)>>(4*hi);
    _Pragma("unroll") for(int r=0;r<16;++r){pA0[r]=MSK(pA0[r],ma_,r);pA1[r]=MSK(pA1[r],mb_,r);} }
  DMA_K(3,0);DMA_V(1,SLOTB);
  ROT();
  kload8(kf,kp0+sl_cur);
  WAIT_BAR(2);
  s16x4 vlo[8],vhi[8]; u32x4 pw0,pw1,pw2,pw3;
  #define PKW(P,B) cvtpk_s(P[B],P[B+1])
  #define PAF(k) __builtin_bit_cast(bf16x8,pw##k)
  #define VFR(i) (bf16x8){vlo[i][0],vlo[i][1],vlo[i][2],vlo[i][3],vhi[i][0],vhi[i][1],vhi[i][2],vhi[i][3]}
  #define PIN(x) asm volatile("":"+v"(x))
  #define GAPA(MF,A0,A1,A2,A3,W0,W1,PW) do{ MF; sacc+=A0; sacc+=A1; sacc+=A2; sacc+=A3; PIN(sacc); W0; W1; PIN(PW); SBAR(); }while(0)
  #define EX(v) __builtin_amdgcn_exp2f(v)
  #define GAPB(MF,X,B,W) do{ MF; X[B]=MSK(EX(X[B]),W,B); X[B+1]=MSK(EX(X[B+1]),W,B+1); X[B+2]=MSK(EX(X[B+2]),W,B+2); X[B+3]=MSK(EX(X[B+3]),W,B+3); PIN(X); SBAR(); }while(0)
  #define VRD(i) do{ vlo[i]=vtr(vp_+(((i)>>2)*4096+((i)&3)*1024)); vhi[i]=vtr(vp_+(((i)>>2)*4096+((i)&3)*1024+512)); }while(0)
  #define KRD(G,j) do{ if(G){ kload2(kf,kp0+sl_next,j); SBAR(); } }while(0)
  #define STEP(C0,C1,P0,P1,t,GK,GV,GL) do{ SBAR(); \
    const unsigned ma_=(unsigned)mN>>(4*hi), mb_=(unsigned)(mN>>32)>>(4*hi); \
    if((t)+1<NT){ mN=gld8(mbase+(size_t)((t)+1)*SEQ,moff); } \
    const lds_cptr vp_=vp0+sl_prev; \
    VRD(0); SBAR(); float sacc=(P0[0]+P0[1]); \
    GAPA(C0=__builtin_amdgcn_mfma_f32_32x32x16_bf16(kf[0],qr[0],negm,0,0,0), P0[2],P0[3],P0[4],P0[5],     pw0[0]=PKW(P0,0), pw0[1]=PKW(P0,2), pw0); \
    VRD(4); SBAR(); GAPA(C1=__builtin_amdgcn_mfma_f32_32x32x16_bf16(kf[1],qr[0],negm,0,0,0), P0[6],P0[7],P0[8],P0[9],     pw0[2]=PKW(P0,4), pw0[3]=PKW(P0,6), pw0); \
    VRD(1); SBAR(); GAPA(C0=__builtin_amdgcn_mfma_f32_32x32x16_bf16(kf[2],qr[1],C0,0,0,0),   P0[10],P0[11],P0[12],P0[13], pw1[0]=PKW(P0,8), pw1[1]=PKW(P0,10), pw1); \
    VRD(5); SBAR(); GAPA(C1=__builtin_amdgcn_mfma_f32_32x32x16_bf16(kf[3],qr[1],C1,0,0,0),   P0[14],P0[15],P1[0],P1[1],   pw1[2]=PKW(P0,12),pw1[3]=PKW(P0,14), pw1); \
    VRD(2); SBAR(); GAPA(C0=__builtin_amdgcn_mfma_f32_32x32x16_bf16(kf[4],qr[2],C0,0,0,0),   P1[2],P1[3],P1[4],P1[5],     pw2[0]=PKW(P1,0), pw2[1]=PKW(P1,2), pw2); \
    VRD(6); SBAR(); GAPA(C1=__builtin_amdgcn_mfma_f32_32x32x16_bf16(kf[5],qr[2],C1,0,0,0),   P1[6],P1[7],P1[8],P1[9],     pw2[2]=PKW(P1,4), pw2[3]=PKW(P1,6), pw2); \
    VRD(3); SBAR(); GAPA(C0=__builtin_amdgcn_mfma_f32_32x32x16_bf16(kf[6],qr[3],C0,0,0,0),   P1[10],P1[11],P1[12],P1[13], pw3[0]=PKW(P1,8), pw3[1]=PKW(P1,10), pw3); \
    VRD(7); SBAR(); GAPA(C1=__builtin_amdgcn_mfma_f32_32x32x16_bf16(kf[7],qr[3],C1,0,0,0),   P1[14],P1[15],0.f,0.f,       pw3[2]=PKW(P1,12),pw3[3]=PKW(P1,14), pw3); \
    l_reg+=sacc; \
    if(GK){DMA_K((t)+3,sl_cur);} if(GV){DMA_V((t)+1,sl_next);} \
    SBAR(); \
    GAPB(o[0]=__builtin_amdgcn_mfma_f32_32x32x16_bf16(PAF(0),VFR(0),o[0],0,0,0), C0,0,ma_); \
    GAPB(o[1]=__builtin_amdgcn_mfma_f32_32x32x16_bf16(PAF(0),VFR(4),o[1],0,0,0), C0,4,ma_); \
    KRD(GL,0); GAPB(o[0]=__builtin_amdgcn_mfma_f32_32x32x16_bf16(PAF(1),VFR(1),o[0],0,0,0), C0,8,ma_); \
    KRD(GL,1); GAPB(o[1]=__builtin_amdgcn_mfma_f32_32x32x16_bf16(PAF(1),VFR(5),o[1],0,0,0), C0,12,ma_); \
    KRD(GL,2); GAPB(o[0]=__builtin_amdgcn_mfma_f32_32x32x16_bf16(PAF(2),VFR(2),o[0],0,0,0), C1,0,mb_); \
    KRD(GL,3); GAPB(o[1]=__builtin_amdgcn_mfma_f32_32x32x16_bf16(PAF(2),VFR(6),o[1],0,0,0), C1,4,mb_); \
    GAPB(o[0]=__builtin_amdgcn_mfma_f32_32x32x16_bf16(PAF(3),VFR(3),o[0],0,0,0), C1,8,mb_); \
    GAPB(o[1]=__builtin_amdgcn_mfma_f32_32x32x16_bf16(PAF(3),VFR(7),o[1],0,0,0), C1,12,mb_); \
    }while(0)
  int t=1;
  for(;t+5<NT;t+=2){
    STEP(pB0,pB1,pA0,pA1,t,true,true,true);     WAIT_BAR(2); ROT();
    STEP(pA0,pA1,pB0,pB1,t+1,true,true,true);   WAIT_BAR(2); ROT();
  }
  #define ENDW(tt) do{ if((tt)+3<NT){WAIT_BAR(2);} else if((tt)+2<NT){WAIT_BAR(1);} else {WAIT_BAR(0);} }while(0)
  for(;t+1<NT;t+=2){
    STEP(pB0,pB1,pA0,pA1,t,(t+3<NT),(t+1<NT),(t+1<NT));       ENDW(t);   ROT();
    STEP(pA0,pA1,pB0,pB1,t+1,(t+4<NT),(t+2<NT),(t+2<NT));     ENDW(t+1); ROT();
  }
  STEP(pB0,pB1,pA0,pA1,NT-1,false,false,false);
  { float sacc=pB0[0]+pB0[1]; _Pragma("unroll") for(int r=2;r<16;++r)sacc+=pB0[r]; _Pragma("unroll") for(int r=0;r<16;++r)sacc+=pB1[r]; l_reg+=sacc;
    pw0=(u32x4){PKW(pB0,0),PKW(pB0,2),PKW(pB0,4),PKW(pB0,6)};pw1=(u32x4){PKW(pB0,8),PKW(pB0,10),PKW(pB0,12),PKW(pB0,14)};pw2=(u32x4){PKW(pB1,0),PKW(pB1,2),PKW(pB1,4),PKW(pB1,6)};pw3=(u32x4){PKW(pB1,8),PKW(pB1,10),PKW(pB1,12),PKW(pB1,14)};
    SBAR(); pv(o,vb0+sl_cur,PAF(0),PAF(1),PAF(2),PAF(3)); }
  #undef PKW
  #undef PAF
  #undef VFR
  #undef PIN
  #undef GAPA
  #undef GAPB
  #undef EX
  #undef VRD
  #undef KRD
  #undef STEP
  #undef ENDW
  {auto rr=__builtin_amdgcn_permlane32_swap(__float_as_uint(l_reg),__float_as_uint(l_reg),false,false);l_reg=__uint_as_float(rr[0])+__uint_as_float(rr[1]);}
  if(hi==0)wsf[32+r32]=l_reg;asm volatile("s_waitcnt lgkmcnt(0)":::"memory");
  float rli[16];
  #pragma unroll
  for(int r=0;r<16;++r)rli[r]=__builtin_amdgcn_rcpf(wsf[32+crow(r,hi)]);
  bf16*Ow=O+(rowbase+q0+wid*QBLK)*OPITCH+h*D;
  { bf16*stg=(bf16*)(shm+LDS_OST)+wid*2048;
    #pragma unroll
    for(int r=0;r<16;++r){const int orow=crow(r,hi);
      #pragma unroll
      for(int d0=0;d0<2;++d0)stg[orow*64+d0*32+r32]=__float2bfloat16(o[d0][r]*rli[r]);}
    asm volatile("s_waitcnt lgkmcnt(0)":::"memory");
    #pragma unroll
    for(int i=0;i<4;++i){const int row=i*8+(lane>>3),ch=lane&7; const u32x4 v=*(const u32x4*)(stg+row*64+ch*8); *(u32x4*)(Ow+(long)row*OPITCH+ch*8)=v;} }
  asm volatile("s_waitcnt lgkmcnt(0)\n\ts_barrier":::"memory");
  #undef DMA_K
  #undef DMA_V
  #undef ROT
  #undef WAIT_BAR
}
#undef MSK
constexpr int ATTN_LDS_BYTES=LDS_BYTES;
#undef SBAR
}
#define XB_TMO      128
#define XB_XCNT(j)  (256  + 64 * (j))
#define XB_XSUB(j)  (1280 + 64 * (j))
#define XB_XGEN(j)  (2304 + 64 * (j))
#define XB_TOP      3328
#define XB_TOPGEN   3392
#define XCD_BAR_WORDS 3456
#define XB_SPIN_CAP (1u << 18)

__device__ __forceinline__ unsigned xb_ld(unsigned* p)              { return __hip_atomic_load(p, __ATOMIC_RELAXED, __HIP_MEMORY_SCOPE_AGENT); }
__device__ __forceinline__ unsigned xb_add(unsigned* p, unsigned v) { return __hip_atomic_fetch_add(p, v, __ATOMIC_RELAXED, __HIP_MEMORY_SCOPE_AGENT); }
__device__ __forceinline__ unsigned xb_xcc_id() { return (unsigned)__builtin_amdgcn_s_getreg((3 << 11) | 20) & 0xFu; }
#define XB_SPIN(cond, bar) do { unsigned _sp = 0; while (cond) { __builtin_amdgcn_s_sleep(1); \
    if ((++_sp & 255u) == 0u) { if (xb_ld(&(bar)[XB_TMO])) break; if (_sp > XB_SPIN_CAP) { atomicAdd(&(bar)[XB_TMO], 1u); break; } } } } while (0)

struct XcdBarrier {
    unsigned* bar; unsigned x;
    volatile LAS unsigned* st;
};

__device__ __forceinline__ XcdBarrier xcd_barrier_post(unsigned* bar, volatile LAS unsigned* st) {
    XcdBarrier b; b.bar = bar; b.x = xb_xcc_id(); b.st = st;
    if (threadIdx.x == 0) (void)xb_add(&bar[XB_XCNT(b.x)], 1u);
    return b;
}
__device__ __forceinline__ void xcd_barrier_complete(unsigned* bar, unsigned x, unsigned& nloc, unsigned& nx) {
    const unsigned G = gridDim.x * gridDim.y * gridDim.z;
    unsigned sum, cnt, mine, sp = 0u;
    for (;;) {
        sum = 0u; cnt = 0u; mine = 0u;
#pragma unroll
        for (unsigned j = 0; j < 16; ++j) { const unsigned c = xb_ld(&bar[XB_XCNT(j)]); sum += c; cnt += (c > 0u) ? 1u : 0u; mine = (j == x) ? c : mine; }
        if (sum == G) break;
        __builtin_amdgcn_s_sleep(1);
        if ((++sp & 255u) == 0u) { if (xb_ld(&bar[XB_TMO])) break; if (sp > XB_SPIN_CAP) { atomicAdd(&bar[XB_TMO], 1u); break; } }
    }
    nloc = mine > 0u ? mine : 1u; nx = cnt > 0u ? cnt : 1u;
}

__device__ __forceinline__ void xcd_barrier(const XcdBarrier& b) {
    asm volatile("s_waitcnt vmcnt(0)" ::: "memory");
    __syncthreads();
    if (threadIdx.x == 0) {
        unsigned* bar = b.bar;
        __builtin_amdgcn_s_waitcnt(0);
        unsigned nloc = b.st[0], nx = b.st[1];
        if (nloc == 0u) { xcd_barrier_complete(bar, b.x, nloc, nx); b.st[0] = nloc; b.st[1] = nx; }
        const unsigned old = xb_add(&bar[XB_XSUB(b.x)], 1u);
        const unsigned gen = old / nloc;
        if (old + 1u == (gen + 1u) * nloc) {
            __builtin_amdgcn_fence(__ATOMIC_RELEASE, "agent");
            asm volatile("s_waitcnt vmcnt(0)" ::: "memory");
            const unsigned og = xb_add(&bar[XB_TOP], 1u);
            const unsigned tg = og / nx;
            if (og + 1u == (tg + 1u) * nx) xb_add(&bar[XB_TOPGEN], 1u);
            else XB_SPIN(xb_ld(&bar[XB_TOPGEN]) == tg, bar);
            __builtin_amdgcn_fence(__ATOMIC_ACQUIRE, "agent");
            xb_add(&bar[XB_XGEN(b.x)], 1u);
            asm volatile("s_waitcnt vmcnt(0)" ::: "memory");
        } else {
            XB_SPIN(xb_ld(&bar[XB_XGEN(b.x)]) == gen, bar);
            __builtin_amdgcn_fence(__ATOMIC_ACQUIRE, "agent");
            asm volatile("s_waitcnt vmcnt(0)" ::: "memory");
        }
    }
    __syncthreads();
}
struct Frame {
    LAS unsigned char* lds;
    volatile LAS unsigned* MISC;
    gu32* ctl;
    int tid, lane, wave;
    int vcu, G;
    unsigned char* ws;
    const float* in[18]; float* out;
};
__device__ __forceinline__ float wave_sum(float v) {
#pragma unroll
    for (int o = 1; o < 64; o <<= 1) v += __shfl_xor(v, o);
    return v;
}
__device__ __forceinline__ float wave_max(float v) {
#pragma unroll
    for (int o = 1; o < 64; o <<= 1) v = fmaxf(v, __shfl_xor(v, o));
    return v;
}
template <int MODE> __device__ __forceinline__ int tr_row(int n) {
    if (MODE == 0) return n < 1860 ? n : n + 188;
    if (MODE == 1) return n < 1024 ? 256 * (n >> 7) + (n & 127) : 256 * ((n - 1024) >> 7) + 128 + ((n - 1024) & 127);
    if (MODE == 4) return 256 * (n >> 7) + (n & 127);
    if (MODE == 5) return 256 * (n >> 7) + 128 + (n & 127);
    return n;
}
template <int MODE> __device__ __forceinline__ void tr_item(const float* W, int N, bf16* WT, int ldt, int koff, LAS float* scr, int kb, int nb, int lane) {
    const int k0 = 64 * kb, n0 = 32 * nb; const bool colok = (n0 + (lane & 31)) < N;
#pragma unroll 8
    for (int i = 0; i < 32; ++i) { const int kk = 2 * i + (lane >> 5); scr[kk * 33 + (lane & 31)] = colok ? W[(size_t)(k0 + kk) * N + n0 + (lane & 31)] : 0.f; }
    LDS_WAIT(); asm volatile("" ::: "memory");
    const int c = lane & 7;
#pragma unroll
    for (int j = 0; j < 4; ++j) { const int n = (lane >> 3) + 8 * j; const LAS float* s = scr + (8 * c) * 33 + n;
        v4u o; o.x = pk2(s[0 * 33], s[1 * 33]); o.y = pk2(s[2 * 33], s[3 * 33]); o.z = pk2(s[4 * 33], s[5 * 33]); o.w = pk2(s[6 * 33], s[7 * 33]);
        if (n0 + n < N) *(GAS v4u*)(WT + (size_t)tr_row<MODE>(n0 + n) * ldt + koff + k0 + 8 * c) = o; }
    LDS_WAIT(); asm volatile("" ::: "memory");
}
__device__ __forceinline__ void rms_row_to_bf16(const float* xrow, const float* g, bf16* orow, int lane) {
    const GAS f32x4* xr = (const GAS f32x4*)xrow + lane; const GAS f32x4* gr = (const GAS f32x4*)g + lane;
    f32x4 v[4]; float s = 0.f;
#pragma unroll
    for (int j = 0; j < 4; ++j) { v[j] = xr[64 * j]; s += (v[j].x * v[j].x + v[j].y * v[j].y) + (v[j].z * v[j].z + v[j].w * v[j].w); }
    const float r = 1.0f / sqrtf(wave_sum(s) * (1.f / 1024.f) + EPS);
    GAS unsigned long long* o8 = (GAS unsigned long long*)orow + lane;
#pragma unroll
    for (int j = 0; j < 4; ++j) { const f32x4 gv = gr[64 * j]; o8[64 * j] = (unsigned long long)pk2(v[j].x * r * gv.x, v[j].y * r * gv.y) | ((unsigned long long)pk2(v[j].z * r * gv.z, v[j].w * r * gv.w) << 32); }
}
__device__ __forceinline__ void p0_prologue(Frame& F) {
    LAS float* scr = (LAS float*)(F.lds + RING_OFF + F.wave * 16384);
    const int gw = F.vcu * NWAVES + F.wave, NGW = F.G * NWAVES;
    bf16* Win_t = (bf16*)(F.ws + WS_WIN); bf16* Wab_t = (bf16*)(F.ws + WS_WAB); bf16* Wout_t = (bf16*)(F.ws + WS_WOUT); bf16* Wpool_t = (bf16*)(F.ws + WS_WPOOL);
    bf16* W1_t = (bf16*)(F.ws + WS_W1); bf16* W2_t = (bf16*)(F.ws + WS_W2);
    constexpr int I_W1 = 32 * 16 * 64, I_W2 = 32 * 16 * 32, I_IN = 16 * 139, I_OUT = 16 * 32, I_WA = 8 * 32, I_WB = 8 * 32, I_POOL = 32;
    constexpr int NITEMS = I_W1 + I_W2 + I_IN + I_OUT + I_WA + I_WB + I_POOL;
    for (int it = gw; it < NITEMS; it += NGW) {
        int r = it;
        if (r < I_W1) { const int e = r >> 10, rr = r & 1023; tr_item<1>(F.in[14] + (size_t)e * 1024 * 2048, 2048, W1_t + (size_t)e * 2048 * 1024, 1024, 0, scr, rr >> 6, rr & 63, F.lane); continue; } r -= I_W1;
        if (r < I_W2) { const int e = r >> 9, rr = r & 511; tr_item<2>(F.in[16] + (size_t)e * 1024 * 1024, 1024, W2_t + (size_t)e * 1024 * 1024, 1024, 0, scr, rr >> 5, rr & 31, F.lane); continue; } r -= I_W2;
        if (r < I_IN) { tr_item<0>(F.in[2], NIN, Win_t, 1024, 0, scr, r / 139, r % 139, F.lane); continue; } r -= I_IN;
        if (r < I_OUT) { tr_item<2>(F.in[10], 1024, Wout_t, 1024, 0, scr, r >> 5, r & 31, F.lane); continue; } r -= I_OUT;
        if (r < I_WA) { tr_item<4>(F.in[8], 1024, Wab_t, 1024, 0, scr, r >> 5, r & 31, F.lane); continue; } r -= I_WA;
        if (r < I_WB) { tr_item<5>(F.in[9], 1024, Wab_t, 1024, 512, scr, r >> 5, r & 31, F.lane); continue; } r -= I_WB;
        { const int g = r >> 3, rr = r & 7; tr_item<2>(F.in[5] + (size_t)g * 128 * 128, 128, Wpool_t + (size_t)(128 * g) * 512, 512, 128 * g, scr, rr >> 2, rr & 3, F.lane); }
    }
    const int gt = F.vcu * (NWAVES * 64) + F.tid, NGT = F.G * NWAVES * 64; const v4u z = {0u, 0u, 0u, 0u};
    for (int i = gt; i < 2048 * 64; i += NGT) { const int row = i >> 6, ch = i & 63; *(GAS v4u*)(Wab_t + (size_t)row * 1024 + (((row & 255) < 128) ? 512 : 0) + ch * 8) = z; }
    for (int i = gt; i < 512 * 64; i += NGT) { const int row = i >> 6, ch = i & 63; if ((ch >> 4) != (row >> 7)) *(GAS v4u*)(Wpool_t + (size_t)row * 512 + ch * 8) = z; }
    for (int i = gt; i < 188 * 128; i += NGT) { const int row = 1860 + (i >> 7), ch = i & 127; *(GAS v4u*)(Win_t + (size_t)row * 1024 + ch * 8) = z; }
    bf16* H = (bf16*)(F.ws + WS_H);
    for (int m = gw; m < M; m += NGW) rms_row_to_bf16(F.in[0] + (size_t)m * 1024, F.in[1], H + (size_t)m * 1024, F.lane);
}
__device__ __forceinline__ void qknorm_rows(Frame& F, bool dry = false) {
    const int gw = F.vcu * NWAVES + F.wave, NGW = F.G * NWAVES, lane = F.lane;
    bf16* Q = (bf16*)(F.ws + WS_Q); bf16* K = (bf16*)(F.ws + WS_K);
    const int d0 = (lane & 7) * 8;
    float gq[8], gk[8];
#pragma unroll
    for (int j = 0; j < 8; ++j) { gq[j] = F.in[3][d0 + j] * attn_body::C2; gk[j] = F.in[4][d0 + j]; }
    for (int m0 = gw; m0 < 2 * M; m0 += 4 * NGW) {
        v4u w[4]; bf16* p[4]; bool isq[4];
#pragma unroll
        for (int u = 0; u < 4; ++u) { const int m = m0 + u * NGW; isq[u] = m < M; p[u] = (isq[u] ? Q + (size_t)m * 512 : K + (size_t)(m - M) * 512) + lane * 8; w[u] = (m < 2 * M) ? *(const GAS v4u*)p[u] : (v4u){0u, 0u, 0u, 0u}; }
#pragma unroll
        for (int u = 0; u < 4; ++u) { if (m0 + u * NGW >= 2 * M) break;
            float x[8] = {bflo(w[u].x), bfhi(w[u].x), bflo(w[u].y), bfhi(w[u].y), bflo(w[u].z), bfhi(w[u].z), bflo(w[u].w), bfhi(w[u].w)};
            float s = 0.f;
#pragma unroll
            for (int j = 0; j < 8; ++j) s += x[j] * x[j];
            s += __shfl_xor(s, 1); s += __shfl_xor(s, 2); s += __shfl_xor(s, 4);
            const float r = 1.0f / sqrtf(s * (1.f / 64.f) + EPS);
#pragma unroll
            for (int j = 0; j < 8; ++j) x[j] = x[j] * r * (isq[u] ? gq[j] : gk[j]);
            v4u o; o.x = pk2(x[0], x[1]); o.y = pk2(x[2], x[3]); o.z = pk2(x[4], x[5]); o.w = pk2(x[6], x[7]);
            *(GAS v4u*)p[u] = dry ? w[u] : o; }
    }
}
__device__ __forceinline__ void pool_diff_rows(Frame& F) {
    const int gw = F.vcu * NWAVES + F.wave, NGW = F.G * NWAVES, lane = F.lane;
    const bf16* U = (const bf16*)(F.ws + WS_U); bf16* Dd = (bf16*)(F.ws + WS_DIFF);
    const int win = 2 << (lane >> 4);
    for (int m = gw; m < M; m += NGW) {
        const int t = m & (SEQ - 1); const int cnt = (t + 1 < win) ? t + 1 : win;
        v4u w[16];
#pragma unroll
        for (int j = 0; j < 16; ++j) w[j] = (j < cnt) ? *(const GAS v4u*)(U + (size_t)(m - j) * 512 + lane * 8) : (v4u){0u, 0u, 0u, 0u};
        float a[8] = {0.f, 0.f, 0.f, 0.f, 0.f, 0.f, 0.f, 0.f};
#pragma unroll
        for (int j = 0; j < 16; ++j) { a[0] += bflo(w[j].x); a[1] += bfhi(w[j].x); a[2] += bflo(w[j].y); a[3] += bfhi(w[j].y); a[4] += bflo(w[j].z); a[5] += bfhi(w[j].z); a[6] += bflo(w[j].w); a[7] += bfhi(w[j].w); }
        const float inv = 1.0f / (float)cnt; v4u o;
        o.x = pk2(a[0] * inv - bflo(w[0].x), a[1] * inv - bfhi(w[0].x)); o.y = pk2(a[2] * inv - bflo(w[0].y), a[3] * inv - bfhi(w[0].y));
        o.z = pk2(a[4] * inv - bflo(w[0].z), a[5] * inv - bfhi(w[0].z)); o.w = pk2(a[6] * inv - bflo(w[0].w), a[7] * inv - bfhi(w[0].w));
        *(GAS v4u*)(Dd + (size_t)m * 512 + lane * 8) = o;
    }
}
__device__ __forceinline__ int tk_fidx(int q) { return (((q >> 3) * 2 + (q & 1)) * 4) + ((q & 7) >> 1); }
__device__ __forceinline__ float relu_f(float x) { const int b = __builtin_bit_cast(int, x); return __builtin_bit_cast(float, b > 0 ? b : 0); }
__device__ __forceinline__ unsigned wave_incl_scan(unsigned v, int lane) {
    v += (unsigned)__builtin_amdgcn_update_dpp(0, (int)v, 0x111, 0xf, 0xf, false);
    v += (unsigned)__builtin_amdgcn_update_dpp(0, (int)v, 0x112, 0xf, 0xf, false);
    v += (unsigned)__builtin_amdgcn_update_dpp(0, (int)v, 0x114, 0xf, 0xf, false);
    v += (unsigned)__builtin_amdgcn_update_dpp(0, (int)v, 0x118, 0xf, 0xf, false);
    const unsigned t0 = (unsigned)__builtin_amdgcn_readlane((int)v, 15), t1 = (unsigned)__builtin_amdgcn_readlane((int)v, 31), t2 = (unsigned)__builtin_amdgcn_readlane((int)v, 47);
    return v + (lane >= 16 ? t0 : 0u) + (lane >= 32 ? t1 : 0u) + (lane >= 48 ? t2 : 0u);
}
struct TkState {
    LAS unsigned char* lds;
    __device__ __forceinline__ LAS unsigned* x(int words) const { return (LAS unsigned*)(lds + XTRA_OFF) + words; }
    __device__ __forceinline__ LAS unsigned* hist_() const { return (LAS unsigned*)(lds + RING_OFF); }
    __device__ __forceinline__ LAS unsigned long long* clist_() const { return (LAS unsigned long long*)(lds + XTRA_OFF + 4096); }
    __device__ __forceinline__ const LAS bf16x8* afl_() const { return (const LAS bf16x8*)(lds + RING_OFF + 131072); }
#define TK_F(name, off) __device__ __forceinline__ LAS unsigned* name() const { return x(off); }
    TK_F(sl_lb_, 0)
    TK_F(sl_p1_, 32)
    TK_F(sl_p2_, 64)
    TK_F(sl_lo_, 96)
    TK_F(sl_hi_, 128)
    TK_F(sl_kth_, 160)
    TK_F(need_, 192)
    TK_F(neq_, 224)
    TK_F(ccnt_, 256)
    TK_F(cmin_, 288)
    TK_F(cmax_, 320)
    TK_F(flag_, 352)
    TK_F(wl_, 448)
#undef TK_F
};
constexpr int TK_CAP = 32;
template <int MODE> __device__ __forceinline__ void tk_scan(const TkState& T, int wave, int lane_in, bool MID) {
    int lane = lane_in; asm volatile("" : "+v"(lane));
    for (int qq = 0; qq < 4; ++qq) {
        const int q = 4 * wave + qq, fi = tk_fidx(q); LAS unsigned* hq = T.hist_() + q * 1024;
        bool up;
        int base;
        unsigned pre = 0u;
        if (MODE == 2) { pre = MID ? T.sl_p1_()[fi] : T.sl_p2_()[fi]; const bool neg = MID ? (pre >= 512u) : (pre >= (512u << 11)); up = neg; base = neg ? 16 * lane : 1024 - 16 * (lane + 1); }
        else { up = lane >= 32; base = up ? 512 + 16 * (lane - 32) : 512 - 16 * (lane + 1); }
        unsigned dr[16], d[16];
#pragma unroll
        for (int i = 0; i < 4; ++i) { const v4u v = *(const LAS v4u*)(hq + base + 4 * i); dr[4 * i] = v.x; dr[4 * i + 1] = v.y; dr[4 * i + 2] = v.z; dr[4 * i + 3] = v.w;
            if (MODE != 1) *(LAS v4u*)(hq + base + 4 * i) = (v4u){0u, 0u, 0u, 0u}; }
#pragma unroll
        for (int i = 0; i < 16; ++i) d[i] = up ? dr[i] : dr[15 - i];
        unsigned s = 0u;
#pragma unroll
        for (int i = 0; i < 16; ++i) s += (MODE == 2) ? ((d[i] & 0xffffu) + (d[i] >> 16)) : d[i];
        const unsigned inc = wave_incl_scan(s, lane);
        const unsigned nd = (MODE == 1) ? (unsigned)TOPK : T.need_()[q];
        const unsigned long long bal = __ballot(inc >= nd);
        if (MODE == 1 && bal == 0ull) continue;
        const int Ls = __builtin_amdgcn_readfirstlane(bal ? (int)__ffsll((long long)bal) - 1 : 63);
        unsigned run = inc - s, fpos = 0u, fneed = 1u, fcnt = 1u; bool found = false;
#pragma unroll
        for (int i = 0; i < 16; ++i) {
            if (MODE != 2) { const unsigned c = d[i]; if (!found && run + c >= nd) { found = true; fpos = (unsigned)i; fneed = nd - run; fcnt = c; } run += c; }
            else { const unsigned c0 = up ? (d[i] & 0xffffu) : (d[i] >> 16), c1 = up ? (d[i] >> 16) : (d[i] & 0xffffu);
                if (!found && run + c0 >= nd) { found = true; fpos = 2u * i; fneed = nd - run; fcnt = c0; } run += c0;
                if (!found && run + c1 >= nd) { found = true; fpos = 2u * i + 1u; fneed = nd - run; fcnt = c1; } run += c1; }
        }
        unsigned fbin;
        if (MODE != 2) fbin = up ? (unsigned)base + fpos : (unsigned)base + 15u - fpos;
        else { const unsigned dw = up ? (unsigned)base + (fpos >> 1) : (unsigned)base + 15u - (fpos >> 1); fbin = 2u * dw + (up ? (fpos & 1u) : 1u - (fpos & 1u)); }
        fbin = (unsigned)__builtin_amdgcn_readlane((int)fbin, Ls); fneed = (unsigned)__builtin_amdgcn_readlane((int)fneed, Ls); fcnt = (unsigned)__builtin_amdgcn_readlane((int)fcnt, Ls);
        if (lane == 0) {
            if (MODE == 1) T.sl_lb_()[fi] = fbin < 512u ? (fbin << 22) : ((fbin << 22) | 0x3fffffu);
            if (MODE == 0) { T.sl_p1_()[fi] = fbin; T.need_()[q] = fneed; T.neq_()[q] = fcnt; }
            if (MODE == 2 && MID) { const unsigned p21 = (pre << 11) | fbin, a = p21 << 11, bb = a | 0x7ffu; const bool neg = pre >= 512u;
                T.sl_p2_()[fi] = p21; T.sl_lo_()[fi] = neg ? bb : a; T.sl_hi_()[fi] = neg ? a : bb; T.need_()[q] = fneed; T.neq_()[q] = fcnt; }
            if (MODE == 2 && !MID) { const unsigned kth = (pre << 11) | fbin; T.sl_lo_()[fi] = kth; T.sl_hi_()[fi] = kth; T.need_()[q] = fneed; T.neq_()[q] = fcnt; }
        }
    }
}
template <int PASS> __device__ __forceinline__ void topk_pass(const bf16x8 (&af)[4][4], const LAS f32x4* wl4, const bf16* IKb, int nb, const TkState& T, int wave, int lane_in, bool low, unsigned one = 1u) {
    int lane = lane_in; asm volatile("" : "+v"(lane));
    const int hi = lane >> 5, n32 = lane & 31;
    const unsigned sh_m = low ? 11u : 22u, sh_b = low ? 0u : 11u;
    LAS unsigned* GT = T.hist_(); LAS unsigned* EQ = T.hist_() + 32 * 257;
    const bf16* kp0 = IKb + (size_t)lane * 8;
    bf16x8 bc[4];
    if (wave < nb) {
#pragma unroll
        for (int kk = 0; kk < 4; ++kk) bc[kk] = *(const GAS bf16x8*)(kp0 + (size_t)wave * 2048 + 512 * kk); }
    const LAS v4u* pa = (const LAS v4u*)(PASS == 2 ? T.sl_lo_() : (low ? T.sl_p2_() : T.sl_p1_()));
    const LAS v4u* pb = (const LAS v4u*)T.sl_hi_();
    for (int blk = wave; blk < nb; blk += 8) {
        f32x4 wq[4]; v4u pfv, pgv;
#define TK_LDW(qg) do { _Pragma("unroll") for (int jj = 0; jj < 4; ++jj) wq[jj] = wl4[((qg) * 2 + hi) * 4 + jj]; pfv = pa[(qg) * 2 + hi]; if (PASS == 2) pgv = pb[(qg) * 2 + hi]; } while (0)
        f32x16 acc[2];
#define TK_MMA(dst, qg) do { dst = f32x16{}; _Pragma("unroll") for (int kk = 0; kk < 4; ++kk) dst = __builtin_amdgcn_mfma_f32_32x32x16_bf16(af[qg][kk], bc[kk], dst, 0, 0, 0); } while (0)
        TK_MMA(acc[0], 0);
#pragma unroll
        for (int qg = 0; qg < 4; ++qg) {
            TK_LDW(qg);
            if (qg < 3) TK_MMA(acc[(qg + 1) & 1], qg + 1);
            if (qg == 2 && blk + 8 < nb) {
#pragma unroll
                for (int kk = 0; kk < 4; ++kk) bc[kk] = *(const GAS bf16x8*)(kp0 + (size_t)(blk + 8) * 2048 + 512 * kk); }
            const f32x16& a = acc[qg & 1];
#define TK_PIN4(x) asm volatile("" : "+v"(x[0]), "+v"(x[1]), "+v"(x[2]), "+v"(x[3]))
            float sc[4], r0[4], r1[4], r2[4], r3[4];
#pragma unroll
            for (int jj = 0; jj < 4; ++jj) { r0[jj] = relu_f(a[4 * jj + 0]); r1[jj] = relu_f(a[4 * jj + 1]); r2[jj] = relu_f(a[4 * jj + 2]); r3[jj] = relu_f(a[4 * jj + 3]); }
            TK_PIN4(r0); TK_PIN4(r1); TK_PIN4(r2); TK_PIN4(r3);
#pragma unroll
            for (int jj = 0; jj < 4; ++jj) sc[jj] = fmaf(wq[jj][0], r0[jj], 0.f);
            TK_PIN4(sc);
#pragma unroll
            for (int jj = 0; jj < 4; ++jj) sc[jj] = fmaf(wq[jj][1], r1[jj], sc[jj]);
            TK_PIN4(sc);
#pragma unroll
            for (int jj = 0; jj < 4; ++jj) sc[jj] = fmaf(wq[jj][2], r2[jj], sc[jj]);
            TK_PIN4(sc);
#pragma unroll
            for (int jj = 0; jj < 4; ++jj) sc[jj] = fmaf(wq[jj][3], r3[jj], sc[jj]);
            TK_PIN4(sc);
#undef TK_PIN4
            LAS unsigned* hq0 = T.hist_() + (8 * qg + hi) * 1024;
            if (PASS == 0) {
#pragma unroll
                for (int jj = 0; jj < 4; ++jj) __hip_atomic_fetch_add(hq0 + jj * 2048 + (__float_as_uint(sc[jj]) >> 22), one, __ATOMIC_RELAXED, __HIP_MEMORY_SCOPE_WORKGROUP); }
            if (PASS == 1) {
#pragma unroll
                for (int jj = 0; jj < 4; ++jj) { const unsigned u = __float_as_uint(sc[jj]); if ((u >> sh_m) == pfv[jj]) { const unsigned bin = (u >> sh_b) & 0x7ffu; __hip_atomic_fetch_add(hq0 + jj * 2048 + (bin >> 1), one << ((bin & 1u) * 16u), __ATOMIC_RELAXED, __HIP_MEMORY_SCOPE_WORKGROUP); } } }
            if (PASS == 2) {
                unsigned long long bg[4], be[4]; unsigned long long anye = 0ull;
#pragma unroll
                for (int jj = 0; jj < 4; ++jj) {
                    bg[jj] = __ballot(sc[jj] > __uint_as_float(pgv[jj])); be[jj] = __ballot(sc[jj] >= __uint_as_float(pfv[jj])) & ~bg[jj];
                    anye |= be[jj]; }
                unsigned vg = 0u;
#pragma unroll
                for (int jj = 0; jj < 4; ++jj) { vg = (lane == 2 * jj) ? (unsigned)bg[jj] : vg; vg = (lane == 2 * jj + 1) ? (unsigned)(bg[jj] >> 32) : vg; }
                if (lane < 8) GT[(8 * qg + lane) * 257 + blk] = vg;
                if (anye != 0ull) {
                    unsigned ve = 0u;
#pragma unroll
                    for (int jj = 0; jj < 4; ++jj) { ve = (lane == 2 * jj) ? (unsigned)be[jj] : ve; ve = (lane == 2 * jj + 1) ? (unsigned)(be[jj] >> 32) : ve; }
                    if (lane < 8) EQ[(8 * qg + lane) * 257 + blk] = ve;
                    if (!low) {
#pragma unroll
                        for (int jj = 0; jj < 4; ++jj) { if ((be[jj] >> lane) & 1ull) { const int q = 8 * qg + 2 * jj + hi; const unsigned u = __float_as_uint(sc[jj]);
                            const unsigned slot = __hip_atomic_fetch_add(T.ccnt_() + q, 1u, __ATOMIC_RELAXED, __HIP_MEMORY_SCOPE_WORKGROUP);
                            __hip_atomic_fetch_min(T.cmin_() + q, u, __ATOMIC_RELAXED, __HIP_MEMORY_SCOPE_WORKGROUP); __hip_atomic_fetch_max(T.cmax_() + q, u, __ATOMIC_RELAXED, __HIP_MEMORY_SCOPE_WORKGROUP);
                            if (slot < (unsigned)TK_CAP) T.clist_()[q * TK_CAP + slot] = ((unsigned long long)u << 32) | (unsigned)(32 * blk + n32); } } }
                }
            }
        }
#undef TK_MMA
#undef TK_LDW
#undef TK_LDA
    }
}
__device__ __forceinline__ void tk_keep_first(LAS unsigned* eqr, unsigned nd, int lane) {
    unsigned w[4], pc = 0u;
#pragma unroll
    for (int i = 0; i < 4; ++i) { w[i] = eqr[4 * lane + i]; pc += (unsigned)__builtin_popcount(w[i]); }
    const unsigned inc = wave_incl_scan(pc, lane);
    unsigned before = inc - pc;
#pragma unroll
    for (int i = 0; i < 4; ++i) { const unsigned p = (unsigned)__builtin_popcount(w[i]); const int take = (int)nd - (int)before;
        if (take <= 0) w[i] = 0u; else if (take < (int)p) { unsigned x = w[i], r = 0u; for (int k = 0; k < take; ++k) { const unsigned lsb = x & (0u - x); r |= lsb; x ^= lsb; } w[i] = r; }
        before += p; eqr[4 * lane + i] = w[i]; }
}
__device__ __forceinline__ void topk_unit(Frame& F, int b, int c, int half) {
    const bf16* IQ = (const bf16*)(F.ws + WS_IQ); const bf16* IK = (const bf16*)(F.ws + WS_IK); const float* IW = (const float*)(F.ws + WS_IW);
    unsigned long long* MK = (unsigned long long*)(F.ws + WS_MASK);
    TkState T; T.lds = F.lds;
    LAS float* wl = (LAS float*)T.wl_();
    LAS unsigned* GT = T.hist_(); LAS unsigned* EQ = T.hist_() + 32 * 257;
    int tid = F.tid; asm volatile("" : "+v"(tid));
    const int lane = tid & 63, wave = F.wave;
    const int t0 = 64 * c + 32 * half, L = 64 * (c + 1), nb = L / 32; const size_t tokb = (size_t)b * SEQ;
    const int ntile = 4 * (c / 4 + 1);
#pragma unroll
    for (int i = 0; i < 16; ++i) ((LAS v4u*)T.hist_())[tid + 512 * i] = (v4u){0u, 0u, 0u, 0u};
    if (tid < 32) { T.sl_lb_()[tid] = 0xff800000u  ; T.need_()[tid] = (unsigned)TOPK; T.neq_()[tid] = 0u; T.ccnt_()[tid] = 0u; T.cmin_()[tid] = 0xffffffffu; T.cmax_()[tid] = 0u; if (tid == 0) T.flag_()[0] = 0u; }
    if (tid < 128) { const int q = tid >> 2, hd = tid & 3; wl[tk_fidx(q) * 4 + hd] = IW[(tokb + t0 + q) * 4 + hd] * 0.0625f; }
    __syncthreads();
    if (L > TOPK) {
        const LAS f32x4* wr = (const LAS f32x4*)wl;
        bf16x8 af[4][4];
#pragma unroll
        for (int qg = 0; qg < 4; ++qg)
#pragma unroll
            for (int kk = 0; kk < 4; ++kk) af[qg][kk] = *(const GAS bf16x8*)(IQ + (tokb + t0 + 8 * qg) * 256 + (lane & 31) * 64 + 16 * kk + 8 * (lane >> 5));
        const bf16* IKb = IK + tokb * 64;
        if ((REP_PHASE) == 22) topk_pass<0>(af, wr, IKb, nb, T, wave, lane, false, 0u);
        topk_pass<0>(af, wr, IKb, nb, T, wave, lane, false); __syncthreads(); tk_scan<0>(T, wave, lane, true); __syncthreads();
        for (int round = 0; round < 2; ++round) {
            const bool low = round != 0;
            if (low) { if (T.flag_()[0] == 0u && (REP_PHASE) != 50) break;
                __syncthreads();
#pragma unroll
                for (int i = 0; i < 16; ++i) ((LAS v4u*)T.hist_())[tid + 512 * i] = (v4u){0u, 0u, 0u, 0u};
                __syncthreads(); }
            if ((REP_PHASE) == 23) topk_pass<1>(af, wr, IKb, nb, T, wave, lane, low, 0u);
            topk_pass<1>(af, wr, IKb, nb, T, wave, lane, low); __syncthreads(); tk_scan<2>(T, wave, lane, !low); __syncthreads();
            for (int rep_ = 0; rep_ < ((REP_PHASE) == 20 ? 2 : 1); ++rep_) { if (rep_) { __syncthreads(); if (tid < 32) { T.ccnt_()[tid] = 0u; } __syncthreads(); } topk_pass<2>(af, wr, IKb, nb, T, wave, lane, low); }
            __syncthreads();
            for (int qq = 0; qq < 4; ++qq) { const int q = 4 * wave + qq; const unsigned nd = T.need_()[q], nc = T.neq_()[q];
                if (nd >= nc) continue;
                if (low || T.cmin_()[q] == T.cmax_()[q]) { tk_keep_first(EQ + q * 257, nd, lane); continue; }
                if (nc <= (unsigned)TK_CAP && (TK_CAP) > 0) {
                    const unsigned long long me = (lane < (int)nc) ? T.clist_()[q * TK_CAP + lane] : 0ull; const float mv = __uint_as_float((unsigned)(me >> 32)); const unsigned mi = (unsigned)me; unsigned rank = 0u;
                    for (unsigned j = 0; j < nc; ++j) { const unsigned long long o = T.clist_()[q * TK_CAP + j]; const float ov = __uint_as_float((unsigned)(o >> 32)); const unsigned oi = (unsigned)o; rank += (ov > mv || (ov == mv && oi < mi)) ? 1u : 0u; }
                    if (lane < (int)nc && rank >= nd) __hip_atomic_fetch_and(EQ + q * 257 + (mi >> 5), ~(1u << (mi & 31u)), __ATOMIC_RELAXED, __HIP_MEMORY_SCOPE_WORKGROUP);
                    continue; }
                if (lane == 0) T.flag_()[0] = 1u;
            }
            __syncthreads();
            if ((REP_PHASE) == 50 && low) { if (tid < 32) T.ccnt_()[tid] = 0u; __syncthreads(); }
            for (int idx = tid; idx < 32 * ntile; idx += NWAVES * 64) { const int q = idx & 31, t = idx >> 5;
                const unsigned w0 = GT[q * 257 + 2 * t] | EQ[q * 257 + 2 * t], w1 = GT[q * 257 + 2 * t + 1] | EQ[q * 257 + 2 * t + 1];
                const unsigned long long wv = (unsigned long long)w0 | ((unsigned long long)w1 << 32); unsigned long long* dst = MK + ((size_t)b * 128 + t) * SEQ + t0 + q;
                if ((REP_PHASE) == 50 && low) { if (*dst != wv) __hip_atomic_store(F.ctl + CW_CODE, 1u, RLX_AGENT); __hip_atomic_fetch_add(T.ccnt_() + q, (unsigned)__builtin_popcountll(wv), __ATOMIC_RELAXED, __HIP_MEMORY_SCOPE_WORKGROUP); }
                else *dst = wv; }
            __syncthreads();
            if ((REP_PHASE) == 50 && low) { if (tid < 32 && T.ccnt_()[tid] != (unsigned)TOPK) __hip_atomic_store(F.ctl + CW_CODE, 1u, RLX_AGENT); __syncthreads(); }
        }
    } else {
        for (int idx = tid; idx < 32 * ntile; idx += NWAVES * 64) { const int q = idx & 31, t = idx >> 5;
            const unsigned w0 = (2 * t < nb) ? 0xffffffffu : 0u, w1 = (2 * t + 1 < nb) ? 0xffffffffu : 0u;
            MK[((size_t)b * 128 + t) * SEQ + t0 + q] = (unsigned long long)w0 | ((unsigned long long)w1 << 32); }
        __syncthreads();
    }
}
typedef float f32x16r __attribute__((ext_vector_type(16)));
__device__ __forceinline__ void router_phase(Frame& F, bool dry = false) {
    LAS float* tab = (LAS float*)(F.lds + RING_OFF);
    LAS float* xch = (LAS float*)(F.lds + RING_OFF + 131072);
    LAS float* ssq = (LAS float*)(F.lds + XTRA_OFF);
    LAS float* rs = ssq + 512;
    LAS unsigned* lc = (LAS unsigned*)(rs + 64);
    LAS unsigned* basep = lc + 32;
    LAS unsigned* rec_e = basep + 32; LAS unsigned* rec_r = rec_e + 256; LAS float* rec_w = (LAS float*)(rec_r + 256);
    const int tid = F.tid, lane = F.lane, wave = F.wave, m32 = lane & 31, kh = lane >> 5, tile = wave >> 2, kq = wave & 3;
    const float* x1 = F.out; const float* g2 = F.in[11]; const float* rw = F.in[12]; const float* rb = F.in[13];
    bf16* H2 = (bf16*)(F.ws + WS_H2); int* TOKE = (int*)(F.ws + WS_TOKE); int* TOKP = TOKE + M * 4; float* TOKW = (float*)(TOKP + M * 4);
    for (int i0 = tid; i0 < 1024 * 8; i0 += 4 * NWAVES * 64) { f32x4 v[4]; float g[4];
#pragma unroll
        for (int u = 0; u < 4; ++u) { const int i = i0 + u * NWAVES * 64; v[u] = *(const GAS f32x4*)(rw + (size_t)(i >> 3) * 32 + 4 * (i & 7)); g[u] = g2[i >> 3]; }
#pragma unroll
        for (int u = 0; u < 4; ++u) { const int i = i0 + u * NWAVES * 64, k = i >> 3, n0 = 4 * (i & 7); LAS float* d = tab + ((k >> 2) * 32 + n0) * 4 + (k & 3);
            d[0] = v[u].x * g[u]; d[4] = v[u].y * g[u]; d[8] = v[u].z * g[u]; d[12] = v[u].w * g[u]; } }
    if (tid < 32) lc[tid] = 0u;
    __syncthreads();
    for (int tb = blockIdx.x; tb < M / 64; tb += F.G) {
        {
            const size_t tok = (size_t)tb * 64 + tile * 32 + m32; const GAS f32x4* xr = (const GAS f32x4*)(x1 + tok * 1024) + 64 * kq + kh;
            const LAS f32x4* br = (const LAS f32x4*)tab + (size_t)(64 * kq + kh) * 32 + m32;
            f32x16r acc = {}; float ss = 0.f;
#pragma unroll 1
            for (int j0 = 0; j0 < 32; j0 += 8) { f32x4 xv[8];
#pragma unroll
                for (int u = 0; u < 8; ++u) xv[u] = xr[2 * (j0 + u)];
#pragma unroll
                for (int u = 0; u < 8; ++u) { const f32x4 bv = br[2 * (j0 + u) * 32]; const f32x4 x4 = xv[u];
                    ss += (x4.x * x4.x + x4.y * x4.y) + (x4.z * x4.z + x4.w * x4.w);
                    acc = __builtin_amdgcn_mfma_f32_32x32x2f32(x4.x, bv.x, acc, 0, 0, 0); acc = __builtin_amdgcn_mfma_f32_32x32x2f32(x4.y, bv.y, acc, 0, 0, 0);
                    acc = __builtin_amdgcn_mfma_f32_32x32x2f32(x4.z, bv.z, acc, 0, 0, 0); acc = __builtin_amdgcn_mfma_f32_32x32x2f32(x4.w, bv.w, acc, 0, 0, 0); } }
            ssq[(tile * 4 + kq) * 64 + lane] = ss;
            LAS float* xw = xch + ((tile * 2 + (kq >> 1)) * 16) * 64 + lane;
            if (kq & 1) {
#pragma unroll
                for (int r = 0; r < 16; ++r) xw[r * 64] = acc[r]; }
            __syncthreads();
            if (!(kq & 1)) {
#pragma unroll
                for (int r = 0; r < 16; ++r) acc[r] += xw[r * 64]; }
            if (tid < 64) { float q = 0.f;
#pragma unroll
                for (int u = 0; u < 4; ++u) q += ssq[((tid >> 5) * 4 + u) * 64 + (tid & 31)] + ssq[((tid >> 5) * 4 + u) * 64 + 32 + (tid & 31)];
                rs[tid] = 1.0f / sqrtf(q * (1.f / 1024.f) + EPS); }
            __syncthreads();
            LAS float* xw2 = xch + ((tile * 2) * 16) * 64 + lane;
            if (kq == 2) {
#pragma unroll
                for (int r = 0; r < 16; ++r) xw2[r * 64] = acc[r]; }
            __syncthreads();
            if (kq == 0) {
#pragma unroll
                for (int r = 0; r < 16; ++r) acc[r] += xw2[r * 64]; }
            __syncthreads();
            if (kq == 0) { const float bias = rb[m32];
#pragma unroll
                for (int r = 0; r < 16; ++r) { const int tk = (r & 3) + 8 * (r >> 2) + 4 * kh; xch[(tile * 32 + tk) * 33 + m32] = acc[r] * rs[tile * 32 + tk] + bias; } }
            __syncthreads();
        }
        if (tid < 64) {
            const LAS float* lg = xch + tid * 33; float bv[4] = {-INFINITY, -INFINITY, -INFINITY, -INFINITY}; int be[4] = {0, 0, 0, 0};
#pragma unroll
            for (int n = 0; n < 32; ++n) { float v = lg[n]; int e = n;
#pragma unroll
                for (int s2 = 0; s2 < 4; ++s2) { if (v > bv[s2]) { const float tv = bv[s2]; const int te = be[s2]; bv[s2] = v; be[s2] = e; v = tv; e = te; } } }
            const float p1 = __expf(bv[1] - bv[0]), p2 = __expf(bv[2] - bv[0]), p3 = __expf(bv[3] - bv[0]); const float inv = 1.0f / (1.0f + p1 + p2 + p3);
            const float pw[4] = {inv, p1 * inv, p2 * inv, p3 * inv};
            if (!dry) {
#pragma unroll
            for (int s2 = 0; s2 < 4; ++s2) { const unsigned rk = __hip_atomic_fetch_add(lc + be[s2], 1u, __ATOMIC_RELAXED, __HIP_MEMORY_SCOPE_WORKGROUP);
                rec_e[tid * 4 + s2] = (unsigned)be[s2]; rec_r[tid * 4 + s2] = rk; rec_w[tid * 4 + s2] = pw[s2]; } }
        }
        { const GAS f32x4* gr = (const GAS f32x4*)g2 + lane; f32x4 gv[4];
#pragma unroll
          for (int j = 0; j < 4; ++j) gv[j] = gr[64 * j];
          for (int h = 0; h < 2; ++h) { f32x4 v[4][4];
#pragma unroll
            for (int u = 0; u < 4; ++u) { const size_t t = (size_t)tb * 64 + wave * 8 + h * 4 + u; const GAS f32x4* xr = (const GAS f32x4*)(x1 + t * 1024) + lane;
#pragma unroll
                for (int j = 0; j < 4; ++j) v[u][j] = xr[64 * j]; }
#pragma unroll
            for (int u = 0; u < 4; ++u) { const int tl = wave * 8 + h * 4 + u; const size_t t = (size_t)tb * 64 + tl; const float r = rs[tl]; GAS unsigned long long* o8 = (GAS unsigned long long*)(H2 + t * 1024) + lane;
#pragma unroll
                for (int j = 0; j < 4; ++j) { const f32x4 y = v[u][j] * r * gv[j]; o8[64 * j] = (unsigned long long)pk2(y.x, y.y) | ((unsigned long long)pk2(y.z, y.w) << 32); } } } }
        __syncthreads();
        if (tid < 32) basep[tid] = __hip_atomic_fetch_add(F.ctl + CW_CNT + tid, lc[tid], RLX_AGENT);
        __syncthreads();
        if (tid < 256 && !dry) { const size_t p = (size_t)tb * 256 + tid; const unsigned me = rec_e[tid]; TOKE[p] = (int)me; TOKP[p] = (int)(basep[me] + rec_r[tid]); TOKW[p] = rec_w[tid]; }
        __syncthreads();
        if (tid < 32) lc[tid] = 0u;
        __syncthreads();
    }
}
__device__ __forceinline__ void moe_tables(Frame& F, LAS unsigned*& tpre, LAS unsigned*& cntl) {
    cntl = (LAS unsigned*)(F.lds + XTRA_OFF + 8192); tpre = cntl + 32;
    if (F.tid < 32) cntl[F.tid] = __hip_atomic_load(F.ctl + CW_CNT + F.tid, RLX_AGENT);
    __syncthreads();
    if (F.tid == 0) { unsigned a = 0u; for (int e = 0; e < 32; ++e) { tpre[e] = a; a += (cntl[e] + 255u) >> 8; } tpre[32] = a; }
    __syncthreads();
}
__device__ __forceinline__ LAS unsigned* moe_build_units(Frame& F, const LAS unsigned* tpre, int NT) {
    LAS unsigned* list = (LAS unsigned*)(F.lds + XTRA_OFF + 8192 + 512);
    if (F.tid < 24) { unsigned w = 0xffffffffu; const int U = (int)tpre[32] * NT; const long Lg = (long)F.tid * F.G + blockIdx.x;
        if (F.tid < 20 && Lg < U) { int wg = (int)Lg; { const int q = U / 8, r = U % 8, xcd = wg % 8, off = wg / 8; wg = (xcd < r ? xcd * (q + 1) : r * (q + 1) + (xcd - r) * q) + off; }
            int e = 0; while (e < 31 && wg >= (int)tpre[e + 1] * NT) ++e;
            const int rr = wg - (int)tpre[e] * NT, mt = (int)(tpre[e + 1] - tpre[e]); const int n = rr / mt, m = rr % mt;
            w = (unsigned)(tpre[e] + m) | ((unsigned)(e * NT + n) << 16); }
        list[F.tid] = w; }
    __syncthreads();
    return list;
}
__device__ __forceinline__ void gather_phase(Frame& F) {
    LAS unsigned* tpre; LAS unsigned* cntl; moe_tables(F, tpre, cntl);
    const int gw = F.vcu * NWAVES + F.wave, NGW = F.G * NWAVES, lane = F.lane;
    const bf16* H2 = (const bf16*)(F.ws + WS_H2); bf16* XP = (bf16*)(F.ws + WS_XP); float* ROWW = (float*)(F.ws + WS_ROWW);
    const int* TOKE = (const int*)(F.ws + WS_TOKE); const int* TOKP = TOKE + M * 4; const float* TOKW = (const float*)(TOKP + M * 4); int* TOKR = (int*)(TOKW + M * 4);
    for (int p0 = gw * 32; p0 < M * 4; p0 += NGW * 32) {
        const int p = p0 + (lane & 31); const int e = TOKE[p]; const int myrow = (int)tpre[e] * 256 + TOKP[p];
        if (lane < 32) { TOKR[p] = myrow; ROWW[myrow] = TOKW[p]; }
        for (int i = 0; i < 32; i += 4) { v4u a[4], bq[4]; int rw[4];
#pragma unroll
            for (int u = 0; u < 4; ++u) { rw[u] = __builtin_amdgcn_readlane(myrow, i + u); const GAS v4u* src = (const GAS v4u*)(H2 + (size_t)((p0 + i + u) >> 2) * 1024); a[u] = src[lane]; bq[u] = src[lane + 64]; }
#pragma unroll
            for (int u = 0; u < 4; ++u) { GAS v4u* dst = (GAS v4u*)(XP + (size_t)rw[u] * 1024); dst[lane] = a[u]; dst[lane + 64] = bq[u]; } }
    }
    for (int i = gw; i < 32 * 256; i += NGW) { const int e = i >> 8; const int row = (int)tpre[e] * 256 + (int)cntl[e] + (i & 255);
        if (row < (int)tpre[e + 1] * 256) { GAS v4u* dst = (GAS v4u*)(XP + (size_t)row * 1024); dst[lane] = (v4u){0u, 0u, 0u, 0u}; dst[lane + 64] = (v4u){0u, 0u, 0u, 0u}; if (lane == 0) ROWW[row] = 0.f; } }
}
__device__ __forceinline__ void combine_phase(Frame& F, bool dry = false) {
    const int gw = F.vcu * NWAVES + F.wave, NGW = F.G * NWAVES, lane = F.lane;
    const bf16* Y = (const bf16*)(F.ws + WS_XP); const int* TOKR = (const int*)(F.ws + WS_TOKE) + 3 * M * 4;
    const bool poison = ((REP_PHASE) == 50 || (REP_PHASE) == 51) && __hip_atomic_load(F.ctl + CW_CODE, RLX_AGENT) != 0u;
    for (int t = gw; t < M; t += NGW) {
        GAS f32x4* o = (GAS f32x4*)(F.out + (size_t)t * 1024) + lane; f32x4 v[4]; v2u y[4][4]; int row[4];
#pragma unroll
        for (int s = 0; s < 4; ++s) row[s] = TOKR[t * 4 + s];
#pragma unroll
        for (int j = 0; j < 4; ++j) v[j] = o[64 * j];
        const f32x4 v0[4] = {v[0], v[1], v[2], v[3]};
#pragma unroll
        for (int s = 0; s < 4; ++s) { const GAS v2u* yp = (const GAS v2u*)(Y + (size_t)row[s] * 1024) + lane;
#pragma unroll
            for (int j = 0; j < 4; ++j) y[s][j] = yp[64 * j]; }
#pragma unroll
        for (int s = 0; s < 4; ++s)
#pragma unroll
            for (int j = 0; j < 4; ++j) { v[j].x += bflo(y[s][j].x); v[j].y += bfhi(y[s][j].x); v[j].z += bflo(y[s][j].y); v[j].w += bfhi(y[s][j].y); }
#pragma unroll
        for (int j = 0; j < 4; ++j) o[64 * j] = poison ? (f32x4){__builtin_nanf(""), __builtin_nanf(""), __builtin_nanf(""), __builtin_nanf("")} : ((dry && v[j].x == v[j].x) ? v0[j] : v[j]);
    }
}
struct Args { const float* in[18]; float* out; unsigned char* ws; int ph_lo, ph_hi; };
static_assert(sizeof(Args) == 18 * 8 + 8 + 8 + 8, "Args has no padding bytes");
__global__ void __launch_bounds__(NWAVES * 64, 2) mk_fwd(Args args) {
    extern __shared__ __attribute__((aligned(16))) unsigned char lds[];
    Frame F;
    F.lds = (LAS unsigned char*)lds;
    F.MISC = (volatile LAS unsigned*)(F.lds + MISC_OFF);
    F.tid = threadIdx.x; F.lane = F.tid & 63; F.wave = __builtin_amdgcn_readfirstlane(F.tid >> 6);
    F.G = gridDim.x; { const int bx = blockIdx.x; F.vcu = (F.G % 8 == 0) ? (bx % 8) * (F.G / 8) + bx / 8 : bx; }
    F.ws = args.ws; F.ctl = (gu32*)(args.ws + WS_CTL); F.out = args.out;
#pragma unroll
    for (int i = 0; i < 18; ++i) F.in[i] = args.in[i];
    for (int u = F.tid; u < (LDS_BYTES - LDSCTL_OFF) / 4; u += NWAVES * 64) ((LAS unsigned*)(F.lds + LDSCTL_OFF))[u] = 0u;
    __syncthreads();
    XcdBarrier bar; bar.bar = (unsigned*)(F.ctl + CW_BAR); bar.x = 0; bar.st = nullptr;
    if (!MK_SPLIT) bar = xcd_barrier_post((unsigned*)(F.ctl + CW_BAR), F.MISC + 8);
#define GRID_BAR() do { if (MK_SPLIT) { if (F.tid == 0) __hip_atomic_store(F.ctl + CW_TMO, 0xBADBA0u, RLX_AGENT); } else { xcd_barrier(bar); if ((REP_PHASE) == 40) xcd_barrier(bar); } } while (0)
    const int lo = args.ph_lo, hi = args.ph_hi;
#define IN(k) (lo <= (k) && (k) < hi)
#define BOTH(k) (IN(k) && IN((k) + 1))
    constexpr bool AL = true, SP = true;
#ifndef REP_PHASE
#define REP_PHASE -1
#endif
#define REPS(k) for (int rep_ = 0; rep_ < ((REP_PHASE) == (k) ? 2 : 1); ++rep_)
    if (IN(0)) { REPS(0) p0_prologue(F); if (BOTH(0)) GRID_BAR(); }
    if (IN(1)) {
        pg8::Gemm g{(const bf16*)(F.ws + WS_H), (const bf16*)(F.ws + WS_WIN), M, NINP, DMODEL}; pg8::StaticOrder S; S.init(M, NINP, F.G, (int)blockIdx.x);
        pg8::EpiInProj E{F.ws};
        REPS(1) pg8::gemm_phase<pg8::EpiInProj, pg8::StaticOrder, AL, SP>(F.lds + RING_OFF, g, S, E);
        if (BOTH(1)) GRID_BAR();
    }
    if (IN(2)) {
        if ((REP_PHASE) == 32) qknorm_rows(F, true);
        qknorm_rows(F); REPS(30) pool_diff_rows(F);
        REPS(2) for (int v = F.vcu; v < 256; v += F.G) { const int b = v >> 7, half = (v >> 6) & 1, cc = v & 63; for (int k = 0; k < ((REP_PHASE) == 24 ? 3 : 2); ++k) topk_unit(F, b, k ? cc : 127 - cc, half); }
        if (BOTH(2)) GRID_BAR();
    }
    if (IN(3)) {
        { pg8::Gemm g{(const bf16*)(F.ws + WS_DIFF), (const bf16*)(F.ws + WS_WPOOL), M, DPOOL, DPOOL}; pg8::StaticOrder S; S.init(M, DPOOL, F.G, (int)blockIdx.x);
          pg8::EpiPool E{(bf16*)(F.ws + WS_YAP), F.in[6], F.in[7]};
          REPS(31) pg8::gemm_phase<pg8::EpiPool, pg8::StaticOrder, AL, SP>(F.lds + RING_OFF, g, S, E); }
        const float cshift = attn_body::C2 * 64.0f * wave_max(fabsf(F.in[3][F.lane])) * wave_max(fabsf(F.in[4][F.lane]));
        REPS(3) for (int v = F.vcu; v < 256; v += F.G) { const int bh = v >> 4, s = v & 15;
            for (int i = 0; i < 2; ++i) attn_body::attn_unit(bh >> 3, bh & 7, i == 0 ? 31 - s : s, (const attn_body::bf16*)(F.ws + WS_Q), (const attn_body::bf16*)(F.ws + WS_K), (const attn_body::bf16*)(F.ws + WS_V),
                                                             (attn_body::bf16*)(F.ws + WS_YAP), (const unsigned long long*)(F.ws + WS_MASK), cshift, (char*)lds + RING_OFF); }
        if (BOTH(3)) GRID_BAR();
    }
    if (IN(4)) {
        pg8::Gemm g{(const bf16*)(F.ws + WS_YAP), (const bf16*)(F.ws + WS_WAB), M, 2048, DMODEL}; pg8::StaticOrder S; S.init(M, 2048, F.G, (int)blockIdx.x);
        pg8::EpiMerge E{(const bf16*)(F.ws + WS_GA), (const bf16*)(F.ws + WS_GB), (bf16*)(F.ws + WS_MERGED)};
        REPS(4) pg8::gemm_phase<pg8::EpiMerge, pg8::StaticOrder, AL, SP>(F.lds + RING_OFF, g, S, E);
        if (BOTH(4)) GRID_BAR();
    }
    if (IN(5)) {
        pg8::Gemm g{(const bf16*)(F.ws + WS_MERGED), (const bf16*)(F.ws + WS_WOUT), M, DMODEL, DMODEL}; pg8::StaticOrder S; S.init(M, DMODEL, F.G, (int)blockIdx.x);
        pg8::EpiResF32 E{F.in[0], F.out};
        REPS(5) pg8::gemm_phase<pg8::EpiResF32, pg8::StaticOrder, AL, SP>(F.lds + RING_OFF, g, S, E);
        if (BOTH(5)) GRID_BAR();
    }
    if (IN(6)) { if ((REP_PHASE) == 6) router_phase(F, true); router_phase(F); if (BOTH(6)) GRID_BAR(); }
    if (IN(7)) { REPS(7) gather_phase(F); if (BOTH(7)) GRID_BAR(); }
    if (IN(8)) {
        LAS unsigned* tpre; LAS unsigned* cntl; moe_tables(F, tpre, cntl);
        pg8::ListOrder S{moe_build_units(F, tpre, 8)};
        pg8::Gemm g{(const bf16*)(F.ws + WS_XP), (const bf16*)(F.ws + WS_W1), MPAD, NEXP * 2048, DMODEL};
        pg8::EpiSwiglu E{F.in[15], (bf16*)(F.ws + WS_ACT)};
        REPS(8) pg8::gemm_phase<pg8::EpiSwiglu, pg8::ListOrder, AL, SP>(F.lds + RING_OFF, g, S, E);
        if (BOTH(8)) GRID_BAR();
    }
    if (IN(9)) {
        LAS unsigned* tpre; LAS unsigned* cntl; moe_tables(F, tpre, cntl);
        pg8::ListOrder S{moe_build_units(F, tpre, 4)};
        pg8::Gemm g{(const bf16*)(F.ws + WS_ACT), (const bf16*)(F.ws + WS_W2), MPAD, NEXP * 1024, DEXP};
        pg8::EpiDown E{F.in[17], (const float*)(F.ws + WS_ROWW), (bf16*)(F.ws + WS_XP)};
        REPS(9) pg8::gemm_phase<pg8::EpiDown, pg8::ListOrder, AL, SP>(F.lds + RING_OFF, g, S, E);
        if (BOTH(9)) GRID_BAR();
    }
    if (IN(2) && (REP_PHASE) == 51 && blockIdx.x == 3 && F.tid == 0) __hip_atomic_store(F.ctl + CW_CODE, 1u, RLX_AGENT);
    if (IN(10)) { if ((REP_PHASE) == 10) combine_phase(F, true); combine_phase(F); }
#undef IN
#undef BOTH
}

extern "C" void kernel_launch(void* const* d_in, const int* in_sizes, int n_in, void* d_out, int out_size, void* d_ws, size_t ws_size, hipStream_t stream) {
    static int grid = 0;
    if (grid == 0) {
        if (n_in != 18 || in_sizes[0] != M * DMODEL || out_size != M * DMODEL || ws_size < WS_END) { fprintf(stderr, "kernel_launch: built for 18 inputs, x/out of %d floats, >= %zu bytes of workspace; got n_in %d, in0 %d, out %d, ws %zu; nothing launched\n", M * DMODEL, (size_t)WS_END, n_in, n_in > 0 ? in_sizes[0] : -1, out_size, ws_size); grid = -1; return; }
        int dev = 0, cus = 0, per_cu = 0;
        if (hipGetDevice(&dev) != hipSuccess || hipDeviceGetAttribute(&cus, hipDeviceAttributeMultiprocessorCount, dev) != hipSuccess) { fprintf(stderr, "kernel_launch: hipGetDevice / hipDeviceGetAttribute failed; nothing launched\n"); grid = -1; return; }
        if (hipFuncSetAttribute((const void*)mk_fwd, hipFuncAttributeMaxDynamicSharedMemorySize, LDS_BYTES) != hipSuccess) { fprintf(stderr, "kernel_launch: hipFuncSetAttribute failed; nothing launched\n"); grid = -1; return; }
        if (hipOccupancyMaxActiveBlocksPerMultiprocessor(&per_cu, (const void*)mk_fwd, NWAVES * 64, LDS_BYTES) != hipSuccess || per_cu < 1) { fprintf(stderr, "kernel_launch: occupancy query reports %d workgroups per CU; nothing launched\n", per_cu); (void)hipGetLastError(); grid = -1; return; }
        (void)hipGetLastError();
        grid = cus;
    }
    if (grid < 0) return;
    if (hipMemsetAsync((char*)d_ws + WS_CTL, 0, CTL_ZERO_BYTES, stream) != hipSuccess) { fprintf(stderr, "kernel_launch: hipMemsetAsync of the control words failed; nothing launched\n"); return; }
    Args a{};
    for (int i = 0; i < 18; ++i) a.in[i] = (const float*)d_in[i];
    a.out = (float*)d_out; a.ws = (unsigned char*)d_ws;
    const int nl = MK_SPLIT ? N_PHASES : 1;
    for (int li = 0; li < nl; ++li) {
        a.ph_lo = MK_SPLIT ? li : 0; a.ph_hi = MK_SPLIT ? li + 1 : N_PHASES;
        hipLaunchKernelGGL(mk_fwd, dim3(grid), dim3(NWAVES * 64), LDS_BYTES, stream, a);
        const hipError_t le = hipPeekAtLastError();
        if (le != hipSuccess) { fprintf(stderr, "kernel_launch: launch %d failed: %s (grid %d x %d threads, %d B LDS)\n", li, hipGetErrorName(le), grid, NWAVES * 64, LDS_BYTES); break; }
    }
}
```

```cpp
#define MK_SPLIT 0
#include <hip/hip_runtime.h>
#include <hip/hip_bf16.h>
#include <cstdio>
#include <cstdint>
#include <cmath>
constexpr int NWAVES = 8;
#ifndef MK_SPLIT
#define MK_SPLIT 0
#endif
constexpr int N_PHASES = 11;
#ifndef REP_PHASE
#define REP_PHASE -1
#endif

constexpr int BATCH = 2, SEQ = 8192, DMODEL = 1024, M = BATCH * SEQ;
constexpr int DATT = 512, HD = 64, NH = 8, NIH = 4, IDIM = 64, TOPK = 256, DPOOL = 512, NEXP = 32, TOPE = 4, DEXP = 1024;
constexpr int NIN = 4420;
constexpr int NINP = 4608;
constexpr float EPS = 1e-6f;
constexpr int MP_TILES = 288, MPAD = MP_TILES * 256;

constexpr size_t MiB = 1u << 20;
constexpr size_t WS_CTL = 0, CTL_ZERO_BYTES = 1 * MiB;
constexpr size_t WS_WIN = 2 * MiB;
constexpr size_t WS_WAB = 12 * MiB;
constexpr size_t WS_WOUT = 16 * MiB;
constexpr size_t WS_WPOOL = 18 * MiB;
constexpr size_t WS_W1 = 20 * MiB;
constexpr size_t WS_W2 = 148 * MiB;
constexpr size_t WS_H = 212 * MiB;
constexpr size_t WS_Q = 244 * MiB, WS_K = 260 * MiB, WS_V = 276 * MiB;
constexpr size_t WS_IQ = 292 * MiB;
constexpr size_t WS_IK = 300 * MiB;
constexpr size_t WS_IW = 302 * MiB;
constexpr size_t WS_U = 303 * MiB;
constexpr size_t WS_DIFF = 319 * MiB;
constexpr size_t WS_GA = 335 * MiB, WS_GB = 367 * MiB;
constexpr size_t WS_MASK = 399 * MiB;
constexpr size_t WS_YAP = 415 * MiB;
constexpr size_t WS_MERGED = 447 * MiB;
constexpr size_t WS_H2 = 479 * MiB;
constexpr size_t WS_TOKE = 511 * MiB;
constexpr size_t WS_ROWW = 512 * MiB;
constexpr size_t WS_XP = 514 * MiB;
constexpr size_t WS_ACT = 658 * MiB;
constexpr size_t WS_TMP = 802 * MiB;
constexpr size_t WS_END = 834 * MiB;

constexpr int CW_TMO = 0, CW_CODE = 1;
constexpr int CW_CNT = 64;
constexpr int CW_BAR = 4096;
constexpr int CW_MOE = 8192;

constexpr int RING_OFF = 0, RING_BYTES = 147456;
constexpr int LDSCTL_OFF = RING_BYTES, MISC_OFF = LDSCTL_OFF + 320;
constexpr int XTRA_OFF = LDSCTL_OFF + 1024;
constexpr int LDS_BYTES = 163840;
static_assert(XTRA_OFF + 14336 <= LDS_BYTES, "LDS map");

#define GAS __attribute__((address_space(1)))
#define LAS __attribute__((address_space(3)))
typedef unsigned short bf16;
typedef unsigned v4u __attribute__((ext_vector_type(4)));
typedef unsigned v2u __attribute__((ext_vector_type(2)));
typedef float f32x4 __attribute__((ext_vector_type(4)));
typedef short bf16x8 __attribute__((ext_vector_type(8)));
typedef float f32x16 __attribute__((ext_vector_type(16)));
typedef GAS unsigned gu32;
#define RLX_AGENT __ATOMIC_RELAXED, __HIP_MEMORY_SCOPE_AGENT
#define LDS_WAIT() asm volatile("s_waitcnt lgkmcnt(0)" ::: "memory")
#define VM_WAIT() asm volatile("s_waitcnt vmcnt(0)" ::: "memory")
__device__ __forceinline__ unsigned f2bf(float f) { unsigned u = __builtin_bit_cast(unsigned, f); return (u + 0x7fffu + ((u >> 16) & 1u)) >> 16; }
__device__ __forceinline__ unsigned pk2(float lo, float hi) { return f2bf(lo) | (f2bf(hi) << 16); }
__device__ __forceinline__ float bflo(unsigned w) { return __uint_as_float(w << 16); }
__device__ __forceinline__ float bfhi(unsigned w) { return __uint_as_float(w & 0xffff0000u); }
namespace pg8 {
#define PG8_LAS __attribute__((address_space(3)))
typedef unsigned short bf16_t;
typedef short bf16x8 __attribute__((ext_vector_type(8)));
typedef float f32x4 __attribute__((ext_vector_type(4)));
typedef unsigned u32x4 __attribute__((ext_vector_type(4)));
constexpr int BM = 256, BK = 64, HALF = 128, HTB = HALF * BK * 2  , STAGE_BYTES = 8 * HTB, NXCD = 8, WGM = 8;

__host__ __device__ __forceinline__ int lds_byte(int r, int c) { const int st = (r >> 4) * 2 + (c >> 5), rr = r & 15, cc = c & 31, ob = rr * 64 + cc * 2; return st * 1024 + (ob ^ (((ob >> 9) & 1) << 5)); }
__host__ __device__ __forceinline__ void stage_rc(int b, int& R, int& C) { const int st = b / 1024, sb = b % 1024, swz = sb ^ (((sb >> 9) & 1) << 5); R = (st >> 1) * 16 + swz / 64; C = (st & 1) * 32 + (swz % 64) / 2; }
__host__ __device__ __forceinline__ int perm32(int rho) { const int n = rho >> 4, i = rho & 15; return 8 * (i >> 2) + 4 * n + (i & 3); }

struct Unit { int pm, pn; };
struct Gemm { const bf16_t* A; const bf16_t* Bt; int M, N, K; };

struct StaticOrder {
    int nM, nN, nwg, G, c;
    __host__ __device__ void init(int M, int N, int G_, int c_) { nM = M / BM; nN = N / BM; nwg = nM * nN; G = G_; c = c_; }
    __host__ __device__ bool next(int i, Unit& u) const {
        const long L = (long)i * G + c; if (L >= nwg) return false;
        int wgid = (int)L; { const int q = nwg / NXCD, r = nwg % NXCD, xcd = wgid % NXCD, off = wgid / NXCD; wgid = (xcd < r ? xcd * (q + 1) : r * (q + 1) + (xcd - r) * q) + off; }
        const int nig = WGM * nN, gid = wgid / nig, fm = gid * WGM, gsz = (nM - fm) < WGM ? (nM - fm) : WGM;
        u.pm = fm + ((wgid % nig) % gsz); u.pn = (wgid % nig) / gsz; return true;
    }
    __device__ __forceinline__ void a_ready(const Unit&) const {}
    __device__ __forceinline__ void done(const Unit&) const {}
    __device__ __forceinline__ const char* abase(const Gemm& g, const Unit& u, size_t tstep) const { return (const char*)g.A + (size_t)u.pm * tstep; }
    __device__ __forceinline__ const char* bbase(const Gemm& g, const Unit& u, size_t tstep) const { return (const char*)g.Bt + (size_t)u.pn * tstep; }
};
__device__ __forceinline__ unsigned cvt_pk_bf16(float lo, float hi) { unsigned r; asm volatile("v_cvt_pk_bf16_f32 %0, %1, %2" : "=v"(r) : "v"(lo), "v"(hi)); return r; }
typedef float f32x2 __attribute__((ext_vector_type(2)));
typedef unsigned u32x2 __attribute__((ext_vector_type(2)));
__device__ __forceinline__ float sigmoidf_fast(float x) { return __builtin_amdgcn_rcpf(1.0f + __builtin_amdgcn_exp2f(-1.4426950408889634f * x)); }
__device__ __forceinline__ float bf_lo(unsigned w) { return __uint_as_float(w << 16); }
__device__ __forceinline__ float bf_hi(unsigned w) { return __uint_as_float(w & 0xffff0000u); }

struct EpiInProj {
    static constexpr bool PERM = true, AFTER_DRAIN = false;
    unsigned char* ws;
    static constexpr unsigned oq = (unsigned)WS_Q, ok = (unsigned)WS_K, ov = (unsigned)WS_V, oiq = (unsigned)WS_IQ, oik = (unsigned)WS_IK, ou = (unsigned)WS_U, oga = (unsigned)WS_GA, ogb = (unsigned)WS_GB, oiw = (unsigned)WS_IW;
    __device__ __forceinline__ void operator()(const f32x4 (&acc)[2][2][4][2], const Unit& un, int wr, int wc, int fr, int fq) const {
        const int pn = un.pn, row0 = un.pm * BM + wr * 64 + fr;
        if (pn == 7) {
#pragma unroll
            for (int ai = 0; ai < 2; ++ai)
#pragma unroll
                for (int m = 0; m < 4; ++m) { const size_t row = (size_t)(row0 + ai * HALF + m * 16);
                    const f32x4 v0 = acc[ai][0][m][0], v1 = acc[ai][0][m][1];
                    if (wc < 2) { u32x4 w; w.x = cvt_pk_bf16(v0[0], v0[1]); w.y = cvt_pk_bf16(v0[2], v0[3]); w.z = cvt_pk_bf16(v1[0], v1[1]); w.w = cvt_pk_bf16(v1[2], v1[3]);
                        *(u32x4*)((bf16_t*)(ws + oik) + (row >> 5) * 2048 + (2 * wc + (fq >> 1)) * 512 + ((fq & 1) * 32 + (row & 31)) * 8) = w; }
                    else if (wc == 2 && fq == 0) { *(f32x4*)((float*)(ws + oiw) + row * 4) = v0; } }
            return;
        }
        unsigned boff; int ldc, colt; bool sig = false;
        if (pn < 6) { boff = pn < 2 ? oq : (pn < 4 ? ok : ov); ldc = 512; colt = (pn & 1) * 256; }
        else if (pn == 6) { boff = oiq; ldc = 256; colt = 0; }
        else if (pn < 10) { boff = ou; ldc = 512; colt = (pn - 8) * 256; }
        else { sig = true; boff = pn < 14 ? oga : ogb; ldc = 1024; colt = ((pn - 10) & 3) * 256; }
        bf16_t* base = (bf16_t*)(ws + boff);
        const int col0 = colt + wc * 32 + 8 * fq;
#pragma unroll
        for (int ai = 0; ai < 2; ++ai)
#pragma unroll
            for (int m = 0; m < 4; ++m) { bf16_t* rowp = base + (size_t)(row0 + ai * HALF + m * 16) * ldc + col0;
#pragma unroll
                for (int bj = 0; bj < 2; ++bj) { f32x4 v0 = acc[ai][bj][m][0], v1 = acc[ai][bj][m][1];
                    if (sig) {
#pragma unroll
                        for (int j = 0; j < 4; ++j) { v0[j] = sigmoidf_fast(v0[j]); v1[j] = sigmoidf_fast(v1[j]); } }
                    u32x4 w; w.x = cvt_pk_bf16(v0[0], v0[1]); w.y = cvt_pk_bf16(v0[2], v0[3]); w.z = cvt_pk_bf16(v1[0], v1[1]); w.w = cvt_pk_bf16(v1[2], v1[3]);
                    *(u32x4*)(rowp + bj * HALF) = w; } }
    }
};
struct EpiPool {
    static constexpr bool PERM = true, AFTER_DRAIN = false;
    bf16_t* yap; const float* pb; const float* ps;
    __device__ __forceinline__ void operator()(const f32x4 (&acc)[2][2][4][2], const Unit& un, int wr, int wc, int fr, int fq) const {
        const int row0 = un.pm * BM + wr * 64 + fr, col0 = un.pn * BM + wc * 32 + 8 * fq;
        f32x4 bv[2][2], sv[2][2];
#pragma unroll
        for (int bj = 0; bj < 2; ++bj)
#pragma unroll
            for (int n = 0; n < 2; ++n) { bv[bj][n] = *(const f32x4*)(pb + col0 + bj * HALF + 4 * n); sv[bj][n] = *(const f32x4*)(ps + col0 + bj * HALF + 4 * n); }
#pragma unroll
        for (int ai = 0; ai < 2; ++ai)
#pragma unroll
            for (int m = 0; m < 4; ++m) { bf16_t* rowp = yap + (size_t)(row0 + ai * HALF + m * 16) * 512 + col0;
#pragma unroll
                for (int bj = 0; bj < 2; ++bj) { const f32x4 v0 = (acc[ai][bj][m][0] + bv[bj][0]) * sv[bj][0], v1 = (acc[ai][bj][m][1] + bv[bj][1]) * sv[bj][1];
                    u32x4 w; w.x = cvt_pk_bf16(v0[0], v0[1]); w.y = cvt_pk_bf16(v0[2], v0[3]); w.z = cvt_pk_bf16(v1[0], v1[1]); w.w = cvt_pk_bf16(v1[2], v1[3]);
                    *(u32x4*)(rowp + bj * HALF) = w; } }
    }
};
struct EpiGate {
    static constexpr bool PERM = true, AFTER_DRAIN = false;
    const bf16_t* g; const bf16_t* add; bf16_t* out;
    __device__ __forceinline__ void operator()(const f32x4 (&acc)[2][2][4][2], const Unit& un, int wr, int wc, int fr, int fq) const {
        const int row0 = un.pm * BM + wr * 64 + fr, col0 = un.pn * BM + wc * 32 + 8 * fq;
#pragma unroll
        for (int ai = 0; ai < 2; ++ai)
#pragma unroll
            for (int m = 0; m < 4; ++m)
#pragma unroll
                for (int bj = 0; bj < 2; ++bj) { const size_t off = (size_t)(row0 + ai * HALF + m * 16) * 1024 + col0 + bj * HALF;
                    const u32x4 a = *(const u32x4*)(g + off); u32x4 t = {0u, 0u, 0u, 0u}; if (add) t = *(const u32x4*)(add + off);
                    const f32x4 p0 = acc[ai][bj][m][0], p1 = acc[ai][bj][m][1];
                    u32x4 w;
                    w.x = cvt_pk_bf16(bf_lo(t.x) + bf_lo(a.x) * p0[0], bf_hi(t.x) + bf_hi(a.x) * p0[1]);
                    w.y = cvt_pk_bf16(bf_lo(t.y) + bf_lo(a.y) * p0[2], bf_hi(t.y) + bf_hi(a.y) * p0[3]);
                    w.z = cvt_pk_bf16(bf_lo(t.z) + bf_lo(a.z) * p1[0], bf_hi(t.z) + bf_hi(a.z) * p1[1]);
                    w.w = cvt_pk_bf16(bf_lo(t.w) + bf_lo(a.w) * p1[2], bf_hi(t.w) + bf_hi(a.w) * p1[3]);
                    *(u32x4*)(out + off) = w; }
    }
};
struct EpiResF32 {
    static constexpr bool PERM = false, AFTER_DRAIN = false;
    const float* base; float* C;
    __device__ __forceinline__ void operator()(const f32x4 (&acc)[2][2][4][2], const Unit& un, int wr, int wc, int fr, int fq) const {
        const int row0 = un.pm * BM + wr * 64 + fr, col0 = un.pn * BM + wc * 32 + 4 * fq;
#pragma unroll
        for (int ai = 0; ai < 2; ++ai)
#pragma unroll
            for (int m = 0; m < 4; ++m) { const size_t off = (size_t)(row0 + ai * HALF + m * 16) * 1024 + col0;
#pragma unroll
                for (int bj = 0; bj < 2; ++bj)
#pragma unroll
                    for (int n = 0; n < 2; ++n) *(f32x4*)(C + off + bj * HALF + n * 16) = *(const f32x4*)(base + off + bj * HALF + n * 16) + acc[ai][bj][m][n]; }
    }
};
struct EpiSwiglu {
    static constexpr bool PERM = true, AFTER_DRAIN = false;
    const float* b1; bf16_t* act;
    __device__ __forceinline__ void operator()(const f32x4 (&acc)[2][2][4][2], const Unit& un, int wr, int wc, int fr, int fq) const {
        const int e = un.pn >> 3, n8 = un.pn & 7, row0 = un.pm * BM + wr * 64 + fr, col0 = n8 * HALF + wc * 32 + 8 * fq;
        const float* bp = b1 + (size_t)e * 2048 + col0;
        const f32x4 bg0 = *(const f32x4*)(bp), bg1 = *(const f32x4*)(bp + 4), bl0 = *(const f32x4*)(bp + 1024), bl1 = *(const f32x4*)(bp + 1028);
#pragma unroll
        for (int ai = 0; ai < 2; ++ai)
#pragma unroll
            for (int m = 0; m < 4; ++m) {
                f32x4 g0 = acc[ai][0][m][0] + bg0, g1 = acc[ai][0][m][1] + bg1, l0 = acc[ai][1][m][0] + bl0, l1 = acc[ai][1][m][1] + bl1, o0, o1;
#pragma unroll
                for (int j = 0; j < 4; ++j) {
                    const float ga = fminf(g0[j], 7.0f), gb = fminf(g1[j], 7.0f);
                    const float la = fminf(fmaxf(l0[j], -7.0f), 7.0f), lb = fminf(fmaxf(l1[j], -7.0f), 7.0f);
                    o0[j] = (la + 1.0f) * ga * sigmoidf_fast(1.702f * ga); o1[j] = (lb + 1.0f) * gb * sigmoidf_fast(1.702f * gb); }
                u32x4 w; w.x = cvt_pk_bf16(o0[0], o0[1]); w.y = cvt_pk_bf16(o0[2], o0[3]); w.z = cvt_pk_bf16(o1[0], o1[1]); w.w = cvt_pk_bf16(o1[2], o1[3]);
                *(u32x4*)(act + (size_t)(row0 + ai * HALF + m * 16) * 1024 + col0) = w; }
    }
};
struct EpiDown {
    static constexpr bool PERM = true, AFTER_DRAIN = false;
    const float* b2; const float* roww; bf16_t* Y;
    __device__ __forceinline__ void operator()(const f32x4 (&acc)[2][2][4][2], const Unit& un, int wr, int wc, int fr, int fq) const {
        const int e = un.pn >> 2, n4 = un.pn & 3, row0 = un.pm * BM + wr * 64 + fr, col0 = n4 * BM + wc * 32 + 8 * fq;
        const float* bp = b2 + (size_t)e * 1024 + col0;
        f32x4 bv[2][2];
#pragma unroll
        for (int bj = 0; bj < 2; ++bj)
#pragma unroll
            for (int n = 0; n < 2; ++n) bv[bj][n] = *(const f32x4*)(bp + bj * HALF + 4 * n);
#pragma unroll
        for (int ai = 0; ai < 2; ++ai)
#pragma unroll
            for (int m = 0; m < 4; ++m) { const int row = row0 + ai * HALF + m * 16; const float rw = roww[row];
#pragma unroll
                for (int bj = 0; bj < 2; ++bj) { const f32x4 v0 = (acc[ai][bj][m][0] + bv[bj][0]) * rw, v1 = (acc[ai][bj][m][1] + bv[bj][1]) * rw;
                    u32x4 w; w.x = cvt_pk_bf16(v0[0], v0[1]); w.y = cvt_pk_bf16(v0[2], v0[3]); w.z = cvt_pk_bf16(v1[0], v1[1]); w.w = cvt_pk_bf16(v1[2], v1[3]);
                    *(u32x4*)(Y + (size_t)row * 1024 + col0 + bj * HALF) = w; } }
    }
};
struct ListOrder {
    const PG8_LAS unsigned* list;
    __device__ __forceinline__ bool next(int i, Unit& u) const { const unsigned w = (unsigned)__builtin_amdgcn_readfirstlane((int)list[i]); if (w == 0xffffffffu) return false; u.pm = (int)(w & 0xffffu); u.pn = (int)(w >> 16); return true; }
    __device__ __forceinline__ void a_ready(const Unit&) const {}
    __device__ __forceinline__ void done(const Unit&) const {}
    __device__ __forceinline__ const char* abase(const Gemm& g, const Unit& u, size_t tstep) const { return (const char*)g.A + (size_t)u.pm * tstep; }
    __device__ __forceinline__ const char* bbase(const Gemm& g, const Unit& u, size_t tstep) const { return (const char*)g.Bt + (size_t)u.pn * tstep; }
};
template <class Epi, class Sched, bool ALIGN_EPI = false, bool SP2 = false>
__device__ __forceinline__ void gemm_phase(PG8_LAS unsigned char* lds, const Gemm g, const Sched& S, const Epi& E) {
    const int tid = threadIdx.x, wid = __builtin_amdgcn_readfirstlane(tid >> 6), lane = tid & 63, wr = wid >> 2, wc = wid & 3, fr = lane & 15, fq = lane >> 4;
    const int K = g.K, nt = K / BK;
    unsigned voffA[2], voffB[2];
#pragma unroll
    for (int i = 0; i < 2; ++i) { int R, C; stage_rc(tid * 16 + i * 8192, R, C); const int Rb = Epi::PERM ? ((R & ~31) + perm32(R & 31)) : R;
        voffA[i] = (unsigned)(R * K + C) * 2u; voffB[i] = (unsigned)(Rb * K + C) * 2u; }
    const size_t kstep = (size_t)(BK * 2);
    const size_t hstep = (size_t)HALF * K * 2;
    const size_t tstep = 2 * hstep;
    const unsigned ldsw = (unsigned)wid * 1024u;
    const int aoff = lds_byte(wr * 64 + fr, fq * 8), boff = lds_byte(wc * 32 + fr, fq * 8);
#define PG8_SA(b, h) (((b) * 2 + (h)) * HTB)
#define PG8_SB(b, h) ((4 + (b) * 2 + (h)) * HTB)
#define PG8_STAGE(bufoff, gbase, voff) do { _Pragma("unroll") for (int _i = 0; _i < 2; ++_i) \
        __builtin_amdgcn_global_load_lds((const unsigned*)((const char*)(gbase) + (voff)[_i]), (PG8_LAS unsigned*)(lds + (bufoff) + ldsw + _i * 8192), 16, 0, 0); } while (0)
#define PG8_LDA(dst, b, h) do { _Pragma("unroll") for (int m = 0; m < 4; ++m) _Pragma("unroll") for (int k = 0; k < 2; ++k) dst[m][k] = *(const PG8_LAS bf16x8*)(lds + PG8_SA(b, h) + aoff + m * 2048 + k * 1024); } while (0)
#define PG8_LDB(dst, b, h) do { _Pragma("unroll") for (int n = 0; n < 2; ++n) _Pragma("unroll") for (int k = 0; k < 2; ++k) dst[n][k] = *(const PG8_LAS bf16x8*)(lds + PG8_SB(b, h) + boff + n * 2048 + k * 1024); } while (0)
#define PG8_MMA(ai, bj, At, Bt) do { __builtin_amdgcn_s_setprio(1); _Pragma("unroll") for (int m = 0; m < 4; ++m) _Pragma("unroll") for (int n = 0; n < 2; ++n) _Pragma("unroll") for (int k = 0; k < 2; ++k) \
        acc[ai][bj][m][n] = __builtin_amdgcn_mfma_f32_16x16x32_bf16(Bt[n][k], At[m][k], acc[ai][bj][m][n], 0, 0, 0); __builtin_amdgcn_s_setprio(0); } while (0)
#define PG8_WAIT_V(n) asm volatile("s_waitcnt vmcnt(" #n ")" ::: "memory")
#define PG8_WAIT_L(n) asm volatile("s_waitcnt lgkmcnt(" #n ")" ::: "memory")
#define PG8_BAR __builtin_amdgcn_s_barrier()
#define PG8_SCHED __builtin_amdgcn_sched_barrier(0)
    Unit cur, nxt; int ui = 0;
    if (!S.next(0, cur)) return;
    f32x4 acc[2][2][4][2];
#pragma unroll
    for (int a = 0; a < 2; ++a)
#pragma unroll
        for (int b = 0; b < 2; ++b)
#pragma unroll
            for (int m = 0; m < 4; ++m)
#pragma unroll
                for (int n = 0; n < 2; ++n) acc[a][b][m][n] = (f32x4){0.f, 0.f, 0.f, 0.f};
    bf16x8 At[4][2], B0[2][2], B1[2][2];
    const char* cA = S.abase(g, cur, tstep); const char* cB = S.bbase(g, cur, tstep);
    S.a_ready(cur);
    if constexpr (SP2) {
        PG8_STAGE(PG8_SB(0, 0), cB, voffB); PG8_STAGE(PG8_SB(0, 1), cB + hstep, voffB); PG8_STAGE(PG8_SA(0, 0), cA, voffA); PG8_STAGE(PG8_SA(0, 1), cA + hstep, voffA);
        if (wr == 1) PG8_BAR;
        PG8_WAIT_V(2); PG8_BAR;
        PG8_STAGE(PG8_SB(1, 0), cB + kstep, voffB); PG8_STAGE(PG8_SA(1, 0), cA + kstep, voffA); PG8_STAGE(PG8_SB(1, 1), cB + hstep + kstep, voffB);
        PG8_WAIT_V(6); PG8_BAR;
    } else {
        PG8_STAGE(PG8_SB(0, 0), cB, voffB); PG8_STAGE(PG8_SA(0, 0), cA, voffA); PG8_STAGE(PG8_SB(0, 1), cB + hstep, voffB); PG8_STAGE(PG8_SA(0, 1), cA + hstep, voffA);
        if (wr == 1) PG8_BAR;
        PG8_WAIT_V(4); PG8_BAR;
        PG8_STAGE(PG8_SB(1, 0), cB + kstep, voffB); PG8_STAGE(PG8_SA(1, 0), cA + kstep, voffA); PG8_STAGE(PG8_SB(1, 1), cB + hstep + kstep, voffB);
        PG8_WAIT_V(6); PG8_BAR;
    }
    for (;;) {
        const bool has_next = S.next(ui + 1, nxt);
        const char* nA = has_next ? S.abase(g, nxt, tstep) : cA; const char* nB = has_next ? S.bbase(g, nxt, tstep) : cB;
        for (int t = 0; t < nt; t += 2) {
            const bool last = (t == nt - 2);
            const char* a1 = cA + (size_t)(t + 1) * kstep;
            const char* a2 = last ? nA : cA + (size_t)(t + 2) * kstep; const char* b2 = last ? nB : cB + (size_t)(t + 2) * kstep;
            const char* a3 = a2 + kstep; const char* b3 = b2 + kstep;
            if (last && has_next) S.a_ready(nxt);
            if constexpr (SP2) {
            PG8_LDB(B0, 0, 0); PG8_LDB(B1, 0, 1); PG8_SCHED; PG8_LDA(At, 0, 0); PG8_STAGE(PG8_SA(1, 1), a1 + hstep, voffA);
            PG8_WAIT_V(8); PG8_WAIT_L(0); PG8_BAR; PG8_MMA(0, 0, At, B0); PG8_MMA(0, 1, At, B1); PG8_BAR; PG8_SCHED;
            PG8_LDA(At, 0, 1); PG8_STAGE(PG8_SB(0, 0), b2, voffB); PG8_STAGE(PG8_SB(0, 1), b2 + hstep, voffB); PG8_STAGE(PG8_SA(0, 0), a2, voffA);
            PG8_WAIT_V(8); PG8_WAIT_L(0); PG8_BAR; PG8_MMA(1, 0, At, B0); PG8_MMA(1, 1, At, B1); PG8_BAR; PG8_SCHED;
            PG8_LDB(B0, 1, 0); PG8_LDB(B1, 1, 1); PG8_SCHED; PG8_LDA(At, 1, 0); PG8_STAGE(PG8_SA(0, 1), a2 + hstep, voffA);
            PG8_WAIT_V(8); PG8_WAIT_L(0); PG8_BAR; PG8_MMA(0, 0, At, B0); PG8_MMA(0, 1, At, B1); PG8_BAR; PG8_SCHED;
            PG8_LDA(At, 1, 1); PG8_STAGE(PG8_SB(1, 0), b3, voffB); PG8_STAGE(PG8_SB(1, 1), b3 + hstep, voffB); PG8_STAGE(PG8_SA(1, 0), a3, voffA);
            PG8_WAIT_V(8); PG8_WAIT_L(0); PG8_BAR; PG8_MMA(1, 0, At, B0); PG8_MMA(1, 1, At, B1); PG8_BAR; PG8_SCHED;
            } else {
            PG8_LDB(B0, 0, 0); PG8_SCHED; PG8_LDA(At, 0, 0); PG8_STAGE(PG8_SA(1, 1), a1 + hstep, voffA);
            PG8_WAIT_L(8); PG8_BAR; PG8_WAIT_L(0); PG8_MMA(0, 0, At, B0); PG8_BAR; PG8_SCHED;
            PG8_LDB(B1, 0, 1); PG8_STAGE(PG8_SB(0, 0), b2, voffB);
            PG8_BAR; PG8_WAIT_L(0); PG8_MMA(0, 1, At, B1); PG8_BAR;
            PG8_LDA(At, 0, 1); PG8_STAGE(PG8_SA(0, 0), a2, voffA);
            PG8_BAR; PG8_WAIT_L(0); PG8_MMA(1, 0, At, B0); PG8_BAR; PG8_SCHED;
            PG8_STAGE(PG8_SB(0, 1), b2 + hstep, voffB);
            PG8_WAIT_V(6); PG8_BAR; PG8_MMA(1, 1, At, B1); PG8_BAR;
            PG8_LDB(B0, 1, 0); PG8_SCHED; PG8_LDA(At, 1, 0); PG8_STAGE(PG8_SA(0, 1), a2 + hstep, voffA);
            PG8_WAIT_L(8); PG8_BAR; PG8_WAIT_L(0); PG8_MMA(0, 0, At, B0); PG8_BAR; PG8_SCHED;
            PG8_LDB(B1, 1, 1); PG8_STAGE(PG8_SB(1, 0), b3, voffB);
            PG8_BAR; PG8_WAIT_L(0); PG8_MMA(0, 1, At, B1); PG8_BAR;
            PG8_LDA(At, 1, 1); PG8_STAGE(PG8_SA(1, 0), a3, voffA);
            PG8_BAR; PG8_WAIT_L(0); PG8_MMA(1, 0, At, B0); PG8_BAR; PG8_SCHED;
            PG8_STAGE(PG8_SB(1, 1), b3 + hstep, voffB);
            PG8_WAIT_V(6); PG8_BAR; PG8_MMA(1, 1, At, B1); PG8_BAR;
            }
        }
        if constexpr (ALIGN_EPI) { if (wr == 0) PG8_BAR; }
        if constexpr (!Epi::AFTER_DRAIN) { E(acc, cur, wr, wc, fr, fq); S.done(cur); }
        if (!has_next) break;
#pragma unroll
        for (int a = 0; a < 2; ++a)
#pragma unroll
            for (int b = 0; b < 2; ++b)
#pragma unroll
                for (int m = 0; m < 4; ++m)
#pragma unroll
                    for (int n = 0; n < 2; ++n) acc[a][b][m][n] = (f32x4){0.f, 0.f, 0.f, 0.f};
        cur = nxt; cA = nA; cB = nB; ++ui;
        if constexpr (ALIGN_EPI) { if (wr == 1) PG8_BAR; }
    }
    PG8_WAIT_V(0);
    if constexpr (!ALIGN_EPI) { if (wr == 0) PG8_BAR; }
    PG8_BAR;
    if constexpr (Epi::AFTER_DRAIN) { E.fused(acc, cur, wr, wc, fr, fq, lds, wid, lane); S.done(cur); }
#undef PG8_SA
#undef PG8_SB
#undef PG8_STAGE
#undef PG8_LDA
#undef PG8_LDB
#undef PG8_MMA
#undef PG8_WAIT_V
#undef PG8_WAIT_L
#undef PG8_BAR
#undef PG8_SCHED
}
}
namespace attn_body {
using bf16=__hip_bfloat16;
using bf16x8=__attribute__((ext_vector_type(8)))short;
using s16x4=__attribute__((ext_vector_type(4)))short;
using f32x16=__attribute__((ext_vector_type(16)))float;
using u32x4=__attribute__((ext_vector_type(4)))unsigned;
constexpr int BATCH=2,NHEAD=8,SEQ=8192,D=64,DM=NHEAD*D,OPITCH=512;
constexpr int NW=8,QBLK=32,QB=QBLK*NW,KVBLK=64,NQB=SEQ/QB;
__device__ __forceinline__ int crow(int r,int hi){return (r&3)+8*(r>>2)+4*hi;}
#define SBAR() __builtin_amdgcn_sched_barrier(0)
constexpr int NSLOT=3, SLOTB=8192;
constexpr int LDS_K=0, LDS_V=NSLOT*SLOTB, LDS_WS=2*NSLOT*SLOTB, LDS_OST=LDS_WS+NW*64*4, LDS_BYTES=LDS_OST+NW*4096;
constexpr float C2=0.125f*1.4426950408889634f;
__device__ __forceinline__ void glds16(const void*gsrc,unsigned lds_dst){unsigned keep;
  asm volatile("s_mov_b32 %0, m0\n\ts_mov_b32 m0, %2\n\ts_nop 0\n\tglobal_load_lds_dwordx4 %1, off\n\ts_mov_b32 m0, %0":"=&s"(keep):"v"(gsrc),"s"(lds_dst):"memory");}
__device__ __forceinline__ unsigned long long gld8(const unsigned long long*sbase,unsigned voff){unsigned long long r; asm volatile("global_load_dwordx2 %0, %1, %2":"=&v"(r):"v"(voff),"s"(sbase):"memory"); return r;}
typedef float f32x2_t __attribute__((ext_vector_type(2))); typedef __bf16 bf16x2_t __attribute__((ext_vector_type(2)));
__device__ __forceinline__ unsigned cvtpk_s(float lo,float hi){f32x2_t v={lo,hi};bf16x2_t b=__builtin_convertvector(v,bf16x2_t);return __builtin_bit_cast(unsigned,b);}

__device__ __forceinline__ void qkt(f32x16&p0,f32x16&p1,const char*Kslot,const bf16x8*qr,int r32,int hi){
  const f32x16 negm=f32x16{};
  const char*kb=Kslot+hi*1024+r32*16;
  #pragma unroll
  for(int d0=0;d0<4;++d0){
    const bf16x8 b0=*reinterpret_cast<const bf16x8*>(kb+d0*2048);
    const bf16x8 b1=*reinterpret_cast<const bf16x8*>(kb+d0*2048+512);
    if(d0==0){p0=__builtin_amdgcn_mfma_f32_32x32x16_bf16(b0,qr[0],negm,0,0,0);p1=__builtin_amdgcn_mfma_f32_32x32x16_bf16(b1,qr[0],negm,0,0,0);}
    else{p0=__builtin_amdgcn_mfma_f32_32x32x16_bf16(b0,qr[d0],p0,0,0,0);p1=__builtin_amdgcn_mfma_f32_32x32x16_bf16(b1,qr[d0],p1,0,0,0);}}
}
typedef __attribute__((address_space(3))) const char* lds_cptr;
typedef short v4i16_t __attribute__((ext_vector_type(4)));
__device__ __forceinline__ void kload8(bf16x8*kf,lds_cptr kp){
  kf[0]=*(const __attribute__((address_space(3))) bf16x8*)(kp);      kf[1]=*(const __attribute__((address_space(3))) bf16x8*)(kp+512);
  kf[2]=*(const __attribute__((address_space(3))) bf16x8*)(kp+2048); kf[3]=*(const __attribute__((address_space(3))) bf16x8*)(kp+2560);
  kf[4]=*(const __attribute__((address_space(3))) bf16x8*)(kp+4096); kf[5]=*(const __attribute__((address_space(3))) bf16x8*)(kp+4608);
  kf[6]=*(const __attribute__((address_space(3))) bf16x8*)(kp+6144); kf[7]=*(const __attribute__((address_space(3))) bf16x8*)(kp+6656);
}
__device__ __forceinline__ void kload2(bf16x8*kf,lds_cptr kp,int j){ kf[2*j]=*(const __attribute__((address_space(3))) bf16x8*)(kp+j*2048); kf[2*j+1]=*(const __attribute__((address_space(3))) bf16x8*)(kp+j*2048+512); }
__device__ __forceinline__ s16x4 vtr(lds_cptr p){ return __builtin_bit_cast(s16x4,__builtin_amdgcn_ds_read_tr16_b64_v4i16((__attribute__((address_space(3))) v4i16_t*)p)); }
__device__ __forceinline__ void pv(f32x16*o,int vb,bf16x8 pa0,bf16x8 pa1,bf16x8 pa2,bf16x8 pa3){
  #pragma unroll
  for(int d0=0;d0<2;++d0){s16x4 lo[4],hi[4];
    #pragma unroll
    for(int ks=0;ks<4;++ks){
      asm volatile("ds_read_b64_tr_b16 %0,%1 offset:%c2":"=&v"(lo[ks]):"v"(vb),"i"(d0*4096+ks*1024):"memory");
      asm volatile("ds_read_b64_tr_b16 %0,%1 offset:%c2":"=&v"(hi[ks]):"v"(vb),"i"(d0*4096+ks*1024+512):"memory");}
    asm volatile("s_waitcnt lgkmcnt(0)":::"memory");SBAR();
    #define PK(k) (bf16x8){lo[k][0],lo[k][1],lo[k][2],lo[k][3],hi[k][0],hi[k][1],hi[k][2],hi[k][3]}
    o[d0]=__builtin_amdgcn_mfma_f32_32x32x16_bf16(pa0,PK(0),o[d0],0,0,0);
    o[d0]=__builtin_amdgcn_mfma_f32_32x32x16_bf16(pa1,PK(1),o[d0],0,0,0);
    o[d0]=__builtin_amdgcn_mfma_f32_32x32x16_bf16(pa2,PK(2),o[d0],0,0,0);
    o[d0]=__builtin_amdgcn_mfma_f32_32x32x16_bf16(pa3,PK(3),o[d0],0,0,0);
    #undef PK
  }
}
#define MSK(v,w,r) __uint_as_float(__float_as_uint(v)&(unsigned)__builtin_amdgcn_sbfe((int)(w),((r)&3)+8*((r)>>2),1))

__device__ __forceinline__ void attn_unit(int b,int h,int qb,const bf16*Q,const bf16*__restrict__ K,const bf16*__restrict__ V,bf16*O,const unsigned long long*MK,float cshift,char*shm){
  const int tid=threadIdx.x,lane=tid&63,r32=lane&31,hi=lane>>5; const int wid=__builtin_amdgcn_readfirstlane(tid>>6);
  const long rowbase=(long)b*SEQ; const int q0=qb*QB;
  const bf16*Qw=Q+(rowbase+q0+wid*QBLK)*DM+h*D;
  const bf16*Kh=K+rowbase*DM+h*D,*Vh=V+rowbase*DM+h*D;
  const unsigned lds0=(unsigned)(uintptr_t)shm;
  float*wsf=(float*)(shm+LDS_WS)+wid*64;
  const bf16*ksrc=Kh+(long)lane*DM+wid*8;
  const bf16*vsrc=Vh+(long)(16*(wid&3)+(lane>>2))*DM+(wid>>2)*32+(lane&3)*8;
  const unsigned kdst=lds0+LDS_K+wid*1024, vdst=lds0+LDS_V+wid*1024;
  #define DMA_K(t,slot) glds16(ksrc+(long)(t)*KVBLK*DM,(unsigned)__builtin_amdgcn_readfirstlane(kdst+(slot)))
  #define DMA_V(t,slot) glds16(vsrc+(long)(t)*KVBLK*DM,(unsigned)__builtin_amdgcn_readfirstlane(vdst+(slot)))
  const int vb0=(int)(lds0+LDS_V)+((lane>>4)&1)*32+(lane&3)*8+(4*hi+((lane&15)>>2))*64;
  const char*Kbase=shm+LDS_K; bf16x8 kf[8];
  const lds_cptr shm3=(lds_cptr)shm; const lds_cptr kp0=shm3+LDS_K+hi*1024+r32*16; const lds_cptr vp0=shm3+LDS_V+((lane>>4)&1)*32+(lane&3)*8+(4*hi+((lane&15)>>2))*64;
  const int NT=(q0+QB)/KVBLK;
  const unsigned long long*mbase=MK+(size_t)b*(SEQ/KVBLK)*SEQ; const unsigned moff=(unsigned)(q0+wid*QBLK+r32)*8u;
  DMA_K(0,0);DMA_V(0,0);DMA_K(1,SLOTB);
  bf16x8 qr[4];
  #pragma unroll
  for(int d0=0;d0<4;++d0)qr[d0]=*reinterpret_cast<const bf16x8*>(&Qw[(long)r32*DM+d0*16+hi*8]);
  unsigned long long mC=gld8(mbase,moff), mN=gld8(mbase+SEQ,moff);
  float l_reg=0.f;f32x16 o[2];o[0]=f32x16{};o[1]=f32x16{};const f32x16 negm=f32x16{};
  (void)cshift;
  #define WAIT_BAR(N) asm volatile("s_waitcnt vmcnt(" #N ") lgkmcnt(0)\n\ts_barrier":"+v"(mN),"+v"(mC)::"memory")
  f32x16 pA0,pA1,pB0,pB1;
  int sl_prev=0,sl_cur=0,sl_next=SLOTB;
  #define ROT() do{sl_prev=sl_cur;sl_cur=sl_next;sl_next=(sl_next==(NSLOT-1)*SLOTB)?0:sl_next+SLOTB;}while(0)
  DMA_K(2,2*SLOTB);
  WAIT_BAR(3);
  qkt(pA0,pA1,Kbase,qr,r32,hi);asm volatile("s_nop 15\n\ts_nop 7":"+v"(pA0),"+v"(pA1));
  _Pragma("unroll") for(int r=0;r<16;++r){pA0[r]=__builtin_amdgcn_exp2f(pA0[r]);pA1[r]=__builtin_amdgcn_exp2f(pA1[r]);}
  WAIT_BAR(0);
  { const unsigned ma_=(unsigned)mC>>(4*hi), mb_=(unsigned)(mC>>32)>>(4*hi);
    _Pragma("unroll") for(int r=0;r<16;++r){pA0[r]=MSK(pA0[r],ma_,r);pA1[r]=MSK(pA1[r],mb_,r);} }
  DMA_K(3,0);DMA_V(1,SLOTB);
  ROT();
  kload8(kf,kp0+sl_cur);
  WAIT_BAR(2);
  s16x4 vlo[8],vhi[8]; u32x4 pw0,pw1,pw2,pw3;
  #define PKW(P,B) cvtpk_s(P[B],P[B+1])
  #define PAF(k) __builtin_bit_cast(bf16x8,pw##k)
  #define VFR(i) (bf16x8){vlo[i][0],vlo[i][1],vlo[i][2],vlo[i][3],vhi[i][0],vhi[i][1],vhi[i][2],vhi[i][3]}
  #define PIN(x) asm volatile("":"+v"(x))
  #define GAPA(MF,A0,A1,A2,A3,W0,W1,PW) do{ MF; sacc+=A0; sacc+=A1; sacc+=A2; sacc+=A3; PIN(sacc); W0; W1; PIN(PW); SBAR(); }while(0)
  #define EX(v) __builtin_amdgcn_exp2f(v)
  #define GAPB(MF,X,B,W) do{ MF; X[B]=MSK(EX(X[B]),W,B); X[B+1]=MSK(EX(X[B+1]),W,B+1); X[B+2]=MSK(EX(X[B+2]),W,B+2); X[B+3]=MSK(EX(X[B+3]),W,B+3); PIN(X); SBAR(); }while(0)
  #define VRD(i) do{ vlo[i]=vtr(vp_+(((i)>>2)*4096+((i)&3)*1024)); vhi[i]=vtr(vp_+(((i)>>2)*4096+((i)&3)*1024+512)); }while(0)
  #define KRD(G,j) do{ if(G){ kload2(kf,kp0+sl_next,j); SBAR(); } }while(0)
  #define STEP(C0,C1,P0,P1,t,GK,GV,GL) do{ SBAR(); \
    const unsigned ma_=(unsigned)mN>>(4*hi), mb_=(unsigned)(mN>>32)>>(4*hi); \
    if((t)+1<NT){ mN=gld8(mbase+(size_t)((t)+1)*SEQ,moff); } \
    const lds_cptr vp_=vp0+sl_prev; \
    VRD(0); SBAR(); float sacc=(P0[0]+P0[1]); \
    GAPA(C0=__builtin_amdgcn_mfma_f32_32x32x16_bf16(kf[0],qr[0],negm,0,0,0), P0[2],P0[3],P0[4],P0[5],     pw0[0]=PKW(P0,0), pw0[1]=PKW(P0,2), pw0); \
    VRD(4); SBAR(); GAPA(C1=__builtin_amdgcn_mfma_f32_32x32x16_bf16(kf[1],qr[0],negm,0,0,0), P0[6],P0[7],P0[8],P0[9],     pw0[2]=PKW(P0,4), pw0[3]=PKW(P0,6), pw0); \
    VRD(1); SBAR(); GAPA(C0=__builtin_amdgcn_mfma_f32_32x32x16_bf16(kf[2],qr[1],C0,0,0,0),   P0[10],P0[11],P0[12],P0[13], pw1[0]=PKW(P0,8), pw1[1]=PKW(P0,10), pw1); \
    VRD(5); SBAR(); GAPA(C1=__builtin_amdgcn_mfma_f32_32x32x16_bf16(kf[3],qr[1],C1,0,0,0),   P0[14],P0[15],P1[0],P1[1],   pw1[2]=PKW(P0,12),pw1[3]=PKW(P0,14), pw1); \
    VRD(2); SBAR(); GAPA(C0=__builtin_amdgcn_mfma_f32_32x32x16_bf16(kf[4],qr[2],C0,0,0,0),   P1[2],P1[3],P1[4],P1[5],     pw2[0]=PKW(P1,0), pw2[1]=PKW(P1,2), pw2); \
    VRD(6); SBAR(); GAPA(C1=__builtin_amdgcn_mfma_f32_32x32x16_bf16(kf[5],qr[2],C1,0,0,0),   P1[6],P1[7],P1[8],P1[9],     pw2[2]=PKW(P1,4), pw2[3]=PKW(P1,6), pw2); \
    VRD(3); SBAR(); GAPA(C0=__builtin_amdgcn_mfma_f32_32x32x16_bf16(kf[6],qr[3],C0,0,0,0),   P1[10],P1[11],P1[12],P1[13], pw3[0]=PKW(P1,8), pw3[1]=PKW(P1,10), pw3); \
    VRD(7); SBAR(); GAPA(C1=__builtin_amdgcn_mfma_f32_32x32x16_bf16(kf[7],qr[3],C1,0,0,0),   P1[14],P1[15],0.f,0.f,       pw3[2]=PKW(P1,12),pw3[3]=PKW(P1,14), pw3); \
    l_reg+=sacc; \
    if(GK){DMA_K((t)+3,sl_cur);} if(GV){DMA_V((t)+1,sl_next);} \
    SBAR(); \
    GAPB(o[0]=__builtin_amdgcn_mfma_f32_32x32x16_bf16(PAF(0),VFR(0),o[0],0,0,0), C0,0,ma_); \
    GAPB(o[1]=__builtin_amdgcn_mfma_f32_32x32x16_bf16(PAF(0),VFR(4),o[1],0,0,0), C0,4,ma_); \
    KRD(GL,0); GAPB(o[0]=__builtin_amdgcn_mfma_f32_32x32x16_bf16(PAF(1),VFR(1),o[0],0,0,0), C0,8,ma_); \
    KRD(GL,1); GAPB(o[1]=__builtin_amdgcn_mfma_f32_32x32x16_bf16(PAF(1),VFR(5),o[1],0,0,0), C0,12,ma_); \
    KRD(GL,2); GAPB(o[0]=__builtin_amdgcn_mfma_f32_32x32x16_bf16(PAF(2),VFR(2),o[0],0,0,0), C1,0,mb_); \
    KRD(GL,3); GAPB(o[1]=__builtin_amdgcn_mfma_f32_32x32x16_bf16(PAF(2),VFR(6),o[1],0,0,0), C1,4,mb_); \
    GAPB(o[0]=__builtin_amdgcn_mfma_f32_32x32x16_bf16(PAF(3),VFR(3),o[0],0,0,0), C1,8,mb_); \
    GAPB(o[1]=__builtin_amdgcn_mfma_f32_32x32x16_bf16(PAF(3),VFR(7),o[1],0,0,0), C1,12,mb_); \
    }while(0)
  int t=1;
  for(;t+5<NT;t+=2){
    STEP(pB0,pB1,pA0,pA1,t,true,true,true);     WAIT_BAR(2); ROT();
    STEP(pA0,pA1,pB0,pB1,t+1,true,true,true);   WAIT_BAR(2); ROT();
  }
  #define ENDW(tt) do{ if((tt)+3<NT){WAIT_BAR(2);} else if((tt)+2<NT){WAIT_BAR(1);} else {WAIT_BAR(0);} }while(0)
  for(;t+1<NT;t+=2){
    STEP(pB0,pB1,pA0,pA1,t,(t+3<NT),(t+1<NT),(t+1<NT));       ENDW(t);   ROT();
    STEP(pA0,pA1,pB0,pB1,t+1,(t+4<NT),(t+2<NT),(t+2<NT));     ENDW(t+1); ROT();
  }
  STEP(pB0,pB1,pA0,pA1,NT-1,false,false,false);
  { float sacc=pB0[0]+pB0[1]; _Pragma("unroll") for(int r=2;r<16;++r)sacc+=pB0[r]; _Pragma("unroll") for(int r=0;r<16;++r)sacc+=pB1[r]; l_reg+=sacc;
    pw0=(u32x4){PKW(pB0,0),PKW(pB0,2),PKW(pB0,4),PKW(pB0,6)};pw1=(u32x4){PKW(pB0,8),PKW(pB0,10),PKW(pB0,12),PKW(pB0,14)};pw2=(u32x4){PKW(pB1,0),PKW(pB1,2),PKW(pB1,4),PKW(pB1,6)};pw3=(u32x4){PKW(pB1,8),PKW(pB1,10),PKW(pB1,12),PKW(pB1,14)};
    SBAR(); pv(o,vb0+sl_cur,PAF(0),PAF(1),PAF(2),PAF(3)); }
  #undef PKW
  #undef PAF
  #undef VFR
  #undef PIN
  #undef GAPA
  #undef GAPB
  #undef EX
  #undef VRD
  #undef KRD
  #undef STEP
  #undef ENDW
  {auto rr=__builtin_amdgcn_permlane32_swap(__float_as_uint(l_reg),__float_as_uint(l_reg),false,false);l_reg=__uint_as_float(rr[0])+__uint_as_float(rr[1]);}
  if(hi==0)wsf[32+r32]=l_reg;asm volatile("s_waitcnt lgkmcnt(0)":::"memory");
  float rli[16];
  #pragma unroll
  for(int r=0;r<16;++r)rli[r]=__builtin_amdgcn_rcpf(wsf[32+crow(r,hi)]);
  bf16*Ow=O+(rowbase+q0+wid*QBLK)*OPITCH+h*D;
  { bf16*stg=(bf16*)(shm+LDS_OST)+wid*2048;
    #pragma unroll
    for(int r=0;r<16;++r){const int orow=crow(r,hi);
      #pragma unroll
      for(int d0=0;d0<2;++d0)stg[orow*64+d0*32+r32]=__float2bfloat16(o[d0][r]*rli[r]);}
    asm volatile("s_waitcnt lgkmcnt(0)":::"memory");
    #pragma unroll
    for(int i=0;i<4;++i){const int row=i*8+(lane>>3),ch=lane&7; const u32x4 v=*(const u32x4*)(stg+row*64+ch*8); *(u32x4*)(Ow+(long)row*OPITCH+ch*8)=v;} }
  asm volatile("s_waitcnt lgkmcnt(0)\n\ts_barrier":::"memory");
  #undef DMA_K
  #undef DMA_V
  #undef ROT
  #undef WAIT_BAR
}
#undef MSK
constexpr int ATTN_LDS_BYTES=LDS_BYTES;
#undef SBAR
}
#define XB_TMO      128
#define XB_XCNT(j)  (256  + 64 * (j))
#define XB_XSUB(j)  (1280 + 64 * (j))
#define XB_XGEN(j)  (2304 + 64 * (j))
#define XB_TOP      3328
#define XB_TOPGEN   3392
#define XCD_BAR_WORDS 3456
#define XB_SPIN_CAP (1u << 18)

__device__ __forceinline__ unsigned xb_ld(unsigned* p)              { return __hip_atomic_load(p, __ATOMIC_RELAXED, __HIP_MEMORY_SCOPE_AGENT); }
__device__ __forceinline__ unsigned xb_add(unsigned* p, unsigned v) { return __hip_atomic_fetch_add(p, v, __ATOMIC_RELAXED, __HIP_MEMORY_SCOPE_AGENT); }
__device__ __forceinline__ unsigned xb_xcc_id() { return (unsigned)__builtin_amdgcn_s_getreg((3 << 11) | 20) & 0xFu; }
#define XB_SPIN(cond, bar) do { unsigned _sp = 0; while (cond) { __builtin_amdgcn_s_sleep(1); \
    if ((++_sp & 255u) == 0u) { if (xb_ld(&(bar)[XB_TMO])) break; if (_sp > XB_SPIN_CAP) { atomicAdd(&(bar)[XB_TMO], 1u); break; } } } } while (0)

struct XcdBarrier {
    unsigned* bar; unsigned x;
    volatile LAS unsigned* st;
};

__device__ __forceinline__ XcdBarrier xcd_barrier_post(unsigned* bar, volatile LAS unsigned* st) {
    XcdBarrier b; b.bar = bar; b.x = xb_xcc_id(); b.st = st;
    if (threadIdx.x == 0) (void)xb_add(&bar[XB_XCNT(b.x)], 1u);
    return b;
}
__device__ __forceinline__ void xcd_barrier_complete(unsigned* bar, unsigned x, unsigned& nloc, unsigned& nx) {
    const unsigned G = gridDim.x * gridDim.y * gridDim.z;
    unsigned sum, cnt, mine, sp = 0u;
    for (;;) {
        sum = 0u; cnt = 0u; mine = 0u;
#pragma unroll
        for (unsigned j = 0; j < 16; ++j) { const unsigned c = xb_ld(&bar[XB_XCNT(j)]); sum += c; cnt += (c > 0u) ? 1u : 0u; mine = (j == x) ? c : mine; }
        if (sum == G) break;
        __builtin_amdgcn_s_sleep(1);
        if ((++sp & 255u) == 0u) { if (xb_ld(&bar[XB_TMO])) break; if (sp > XB_SPIN_CAP) { atomicAdd(&bar[XB_TMO], 1u); break; } }
    }
    nloc = mine > 0u ? mine : 1u; nx = cnt > 0u ? cnt : 1u;
}

__device__ __forceinline__ void xcd_barrier(const XcdBarrier& b) {
    asm volatile("s_waitcnt vmcnt(0)" ::: "memory");
    __syncthreads();
    if (threadIdx.x == 0) {
        unsigned* bar = b.bar;
        __builtin_amdgcn_s_waitcnt(0);
        unsigned nloc = b.st[0], nx = b.st[1];
        if (nloc == 0u) { xcd_barrier_complete(bar, b.x, nloc, nx); b.st[0] = nloc; b.st[1] = nx; }
        const unsigned old = xb_add(&bar[XB_XSUB(b.x)], 1u);
        const unsigned gen = old / nloc;
        if (old + 1u == (gen + 1u) * nloc) {
            __builtin_amdgcn_fence(__ATOMIC_RELEASE, "agent");
            asm volatile("s_waitcnt vmcnt(0)" ::: "memory");
            const unsigned og = xb_add(&bar[XB_TOP], 1u);
            const unsigned tg = og / nx;
            if (og + 1u == (tg + 1u) * nx) xb_add(&bar[XB_TOPGEN], 1u);
            else XB_SPIN(xb_ld(&bar[XB_TOPGEN]) == tg, bar);
            __builtin_amdgcn_fence(__ATOMIC_ACQUIRE, "agent");
            xb_add(&bar[XB_XGEN(b.x)], 1u);
            asm volatile("s_waitcnt vmcnt(0)" ::: "memory");
        } else {
            XB_SPIN(xb_ld(&bar[XB_XGEN(b.x)]) == gen, bar);
            __builtin_amdgcn_fence(__ATOMIC_ACQUIRE, "agent");
            asm volatile("s_waitcnt vmcnt(0)" ::: "memory");
        }
    }
    __syncthreads();
}
struct Frame {
    LAS unsigned char* lds;
    volatile LAS unsigned* MISC;
    gu32* ctl;
    int tid, lane, wave;
    int vcu, G;
    unsigned char* ws;
    const float* in[18]; float* out;
};
__device__ __forceinline__ float wave_sum(float v) {
#pragma unroll
    for (int o = 1; o < 64; o <<= 1) v += __shfl_xor(v, o);
    return v;
}
__device__ __forceinline__ float wave_max(float v) {
#pragma unroll
    for (int o = 1; o < 64; o <<= 1) v = fmaxf(v, __shfl_xor(v, o));
    return v;
}
template <int MODE> __device__ __forceinline__ int tr_row(int n) {
    if (MODE == 0) return n < 1860 ? n : n + 188;
    if (MODE == 1) return n < 1024 ? 256 * (n >> 7) + (n & 127) : 256 * ((n - 1024) >> 7) + 128 + ((n - 1024) & 127);
    if (MODE == 4) return 256 * (n >> 7) + (n & 127);
    if (MODE == 5) return 256 * (n >> 7) + 128 + (n & 127);
    return n;
}
template <int MODE> __device__ __forceinline__ void tr_item(const float* W, int N, bf16* WT, int ldt, int koff, LAS float* scr, int kb, int nb, int lane) {
    const int k0 = 64 * kb, n0 = 64 * nb, cq = 4 * (lane & 15), r0 = lane >> 4; const bool colok = (n0 + cq) < N;
    f32x4 v[16];
#pragma unroll
    for (int j = 0; j < 16; ++j) v[j] = colok ? *(const GAS f32x4*)(W + (size_t)(k0 + r0 + 4 * j) * N + n0 + cq) : (f32x4){0.f, 0.f, 0.f, 0.f};
#pragma unroll
    for (int j = 0; j < 16; ++j) { LAS float* d = scr + (r0 + 4 * j) * 65 + cq; d[0] = v[j].x; d[1] = v[j].y; d[2] = v[j].z; d[3] = v[j].w; }
    LDS_WAIT(); asm volatile("" ::: "memory");
    const int c = lane & 7;
#pragma unroll
    for (int j = 0; j < 8; ++j) { const int n = (lane >> 3) + 8 * j; const LAS float* s = scr + (8 * c) * 65 + n;
        v4u o; o.x = pk2(s[0 * 65], s[1 * 65]); o.y = pk2(s[2 * 65], s[3 * 65]); o.z = pk2(s[4 * 65], s[5 * 65]); o.w = pk2(s[6 * 65], s[7 * 65]);
        if (n0 + n < N) *(GAS v4u*)(WT + (size_t)tr_row<MODE>(n0 + n) * ldt + koff + k0 + 8 * c) = o; }
    LDS_WAIT(); asm volatile("" ::: "memory");
}
__device__ __forceinline__ void rms_row_to_bf16(const float* xrow, const float* g, bf16* orow, int lane) {
    const GAS f32x4* xr = (const GAS f32x4*)xrow + lane; const GAS f32x4* gr = (const GAS f32x4*)g + lane;
    f32x4 v[4]; float s = 0.f;
#pragma unroll
    for (int j = 0; j < 4; ++j) { v[j] = xr[64 * j]; s += (v[j].x * v[j].x + v[j].y * v[j].y) + (v[j].z * v[j].z + v[j].w * v[j].w); }
    const float r = 1.0f / sqrtf(wave_sum(s) * (1.f / 1024.f) + EPS);
    GAS unsigned long long* o8 = (GAS unsigned long long*)orow + lane;
#pragma unroll
    for (int j = 0; j < 4; ++j) { const f32x4 gv = gr[64 * j]; o8[64 * j] = (unsigned long long)pk2(v[j].x * r * gv.x, v[j].y * r * gv.y) | ((unsigned long long)pk2(v[j].z * r * gv.z, v[j].w * r * gv.w) << 32); }
}
__device__ __forceinline__ void p0_prologue(Frame& F) {
    LAS float* scr = (LAS float*)(F.lds + RING_OFF + F.wave * 16640);
    const int gw = F.vcu * NWAVES + F.wave, NGW = F.G * NWAVES;
    bf16* Win_t = (bf16*)(F.ws + WS_WIN); bf16* Wab_t = (bf16*)(F.ws + WS_WAB); bf16* Wout_t = (bf16*)(F.ws + WS_WOUT); bf16* Wpool_t = (bf16*)(F.ws + WS_WPOOL);
    bf16* W1_t = (bf16*)(F.ws + WS_W1); bf16* W2_t = (bf16*)(F.ws + WS_W2);
    constexpr int I_W1 = 32 * 16 * 32, I_W2 = 32 * 16 * 16, I_IN = 16 * 70, I_OUT = 16 * 16, I_WA = 8 * 16, I_WB = 8 * 16, I_POOL = 16;
    constexpr int NITEMS = I_W1 + I_W2 + I_IN + I_OUT + I_WA + I_WB + I_POOL;
    for (int it = gw; it < NITEMS; it += NGW) {
        int r = it;
        if (r < I_W1) { const int e = r >> 9, rr = r & 511; tr_item<1>(F.in[14] + (size_t)e * 1024 * 2048, 2048, W1_t + (size_t)e * 2048 * 1024, 1024, 0, scr, rr >> 5, rr & 31, F.lane); continue; } r -= I_W1;
        if (r < I_W2) { const int e = r >> 8, rr = r & 255; tr_item<2>(F.in[16] + (size_t)e * 1024 * 1024, 1024, W2_t + (size_t)e * 1024 * 1024, 1024, 0, scr, rr >> 4, rr & 15, F.lane); continue; } r -= I_W2;
        if (r < I_IN) { tr_item<0>(F.in[2], NIN, Win_t, 1024, 0, scr, r / 70, r % 70, F.lane); continue; } r -= I_IN;
        if (r < I_OUT) { tr_item<2>(F.in[10], 1024, Wout_t, 1024, 0, scr, r >> 4, r & 15, F.lane); continue; } r -= I_OUT;
        if (r < I_WA) { tr_item<2>(F.in[8], 1024, Wab_t, 512, 0, scr, r >> 4, r & 15, F.lane); continue; } r -= I_WA;
        if (r < I_WB) { tr_item<2>(F.in[9], 1024, Wab_t + 1024 * 512, 512, 0, scr, r >> 4, r & 15, F.lane); continue; } r -= I_WB;
        { const int g = r >> 2, rr = r & 3; tr_item<2>(F.in[5] + (size_t)g * 128 * 128, 128, Wpool_t + (size_t)(128 * g) * 512, 512, 128 * g, scr, rr >> 1, rr & 1, F.lane); }
    }
    const int gt = F.vcu * (NWAVES * 64) + F.tid, NGT = F.G * NWAVES * 64; const v4u z = {0u, 0u, 0u, 0u};
    for (int i = gt; i < 512 * 64; i += NGT) { const int row = i >> 6, ch = i & 63; if ((ch >> 4) != (row >> 7)) *(GAS v4u*)(Wpool_t + (size_t)row * 512 + ch * 8) = z; }
    for (int i = gt; i < 188 * 128; i += NGT) { const int row = 1860 + (i >> 7), ch = i & 127; *(GAS v4u*)(Win_t + (size_t)row * 1024 + ch * 8) = z; }
    bf16* H = (bf16*)(F.ws + WS_H);
    { const GAS f32x4* gr = (const GAS f32x4*)F.in[1] + F.lane; f32x4 gv[4];
#pragma unroll
      for (int j = 0; j < 4; ++j) gv[j] = gr[64 * j];
      for (int m0 = gw; m0 < M; m0 += 4 * NGW) { f32x4 v[4][4];
#pragma unroll
          for (int u = 0; u < 4; ++u) { const GAS f32x4* xr = (const GAS f32x4*)(F.in[0] + (size_t)(m0 + u * NGW) * 1024) + F.lane;
#pragma unroll
              for (int j = 0; j < 4; ++j) v[u][j] = xr[64 * j]; }
#pragma unroll
          for (int u = 0; u < 4; ++u) { float ss = 0.f;
#pragma unroll
              for (int j = 0; j < 4; ++j) ss += (v[u][j].x * v[u][j].x + v[u][j].y * v[u][j].y) + (v[u][j].z * v[u][j].z + v[u][j].w * v[u][j].w);
              const float r = 1.0f / sqrtf(wave_sum(ss) * (1.f / 1024.f) + EPS); GAS unsigned long long* o8 = (GAS unsigned long long*)(H + (size_t)(m0 + u * NGW) * 1024) + F.lane;
#pragma unroll
              for (int j = 0; j < 4; ++j) { const f32x4 y = v[u][j] * r * gv[j]; o8[64 * j] = (unsigned long long)pk2(y.x, y.y) | ((unsigned long long)pk2(y.z, y.w) << 32); } } } }
}
__device__ __forceinline__ void qknorm_rows(Frame& F, bool dry = false) {
    const int gw = F.vcu * NWAVES + F.wave, NGW = F.G * NWAVES, lane = F.lane;
    bf16* Q = (bf16*)(F.ws + WS_Q); bf16* K = (bf16*)(F.ws + WS_K);
    const int d0 = (lane & 7) * 8;
    float gq[8], gk[8];
#pragma unroll
    for (int j = 0; j < 8; ++j) { gq[j] = F.in[3][d0 + j] * attn_body::C2; gk[j] = F.in[4][d0 + j]; }
    for (int m0 = gw; m0 < 2 * M; m0 += 4 * NGW) {
        v4u w[4]; bf16* p[4]; bool isq[4];
#pragma unroll
        for (int u = 0; u < 4; ++u) { const int m = m0 + u * NGW; isq[u] = m < M; p[u] = (isq[u] ? Q + (size_t)m * 512 : K + (size_t)(m - M) * 512) + lane * 8; w[u] = (m < 2 * M) ? *(const GAS v4u*)p[u] : (v4u){0u, 0u, 0u, 0u}; }
#pragma unroll
        for (int u = 0; u < 4; ++u) { if (m0 + u * NGW >= 2 * M) break;
            float x[8] = {bflo(w[u].x), bfhi(w[u].x), bflo(w[u].y), bfhi(w[u].y), bflo(w[u].z), bfhi(w[u].z), bflo(w[u].w), bfhi(w[u].w)};
            float s = 0.f;
#pragma unroll
            for (int j = 0; j < 8; ++j) s += x[j] * x[j];
            s += __shfl_xor(s, 1); s += __shfl_xor(s, 2); s += __shfl_xor(s, 4);
            const float r = 1.0f / sqrtf(s * (1.f / 64.f) + EPS);
#pragma unroll
            for (int j = 0; j < 8; ++j) x[j] = x[j] * r * (isq[u] ? gq[j] : gk[j]);
            v4u o; o.x = pk2(x[0], x[1]); o.y = pk2(x[2], x[3]); o.z = pk2(x[4], x[5]); o.w = pk2(x[6], x[7]);
            *(GAS v4u*)p[u] = dry ? w[u] : o; }
    }
}
__device__ __forceinline__ void pool_diff_rows(Frame& F) {
    const int gw = F.vcu * NWAVES + F.wave, NGW = F.G * NWAVES, lane = F.lane;
    const bf16* U = (const bf16*)(F.ws + WS_U); bf16* Dd = (bf16*)(F.ws + WS_DIFF);
    const int win = 2 << (lane >> 4);
    for (int m = gw; m < M; m += NGW) {
        const int t = m & (SEQ - 1); const int cnt = (t + 1 < win) ? t + 1 : win;
        v4u w[16];
#pragma unroll
        for (int j = 0; j < 16; ++j) w[j] = (j < cnt) ? *(const GAS v4u*)(U + (size_t)(m - j) * 512 + lane * 8) : (v4u){0u, 0u, 0u, 0u};
        float a[8] = {0.f, 0.f, 0.f, 0.f, 0.f, 0.f, 0.f, 0.f};
#pragma unroll
        for (int j = 0; j < 16; ++j) { a[0] += bflo(w[j].x); a[1] += bfhi(w[j].x); a[2] += bflo(w[j].y); a[3] += bfhi(w[j].y); a[4] += bflo(w[j].z); a[5] += bfhi(w[j].z); a[6] += bflo(w[j].w); a[7] += bfhi(w[j].w); }
        const float inv = 1.0f / (float)cnt; v4u o;
        o.x = pk2(a[0] * inv - bflo(w[0].x), a[1] * inv - bfhi(w[0].x)); o.y = pk2(a[2] * inv - bflo(w[0].y), a[3] * inv - bfhi(w[0].y));
        o.z = pk2(a[4] * inv - bflo(w[0].z), a[5] * inv - bfhi(w[0].z)); o.w = pk2(a[6] * inv - bflo(w[0].w), a[7] * inv - bfhi(w[0].w));
        *(GAS v4u*)(Dd + (size_t)m * 512 + lane * 8) = o;
    }
}
__device__ __forceinline__ int tk_fidx(int q) { return (((q >> 3) * 2 + (q & 1)) * 4) + ((q & 7) >> 1); }
__device__ __forceinline__ float relu_f(float x) { const int b = __builtin_bit_cast(int, x); return __builtin_bit_cast(float, b > 0 ? b : 0); }
__device__ __forceinline__ unsigned wave_incl_scan(unsigned v, int lane) {
    v += (unsigned)__builtin_amdgcn_update_dpp(0, (int)v, 0x111, 0xf, 0xf, false);
    v += (unsigned)__builtin_amdgcn_update_dpp(0, (int)v, 0x112, 0xf, 0xf, false);
    v += (unsigned)__builtin_amdgcn_update_dpp(0, (int)v, 0x114, 0xf, 0xf, false);
    v += (unsigned)__builtin_amdgcn_update_dpp(0, (int)v, 0x118, 0xf, 0xf, false);
    const unsigned t0 = (unsigned)__builtin_amdgcn_readlane((int)v, 15), t1 = (unsigned)__builtin_amdgcn_readlane((int)v, 31), t2 = (unsigned)__builtin_amdgcn_readlane((int)v, 47);
    return v + (lane >= 16 ? t0 : 0u) + (lane >= 32 ? t1 : 0u) + (lane >= 48 ? t2 : 0u);
}
struct TkState {
    LAS unsigned char* lds;
    __device__ __forceinline__ LAS unsigned* x(int words) const { return (LAS unsigned*)(lds + XTRA_OFF) + words; }
    __device__ __forceinline__ LAS unsigned* hist_() const { return (LAS unsigned*)(lds + RING_OFF); }
    __device__ __forceinline__ LAS unsigned long long* clist_() const { return (LAS unsigned long long*)(lds + XTRA_OFF + 4096); }
    __device__ __forceinline__ const LAS bf16x8* afl_() const { return (const LAS bf16x8*)(lds + RING_OFF + 131072); }
#define TK_F(name, off) __device__ __forceinline__ LAS unsigned* name() const { return x(off); }
    TK_F(sl_lb_, 0)
    TK_F(sl_p1_, 32)
    TK_F(sl_p2_, 64)
    TK_F(sl_lo_, 96)
    TK_F(sl_hi_, 128)
    TK_F(sl_kth_, 160)
    TK_F(need_, 192)
    TK_F(neq_, 224)
    TK_F(ccnt_, 256)
    TK_F(cmin_, 288)
    TK_F(cmax_, 320)
    TK_F(flag_, 352)
    TK_F(wl_, 448)
#undef TK_F
};
constexpr int TK_CAP = 32;
template <int MODE> __device__ __forceinline__ void tk_scan(const TkState& T, int wave, int lane_in, bool MID) {
    int lane = lane_in; asm volatile("" : "+v"(lane));
    for (int qq = 0; qq < 4; ++qq) {
        const int q = 4 * wave + qq, fi = tk_fidx(q); LAS unsigned* hq = T.hist_() + q * 1024;
        bool up;
        int base;
        unsigned pre = 0u;
        if (MODE == 2) { pre = MID ? T.sl_p1_()[fi] : T.sl_p2_()[fi]; const bool neg = MID ? (pre >= 512u) : (pre >= (512u << 11)); up = neg; base = neg ? 16 * lane : 1024 - 16 * (lane + 1); }
        else { up = lane >= 32; base = up ? 512 + 16 * (lane - 32) : 512 - 16 * (lane + 1); }
        unsigned dr[16], d[16];
#pragma unroll
        for (int i = 0; i < 4; ++i) { const v4u v = *(const LAS v4u*)(hq + base + 4 * i); dr[4 * i] = v.x; dr[4 * i + 1] = v.y; dr[4 * i + 2] = v.z; dr[4 * i + 3] = v.w;
            if (MODE != 1) *(LAS v4u*)(hq + base + 4 * i) = (v4u){0u, 0u, 0u, 0u}; }
#pragma unroll
        for (int i = 0; i < 16; ++i) d[i] = up ? dr[i] : dr[15 - i];
        unsigned s = 0u;
#pragma unroll
        for (int i = 0; i < 16; ++i) s += (MODE == 2) ? ((d[i] & 0xffffu) + (d[i] >> 16)) : d[i];
        const unsigned inc = wave_incl_scan(s, lane);
        const unsigned nd = (MODE == 1) ? (unsigned)TOPK : T.need_()[q];
        const unsigned long long bal = __ballot(inc >= nd);
        if (MODE == 1 && bal == 0ull) continue;
        const int Ls = __builtin_amdgcn_readfirstlane(bal ? (int)__ffsll((long long)bal) - 1 : 63);
        unsigned run = inc - s, fpos = 0u, fneed = 1u, fcnt = 1u; bool found = false;
#pragma unroll
        for (int i = 0; i < 16; ++i) {
            if (MODE != 2) { const unsigned c = d[i]; if (!found && run + c >= nd) { found = true; fpos = (unsigned)i; fneed = nd - run; fcnt = c; } run += c; }
            else { const unsigned c0 = up ? (d[i] & 0xffffu) : (d[i] >> 16), c1 = up ? (d[i] >> 16) : (d[i] & 0xffffu);
                if (!found && run + c0 >= nd) { found = true; fpos = 2u * i; fneed = nd - run; fcnt = c0; } run += c0;
                if (!found && run + c1 >= nd) { found = true; fpos = 2u * i + 1u; fneed = nd - run; fcnt = c1; } run += c1; }
        }
        unsigned fbin;
        if (MODE != 2) fbin = up ? (unsigned)base + fpos : (unsigned)base + 15u - fpos;
        else { const unsigned dw = up ? (unsigned)base + (fpos >> 1) : (unsigned)base + 15u - (fpos >> 1); fbin = 2u * dw + (up ? (fpos & 1u) : 1u - (fpos & 1u)); }
        fbin = (unsigned)__builtin_amdgcn_readlane((int)fbin, Ls); fneed = (unsigned)__builtin_amdgcn_readlane((int)fneed, Ls); fcnt = (unsigned)__builtin_amdgcn_readlane((int)fcnt, Ls);
        if (lane == 0) {
            if (MODE == 1) T.sl_lb_()[fi] = fbin < 512u ? (fbin << 22) : ((fbin << 22) | 0x3fffffu);
            if (MODE == 0) { T.sl_p1_()[fi] = fbin; T.need_()[q] = fneed; T.neq_()[q] = fcnt; }
            if (MODE == 2 && MID) { const unsigned p21 = (pre << 11) | fbin, a = p21 << 11, bb = a | 0x7ffu; const bool neg = pre >= 512u;
                T.sl_p2_()[fi] = p21; T.sl_lo_()[fi] = neg ? bb : a; T.sl_hi_()[fi] = neg ? a : bb; T.need_()[q] = fneed; T.neq_()[q] = fcnt; }
            if (MODE == 2 && !MID) { const unsigned kth = (pre << 11) | fbin; T.sl_lo_()[fi] = kth; T.sl_hi_()[fi] = kth; T.need_()[q] = fneed; T.neq_()[q] = fcnt; }
        }
    }
}
template <int PASS> __device__ __forceinline__ void topk_pass(const bf16x8 (&af)[4][4], const LAS f32x4* wl4, const bf16* IKb, int nb, const TkState& T, int wave, int lane_in, bool low, unsigned one = 1u) {
    int lane = lane_in; asm volatile("" : "+v"(lane));
    const int hi = lane >> 5, n32 = lane & 31;
    const unsigned sh_m = low ? 11u : 22u, sh_b = low ? 0u : 11u;
    LAS unsigned* GT = T.hist_(); LAS unsigned* EQ = T.hist_() + 32 * 257;
    const bf16* kp0 = IKb + (size_t)lane * 8;
    bf16x8 bc[4];
    if (wave < nb) {
#pragma unroll
        for (int kk = 0; kk < 4; ++kk) bc[kk] = *(const GAS bf16x8*)(kp0 + (size_t)wave * 2048 + 512 * kk); }
    const LAS v4u* pa = (const LAS v4u*)(PASS == 2 ? T.sl_lo_() : (low ? T.sl_p2_() : T.sl_p1_()));
    const LAS v4u* pb = (const LAS v4u*)T.sl_hi_();
    for (int blk = wave; blk < nb; blk += 8) {
        f32x4 wq[4]; v4u pfv, pgv;
#define TK_LDW(qg) do { _Pragma("unroll") for (int jj = 0; jj < 4; ++jj) wq[jj] = wl4[((qg) * 2 + hi) * 4 + jj]; pfv = pa[(qg) * 2 + hi]; if (PASS == 2) pgv = pb[(qg) * 2 + hi]; } while (0)
        f32x16 acc[2];
#define TK_MMA(dst, qg) do { dst = f32x16{}; _Pragma("unroll") for (int kk = 0; kk < 4; ++kk) dst = __builtin_amdgcn_mfma_f32_32x32x16_bf16(af[qg][kk], bc[kk], dst, 0, 0, 0); } while (0)
        TK_MMA(acc[0], 0);
#pragma unroll
        for (int qg = 0; qg < 4; ++qg) {
            TK_LDW(qg);
            if (qg < 3) TK_MMA(acc[(qg + 1) & 1], qg + 1);
            if (qg == 2 && blk + 8 < nb) {
#pragma unroll
                for (int kk = 0; kk < 4; ++kk) bc[kk] = *(const GAS bf16x8*)(kp0 + (size_t)(blk + 8) * 2048 + 512 * kk); }
            const f32x16& a = acc[qg & 1];
#define TK_PIN4(x) asm volatile("" : "+v"(x[0]), "+v"(x[1]), "+v"(x[2]), "+v"(x[3]))
            float sc[4], r0[4], r1[4], r2[4], r3[4];
#pragma unroll
            for (int jj = 0; jj < 4; ++jj) { r0[jj] = relu_f(a[4 * jj + 0]); r1[jj] = relu_f(a[4 * jj + 1]); r2[jj] = relu_f(a[4 * jj + 2]); r3[jj] = relu_f(a[4 * jj + 3]); }
            TK_PIN4(r0); TK_PIN4(r1); TK_PIN4(r2); TK_PIN4(r3);
#pragma unroll
            for (int jj = 0; jj < 4; ++jj) sc[jj] = fmaf(wq[jj][0], r0[jj], 0.f);
            TK_PIN4(sc);
#pragma unroll
            for (int jj = 0; jj < 4; ++jj) sc[jj] = fmaf(wq[jj][1], r1[jj], sc[jj]);
            TK_PIN4(sc);
#pragma unroll
            for (int jj = 0; jj < 4; ++jj) sc[jj] = fmaf(wq[jj][2], r2[jj], sc[jj]);
            TK_PIN4(sc);
#pragma unroll
            for (int jj = 0; jj < 4; ++jj) sc[jj] = fmaf(wq[jj][3], r3[jj], sc[jj]);
            TK_PIN4(sc);
#undef TK_PIN4
            LAS unsigned* hq0 = T.hist_() + (8 * qg + hi) * 1024;
            if (PASS == 0) {
#pragma unroll
                for (int jj = 0; jj < 4; ++jj) __hip_atomic_fetch_add(hq0 + jj * 2048 + (__float_as_uint(sc[jj]) >> 22), one, __ATOMIC_RELAXED, __HIP_MEMORY_SCOPE_WORKGROUP); }
            if (PASS == 1) {
#pragma unroll
                for (int jj = 0; jj < 4; ++jj) { const unsigned u = __float_as_uint(sc[jj]); if ((u >> sh_m) == pfv[jj]) { const unsigned bin = (u >> sh_b) & 0x7ffu; __hip_atomic_fetch_add(hq0 + jj * 2048 + (bin >> 1), one << ((bin & 1u) * 16u), __ATOMIC_RELAXED, __HIP_MEMORY_SCOPE_WORKGROUP); } } }
            if (PASS == 2) {
                unsigned long long bg[4], be[4]; unsigned long long anye = 0ull;
#pragma unroll
                for (int jj = 0; jj < 4; ++jj) {
                    bg[jj] = __ballot(sc[jj] > __uint_as_float(pgv[jj])); be[jj] = __ballot(sc[jj] >= __uint_as_float(pfv[jj])) & ~bg[jj];
                    anye |= be[jj]; }
                unsigned vg = 0u;
#pragma unroll
                for (int jj = 0; jj < 4; ++jj) { vg = (lane == 2 * jj) ? (unsigned)bg[jj] : vg; vg = (lane == 2 * jj + 1) ? (unsigned)(bg[jj] >> 32) : vg; }
                if (lane < 8) GT[(8 * qg + lane) * 257 + blk] = vg;
                if (anye != 0ull) {
                    unsigned ve = 0u;
#pragma unroll
                    for (int jj = 0; jj < 4; ++jj) { ve = (lane == 2 * jj) ? (unsigned)be[jj] : ve; ve = (lane == 2 * jj + 1) ? (unsigned)(be[jj] >> 32) : ve; }
                    if (lane < 8) EQ[(8 * qg + lane) * 257 + blk] = ve;
                    if (!low) {
#pragma unroll
                        for (int jj = 0; jj < 4; ++jj) { if ((be[jj] >> lane) & 1ull) { const int q = 8 * qg + 2 * jj + hi; const unsigned u = __float_as_uint(sc[jj]);
                            const unsigned slot = __hip_atomic_fetch_add(T.ccnt_() + q, 1u, __ATOMIC_RELAXED, __HIP_MEMORY_SCOPE_WORKGROUP);
                            __hip_atomic_fetch_min(T.cmin_() + q, u, __ATOMIC_RELAXED, __HIP_MEMORY_SCOPE_WORKGROUP); __hip_atomic_fetch_max(T.cmax_() + q, u, __ATOMIC_RELAXED, __HIP_MEMORY_SCOPE_WORKGROUP);
                            if (slot < (unsigned)TK_CAP) T.clist_()[q * TK_CAP + slot] = ((unsigned long long)u << 32) | (unsigned)(32 * blk + n32); } } }
                }
            }
        }
#undef TK_MMA
#undef TK_LDW
#undef TK_LDA
    }
}
__device__ __forceinline__ void tk_keep_first(LAS unsigned* eqr, unsigned nd, int lane) {
    unsigned w[4], pc = 0u;
#pragma unroll
    for (int i = 0; i < 4; ++i) { w[i] = eqr[4 * lane + i]; pc += (unsigned)__builtin_popcount(w[i]); }
    const unsigned inc = wave_incl_scan(pc, lane);
    unsigned before = inc - pc;
#pragma unroll
    for (int i = 0; i < 4; ++i) { const unsigned p = (unsigned)__builtin_popcount(w[i]); const int take = (int)nd - (int)before;
        if (take <= 0) w[i] = 0u; else if (take < (int)p) { unsigned x = w[i], r = 0u; for (int k = 0; k < take; ++k) { const unsigned lsb = x & (0u - x); r |= lsb; x ^= lsb; } w[i] = r; }
        before += p; eqr[4 * lane + i] = w[i]; }
}
__device__ __forceinline__ void topk_unit(Frame& F, int b, int c, int half) {
    const bf16* IQ = (const bf16*)(F.ws + WS_IQ); const bf16* IK = (const bf16*)(F.ws + WS_IK); const float* IW = (const float*)(F.ws + WS_IW);
    unsigned long long* MK = (unsigned long long*)(F.ws + WS_MASK);
    TkState T; T.lds = F.lds;
    LAS float* wl = (LAS float*)T.wl_();
    LAS unsigned* GT = T.hist_(); LAS unsigned* EQ = T.hist_() + 32 * 257;
    int tid = F.tid; asm volatile("" : "+v"(tid));
    const int lane = tid & 63, wave = F.wave;
    const int t0 = 64 * c + 32 * half, L = 64 * (c + 1), nb = L / 32; const size_t tokb = (size_t)b * SEQ;
    const int ntile = 4 * (c / 4 + 1);
#pragma unroll
    for (int i = 0; i < 16; ++i) ((LAS v4u*)T.hist_())[tid + 512 * i] = (v4u){0u, 0u, 0u, 0u};
    if (tid < 32) { T.sl_lb_()[tid] = 0xff800000u  ; T.need_()[tid] = (unsigned)TOPK; T.neq_()[tid] = 0u; T.ccnt_()[tid] = 0u; T.cmin_()[tid] = 0xffffffffu; T.cmax_()[tid] = 0u; if (tid == 0) T.flag_()[0] = 0u; }
    if (tid < 128) { const int q = tid >> 2, hd = tid & 3; wl[tk_fidx(q) * 4 + hd] = IW[(tokb + t0 + q) * 4 + hd] * 0.0625f; }
    __syncthreads();
    if (L > TOPK) {
        const LAS f32x4* wr = (const LAS f32x4*)wl;
        bf16x8 af[4][4];
#pragma unroll
        for (int qg = 0; qg < 4; ++qg)
#pragma unroll
            for (int kk = 0; kk < 4; ++kk) af[qg][kk] = *(const GAS bf16x8*)(IQ + (tokb + t0 + 8 * qg) * 256 + (lane & 31) * 64 + 16 * kk + 8 * (lane >> 5));
        const bf16* IKb = IK + tokb * 64;
        if ((REP_PHASE) == 22) topk_pass<0>(af, wr, IKb, nb, T, wave, lane, false, 0u);
        topk_pass<0>(af, wr, IKb, nb, T, wave, lane, false); __syncthreads(); tk_scan<0>(T, wave, lane, true); __syncthreads();
        for (int round = 0; round < 2; ++round) {
            const bool low = round != 0;
            if (low) { if (T.flag_()[0] == 0u && (REP_PHASE) != 50) break;
                __syncthreads();
#pragma unroll
                for (int i = 0; i < 16; ++i) ((LAS v4u*)T.hist_())[tid + 512 * i] = (v4u){0u, 0u, 0u, 0u};
                __syncthreads(); }
            if ((REP_PHASE) == 23) topk_pass<1>(af, wr, IKb, nb, T, wave, lane, low, 0u);
            topk_pass<1>(af, wr, IKb, nb, T, wave, lane, low); __syncthreads(); tk_scan<2>(T, wave, lane, !low); __syncthreads();
            for (int rep_ = 0; rep_ < ((REP_PHASE) == 20 ? 2 : 1); ++rep_) { if (rep_) { __syncthreads(); if (tid < 32) { T.ccnt_()[tid] = 0u; } __syncthreads(); } topk_pass<2>(af, wr, IKb, nb, T, wave, lane, low); }
            __syncthreads();
            for (int qq = 0; qq < 4; ++qq) { const int q = 4 * wave + qq; const unsigned nd = T.need_()[q], nc = T.neq_()[q];
                if (nd >= nc) continue;
                if (low || T.cmin_()[q] == T.cmax_()[q]) { tk_keep_first(EQ + q * 257, nd, lane); continue; }
                if (nc <= (unsigned)TK_CAP && (TK_CAP) > 0) {
                    const unsigned long long me = (lane < (int)nc) ? T.clist_()[q * TK_CAP + lane] : 0ull; const float mv = __uint_as_float((unsigned)(me >> 32)); const unsigned mi = (unsigned)me; unsigned rank = 0u;
                    for (unsigned j = 0; j < nc; ++j) { const unsigned long long o = T.clist_()[q * TK_CAP + j]; const float ov = __uint_as_float((unsigned)(o >> 32)); const unsigned oi = (unsigned)o; rank += (ov > mv || (ov == mv && oi < mi)) ? 1u : 0u; }
                    if (lane < (int)nc && rank >= nd) __hip_atomic_fetch_and(EQ + q * 257 + (mi >> 5), ~(1u << (mi & 31u)), __ATOMIC_RELAXED, __HIP_MEMORY_SCOPE_WORKGROUP);
                    continue; }
                if (lane == 0) T.flag_()[0] = 1u;
            }
            __syncthreads();
            if ((REP_PHASE) == 50 && low) { if (tid < 32) T.ccnt_()[tid] = 0u; __syncthreads(); }
            for (int idx = tid; idx < 32 * ntile; idx += NWAVES * 64) { const int q = idx & 31, t = idx >> 5;
                const unsigned w0 = GT[q * 257 + 2 * t] | EQ[q * 257 + 2 * t], w1 = GT[q * 257 + 2 * t + 1] | EQ[q * 257 + 2 * t + 1];
                const unsigned long long wv = (unsigned long long)w0 | ((unsigned long long)w1 << 32); unsigned long long* dst = MK + ((size_t)b * 128 + t) * SEQ + t0 + q;
                if ((REP_PHASE) == 50 && low) { if (*dst != wv) __hip_atomic_store(F.ctl + CW_CODE, 1u, RLX_AGENT); __hip_atomic_fetch_add(T.ccnt_() + q, (unsigned)__builtin_popcountll(wv), __ATOMIC_RELAXED, __HIP_MEMORY_SCOPE_WORKGROUP); }
                else *dst = wv; }
            __syncthreads();
            if ((REP_PHASE) == 50 && low) { if (tid < 32 && T.ccnt_()[tid] != (unsigned)TOPK) __hip_atomic_store(F.ctl + CW_CODE, 1u, RLX_AGENT); __syncthreads(); }
        }
    } else {
        for (int idx = tid; idx < 32 * ntile; idx += NWAVES * 64) { const int q = idx & 31, t = idx >> 5;
            const unsigned w0 = (2 * t < nb) ? 0xffffffffu : 0u, w1 = (2 * t + 1 < nb) ? 0xffffffffu : 0u;
            MK[((size_t)b * 128 + t) * SEQ + t0 + q] = (unsigned long long)w0 | ((unsigned long long)w1 << 32); }
        __syncthreads();
    }
}
typedef float f32x16r __attribute__((ext_vector_type(16)));
__device__ __forceinline__ void router_phase(Frame& F, bool dry = false) {
    LAS float* tab = (LAS float*)(F.lds + RING_OFF);
    LAS float* xch = (LAS float*)(F.lds + RING_OFF + 131072);
    LAS float* ssq = (LAS float*)(F.lds + XTRA_OFF);
    LAS float* rs = ssq + 512;
    LAS unsigned* lc = (LAS unsigned*)(rs + 64);
    LAS unsigned* basep = lc + 32;
    LAS unsigned* rec_e = basep + 32; LAS unsigned* rec_r = rec_e + 256; LAS float* rec_w = (LAS float*)(rec_r + 256);
    const int tid = F.tid, lane = F.lane, wave = F.wave, m32 = lane & 31, kh = lane >> 5, tile = wave >> 2, kq = wave & 3;
    const float* x1 = F.out; const float* g2 = F.in[11]; const float* rw = F.in[12]; const float* rb = F.in[13];
    bf16* H2 = (bf16*)(F.ws + WS_H2); int* TOKE = (int*)(F.ws + WS_TOKE); int* TOKP = TOKE + M * 4; float* TOKW = (float*)(TOKP + M * 4);
    for (int i0 = tid; i0 < 1024 * 8; i0 += 4 * NWAVES * 64) { f32x4 v[4]; float g[4];
#pragma unroll
        for (int u = 0; u < 4; ++u) { const int i = i0 + u * NWAVES * 64; v[u] = *(const GAS f32x4*)(rw + (size_t)(i >> 3) * 32 + 4 * (i & 7)); g[u] = g2[i >> 3]; }
#pragma unroll
        for (int u = 0; u < 4; ++u) { const int i = i0 + u * NWAVES * 64, k = i >> 3, n0 = 4 * (i & 7); LAS float* d = tab + ((k >> 2) * 32 + n0) * 4 + (k & 3);
            d[0] = v[u].x * g[u]; d[4] = v[u].y * g[u]; d[8] = v[u].z * g[u]; d[12] = v[u].w * g[u]; } }
    if (tid < 32) lc[tid] = 0u;
    __syncthreads();
    for (int tb = blockIdx.x; tb < M / 64; tb += F.G) {
        {
            const size_t tok = (size_t)tb * 64 + tile * 32 + m32; const GAS f32x4* xr = (const GAS f32x4*)(x1 + tok * 1024) + 64 * kq + kh;
            const LAS f32x4* br = (const LAS f32x4*)tab + (size_t)(64 * kq + kh) * 32 + m32;
            f32x16r acc = {}; float ss = 0.f;
#pragma unroll 1
            for (int j0 = 0; j0 < 32; j0 += 8) { f32x4 xv[8];
#pragma unroll
                for (int u = 0; u < 8; ++u) xv[u] = xr[2 * (j0 + u)];
#pragma unroll
                for (int u = 0; u < 8; ++u) { const f32x4 bv = br[2 * (j0 + u) * 32]; const f32x4 x4 = xv[u];
                    ss += (x4.x * x4.x + x4.y * x4.y) + (x4.z * x4.z + x4.w * x4.w);
                    acc = __builtin_amdgcn_mfma_f32_32x32x2f32(x4.x, bv.x, acc, 0, 0, 0); acc = __builtin_amdgcn_mfma_f32_32x32x2f32(x4.y, bv.y, acc, 0, 0, 0);
                    acc = __builtin_amdgcn_mfma_f32_32x32x2f32(x4.z, bv.z, acc, 0, 0, 0); acc = __builtin_amdgcn_mfma_f32_32x32x2f32(x4.w, bv.w, acc, 0, 0, 0); } }
            ssq[(tile * 4 + kq) * 64 + lane] = ss;
            LAS float* xw = xch + ((tile * 2 + (kq >> 1)) * 16) * 64 + lane;
            if (kq & 1) {
#pragma unroll
                for (int r = 0; r < 16; ++r) xw[r * 64] = acc[r]; }
            __syncthreads();
            if (!(kq & 1)) {
#pragma unroll
                for (int r = 0; r < 16; ++r) acc[r] += xw[r * 64]; }
            if (tid < 64) { float q = 0.f;
#pragma unroll
                for (int u = 0; u < 4; ++u) q += ssq[((tid >> 5) * 4 + u) * 64 + (tid & 31)] + ssq[((tid >> 5) * 4 + u) * 64 + 32 + (tid & 31)];
                rs[tid] = 1.0f / sqrtf(q * (1.f / 1024.f) + EPS); }
            __syncthreads();
            LAS float* xw2 = xch + ((tile * 2) * 16) * 64 + lane;
            if (kq == 2) {
#pragma unroll
                for (int r = 0; r < 16; ++r) xw2[r * 64] = acc[r]; }
            __syncthreads();
            if (kq == 0) {
#pragma unroll
                for (int r = 0; r < 16; ++r) acc[r] += xw2[r * 64]; }
            __syncthreads();
            if (kq == 0) { const float bias = rb[m32];
#pragma unroll
                for (int r = 0; r < 16; ++r) { const int tk = (r & 3) + 8 * (r >> 2) + 4 * kh; xch[(tile * 32 + tk) * 33 + m32] = acc[r] * rs[tile * 32 + tk] + bias; } }
            __syncthreads();
        }
        if (tid < 64) {
            const LAS float* lg = xch + tid * 33; float bv[4] = {-INFINITY, -INFINITY, -INFINITY, -INFINITY}; int be[4] = {0, 0, 0, 0};
#pragma unroll
            for (int n = 0; n < 32; ++n) { float v = lg[n]; int e = n;
#pragma unroll
                for (int s2 = 0; s2 < 4; ++s2) { if (v > bv[s2]) { const float tv = bv[s2]; const int te = be[s2]; bv[s2] = v; be[s2] = e; v = tv; e = te; } } }
            const float p1 = __expf(bv[1] - bv[0]), p2 = __expf(bv[2] - bv[0]), p3 = __expf(bv[3] - bv[0]); const float inv = 1.0f / (1.0f + p1 + p2 + p3);
            const float pw[4] = {inv, p1 * inv, p2 * inv, p3 * inv};
            if (!dry) {
#pragma unroll
            for (int s2 = 0; s2 < 4; ++s2) { const unsigned rk = __hip_atomic_fetch_add(lc + be[s2], 1u, __ATOMIC_RELAXED, __HIP_MEMORY_SCOPE_WORKGROUP);
                rec_e[tid * 4 + s2] = (unsigned)be[s2]; rec_r[tid * 4 + s2] = rk; rec_w[tid * 4 + s2] = pw[s2]; } }
        }
        { const GAS f32x4* gr = (const GAS f32x4*)g2 + lane; f32x4 gv[4];
#pragma unroll
          for (int j = 0; j < 4; ++j) gv[j] = gr[64 * j];
          for (int h = 0; h < 2; ++h) { f32x4 v[4][4];
#pragma unroll
            for (int u = 0; u < 4; ++u) { const size_t t = (size_t)tb * 64 + wave * 8 + h * 4 + u; const GAS f32x4* xr = (const GAS f32x4*)(x1 + t * 1024) + lane;
#pragma unroll
                for (int j = 0; j < 4; ++j) v[u][j] = xr[64 * j]; }
#pragma unroll
            for (int u = 0; u < 4; ++u) { const int tl = wave * 8 + h * 4 + u; const size_t t = (size_t)tb * 64 + tl; const float r = rs[tl]; GAS unsigned long long* o8 = (GAS unsigned long long*)(H2 + t * 1024) + lane;
#pragma unroll
                for (int j = 0; j < 4; ++j) { const f32x4 y = v[u][j] * r * gv[j]; o8[64 * j] = (unsigned long long)pk2(y.x, y.y) | ((unsigned long long)pk2(y.z, y.w) << 32); } } } }
        __syncthreads();
        if (tid < 32) basep[tid] = __hip_atomic_fetch_add(F.ctl + CW_CNT + tid, lc[tid], RLX_AGENT);
        __syncthreads();
        if (tid < 256 && !dry) { const size_t p = (size_t)tb * 256 + tid; const unsigned me = rec_e[tid]; TOKE[p] = (int)me; TOKP[p] = (int)(basep[me] + rec_r[tid]); TOKW[p] = rec_w[tid]; }
        __syncthreads();
        if (tid < 32) lc[tid] = 0u;
        __syncthreads();
    }
}
__device__ __forceinline__ void moe_tables(Frame& F, LAS unsigned*& tpre, LAS unsigned*& cntl) {
    cntl = (LAS unsigned*)(F.lds + XTRA_OFF + 8192); tpre = cntl + 32;
    if (F.tid < 32) cntl[F.tid] = __hip_atomic_load(F.ctl + CW_CNT + F.tid, RLX_AGENT);
    __syncthreads();
    if (F.tid == 0) { unsigned a = 0u; for (int e = 0; e < 32; ++e) { tpre[e] = a; a += (cntl[e] + 255u) >> 8; } tpre[32] = a; }
    __syncthreads();
}
__device__ __forceinline__ LAS unsigned* moe_build_units(Frame& F, const LAS unsigned* tpre, int NT) {
    LAS unsigned* list = (LAS unsigned*)(F.lds + XTRA_OFF + 8192 + 512);
    if (F.tid < 24) { unsigned w = 0xffffffffu; const int U = (int)tpre[32] * NT; const long Lg = (long)F.tid * F.G + blockIdx.x;
        if (F.tid < 20 && Lg < U) { int wg = (int)Lg; { const int q = U / 8, r = U % 8, xcd = wg % 8, off = wg / 8; wg = (xcd < r ? xcd * (q + 1) : r * (q + 1) + (xcd - r) * q) + off; }
            int e = 0; while (e < 31 && wg >= (int)tpre[e + 1] * NT) ++e;
            const int rr = wg - (int)tpre[e] * NT, mt = (int)(tpre[e + 1] - tpre[e]); const int n = rr / mt, m = rr % mt;
            w = (unsigned)(tpre[e] + m) | ((unsigned)(e * NT + n) << 16); }
        list[F.tid] = w; }
    __syncthreads();
    return list;
}
__device__ __forceinline__ void gather_phase(Frame& F) {
    LAS unsigned* tpre; LAS unsigned* cntl; moe_tables(F, tpre, cntl);
    const int gw = F.vcu * NWAVES + F.wave, NGW = F.G * NWAVES, lane = F.lane;
    const bf16* H2 = (const bf16*)(F.ws + WS_H2); bf16* XP = (bf16*)(F.ws + WS_XP); float* ROWW = (float*)(F.ws + WS_ROWW);
    const int* TOKE = (const int*)(F.ws + WS_TOKE); const int* TOKP = TOKE + M * 4; const float* TOKW = (const float*)(TOKP + M * 4); int* TOKR = (int*)(TOKW + M * 4);
    for (int p0 = gw * 32; p0 < M * 4; p0 += NGW * 32) {
        const int p = p0 + (lane & 31); const int e = TOKE[p]; const int myrow = (int)tpre[e] * 256 + TOKP[p];
        if (lane < 32) { TOKR[p] = myrow; ROWW[myrow] = TOKW[p]; }
        for (int i = 0; i < 32; i += 4) { v4u a[4], bq[4]; int rw[4];
#pragma unroll
            for (int u = 0; u < 4; ++u) { rw[u] = __builtin_amdgcn_readlane(myrow, i + u); const GAS v4u* src = (const GAS v4u*)(H2 + (size_t)((p0 + i + u) >> 2) * 1024); a[u] = src[lane]; bq[u] = src[lane + 64]; }
#pragma unroll
            for (int u = 0; u < 4; ++u) { GAS v4u* dst = (GAS v4u*)(XP + (size_t)rw[u] * 1024); dst[lane] = a[u]; dst[lane + 64] = bq[u]; } }
    }
    for (int i = gw; i < 32 * 256; i += NGW) { const int e = i >> 8; const int row = (int)tpre[e] * 256 + (int)cntl[e] + (i & 255);
        if (row < (int)tpre[e + 1] * 256) { GAS v4u* dst = (GAS v4u*)(XP + (size_t)row * 1024); dst[lane] = (v4u){0u, 0u, 0u, 0u}; dst[lane + 64] = (v4u){0u, 0u, 0u, 0u}; if (lane == 0) ROWW[row] = 0.f; } }
}
__device__ __forceinline__ void combine_phase(Frame& F, bool dry = false) {
    const int gw = F.vcu * NWAVES + F.wave, NGW = F.G * NWAVES, lane = F.lane;
    const bf16* Y = (const bf16*)(F.ws + WS_XP); const int* TOKR = (const int*)(F.ws + WS_TOKE) + 3 * M * 4;
    const bool poison = ((REP_PHASE) == 50 || (REP_PHASE) == 51) && __hip_atomic_load(F.ctl + CW_CODE, RLX_AGENT) != 0u;
    for (int t = gw; t < M; t += NGW) {
        GAS f32x4* o = (GAS f32x4*)(F.out + (size_t)t * 1024) + lane; f32x4 v[4]; v2u y[4][4]; int row[4];
#pragma unroll
        for (int s = 0; s < 4; ++s) row[s] = TOKR[t * 4 + s];
#pragma unroll
        for (int j = 0; j < 4; ++j) v[j] = o[64 * j];
        const f32x4 v0[4] = {v[0], v[1], v[2], v[3]};
#pragma unroll
        for (int s = 0; s < 4; ++s) { const GAS v2u* yp = (const GAS v2u*)(Y + (size_t)row[s] * 1024) + lane;
#pragma unroll
            for (int j = 0; j < 4; ++j) y[s][j] = yp[64 * j]; }
#pragma unroll
        for (int s = 0; s < 4; ++s)
#pragma unroll
            for (int j = 0; j < 4; ++j) { v[j].x += bflo(y[s][j].x); v[j].y += bfhi(y[s][j].x); v[j].z += bflo(y[s][j].y); v[j].w += bfhi(y[s][j].y); }
#pragma unroll
        for (int j = 0; j < 4; ++j) o[64 * j] = poison ? (f32x4){__builtin_nanf(""), __builtin_nanf(""), __builtin_nanf(""), __builtin_nanf("")} : ((dry && v[j].x == v[j].x) ? v0[j] : v[j]);
    }
}
struct Args { const float* in[18]; float* out; unsigned char* ws; int ph_lo, ph_hi; };
static_assert(sizeof(Args) == 18 * 8 + 8 + 8 + 8, "Args has no padding bytes");
__global__ void __launch_bounds__(NWAVES * 64, 2) mk_fwd(Args args) {
    extern __shared__ __attribute__((aligned(16))) unsigned char lds[];
    Frame F;
    F.lds = (LAS unsigned char*)lds;
    F.MISC = (volatile LAS unsigned*)(F.lds + MISC_OFF);
    F.tid = threadIdx.x; F.lane = F.tid & 63; F.wave = __builtin_amdgcn_readfirstlane(F.tid >> 6);
    F.G = gridDim.x; { const int bx = blockIdx.x; F.vcu = (F.G % 8 == 0) ? (bx % 8) * (F.G / 8) + bx / 8 : bx; }
    F.ws = args.ws; F.ctl = (gu32*)(args.ws + WS_CTL); F.out = args.out;
#pragma unroll
    for (int i = 0; i < 18; ++i) F.in[i] = args.in[i];
    for (int u = F.tid; u < (LDS_BYTES - LDSCTL_OFF) / 4; u += NWAVES * 64) ((LAS unsigned*)(F.lds + LDSCTL_OFF))[u] = 0u;
    __syncthreads();
    XcdBarrier bar; bar.bar = (unsigned*)(F.ctl + CW_BAR); bar.x = 0; bar.st = nullptr;
    if (!MK_SPLIT) bar = xcd_barrier_post((unsigned*)(F.ctl + CW_BAR), F.MISC + 8);
#define GRID_BAR() do { if (MK_SPLIT) { if (F.tid == 0) __hip_atomic_store(F.ctl + CW_TMO, 0xBADBA0u, RLX_AGENT); } else { xcd_barrier(bar); if ((REP_PHASE) == 40) xcd_barrier(bar); } } while (0)
    const int lo = args.ph_lo, hi = args.ph_hi;
#define IN(k) (lo <= (k) && (k) < hi)
#define BOTH(k) (IN(k) && IN((k) + 1))
    constexpr bool AL = true, SP = true;
#ifndef REP_PHASE
#define REP_PHASE -1
#endif
#define REPS(k) for (int rep_ = 0; rep_ < ((REP_PHASE) == (k) ? 2 : 1); ++rep_)
    if (IN(0)) { REPS(0) p0_prologue(F); if (BOTH(0)) GRID_BAR(); }
    if (IN(1)) {
        pg8::Gemm g{(const bf16*)(F.ws + WS_H), (const bf16*)(F.ws + WS_WIN), M, NINP, DMODEL}; pg8::StaticOrder S; S.init(M, NINP, F.G, (int)blockIdx.x);
        pg8::EpiInProj E{F.ws};
        REPS(1) pg8::gemm_phase<pg8::EpiInProj, pg8::StaticOrder, AL, SP>(F.lds + RING_OFF, g, S, E);
        if (BOTH(1)) GRID_BAR();
    }
    if (IN(2)) {
        if ((REP_PHASE) == 32) qknorm_rows(F, true);
        qknorm_rows(F); REPS(30) pool_diff_rows(F);
        REPS(2) for (int v = F.vcu; v < 256; v += F.G) { const int b = v >> 7, half = (v >> 6) & 1, cc = v & 63; for (int k = 0; k < ((REP_PHASE) == 24 ? 3 : 2); ++k) topk_unit(F, b, k ? cc : 127 - cc, half); }
        if (BOTH(2)) GRID_BAR();
    }
    if (IN(3)) {
        { pg8::Gemm g{(const bf16*)(F.ws + WS_DIFF), (const bf16*)(F.ws + WS_WPOOL), M, DPOOL, DPOOL}; pg8::StaticOrder S; S.init(M, DPOOL, F.G, (int)blockIdx.x);
          pg8::EpiPool E{(bf16*)(F.ws + WS_YAP + 16 * MiB), F.in[6], F.in[7]};
          REPS(31) pg8::gemm_phase<pg8::EpiPool, pg8::StaticOrder, AL, SP>(F.lds + RING_OFF, g, S, E); }
        const float cshift = attn_body::C2 * 64.0f * wave_max(fabsf(F.in[3][F.lane])) * wave_max(fabsf(F.in[4][F.lane]));
        REPS(3) for (int v = F.vcu; v < 256; v += F.G) { const int bh = v >> 4, s = v & 15;
            for (int i = 0; i < 2; ++i) attn_body::attn_unit(bh >> 3, bh & 7, i == 0 ? 31 - s : s, (const attn_body::bf16*)(F.ws + WS_Q), (const attn_body::bf16*)(F.ws + WS_K), (const attn_body::bf16*)(F.ws + WS_V),
                                                             (attn_body::bf16*)(F.ws + WS_YAP), (const unsigned long long*)(F.ws + WS_MASK), cshift, (char*)lds + RING_OFF); }
        if (BOTH(3)) GRID_BAR();
    }
    if (IN(4)) {
        pg8::StaticOrder S; S.init(M, DMODEL, F.G, (int)blockIdx.x);
        { pg8::Gemm g{(const bf16*)(F.ws + WS_YAP), (const bf16*)(F.ws + WS_WAB), M, DMODEL, 512};
          pg8::EpiGate E{(const bf16*)(F.ws + WS_GA), nullptr, (bf16*)(F.ws + WS_TMP)};
          pg8::gemm_phase<pg8::EpiGate, pg8::StaticOrder, AL, SP>(F.lds + RING_OFF, g, S, E); }
        { pg8::Gemm g{(const bf16*)(F.ws + WS_YAP + 16 * MiB), (const bf16*)(F.ws + WS_WAB + 1 * MiB), M, DMODEL, 512};
          pg8::EpiGate E{(const bf16*)(F.ws + WS_GB), (const bf16*)(F.ws + WS_TMP), (bf16*)(F.ws + WS_MERGED)};
          pg8::gemm_phase<pg8::EpiGate, pg8::StaticOrder, AL, SP>(F.lds + RING_OFF, g, S, E); }
        if (BOTH(4)) GRID_BAR();
    }
    if (IN(5)) {
        pg8::Gemm g{(const bf16*)(F.ws + WS_MERGED), (const bf16*)(F.ws + WS_WOUT), M, DMODEL, DMODEL}; pg8::StaticOrder S; S.init(M, DMODEL, F.G, (int)blockIdx.x);
        pg8::EpiResF32 E{F.in[0], F.out};
        REPS(5) pg8::gemm_phase<pg8::EpiResF32, pg8::StaticOrder, AL, SP>(F.lds + RING_OFF, g, S, E);
        if (BOTH(5)) GRID_BAR();
    }
    if (IN(6)) { if ((REP_PHASE) == 6) router_phase(F, true); router_phase(F); if (BOTH(6)) GRID_BAR(); }
    if (IN(7)) { REPS(7) gather_phase(F); if (BOTH(7)) GRID_BAR(); }
    if (IN(8)) {
        LAS unsigned* tpre; LAS unsigned* cntl; moe_tables(F, tpre, cntl);
        pg8::ListOrder S{moe_build_units(F, tpre, 8)};
        pg8::Gemm g{(const bf16*)(F.ws + WS_XP), (const bf16*)(F.ws + WS_W1), MPAD, NEXP * 2048, DMODEL};
        pg8::EpiSwiglu E{F.in[15], (bf16*)(F.ws + WS_ACT)};
        REPS(8) pg8::gemm_phase<pg8::EpiSwiglu, pg8::ListOrder, AL, SP>(F.lds + RING_OFF, g, S, E);
        if (BOTH(8)) GRID_BAR();
    }
    if (IN(9)) {
        LAS unsigned* tpre; LAS unsigned* cntl; moe_tables(F, tpre, cntl);
        pg8::ListOrder S{moe_build_units(F, tpre, 4)};
        pg8::Gemm g{(const bf16*)(F.ws + WS_ACT), (const bf16*)(F.ws + WS_W2), MPAD, NEXP * 1024, DEXP};
        pg8::EpiDown E{F.in[17], (const float*)(F.ws + WS_ROWW), (bf16*)(F.ws + WS_XP)};
        REPS(9) pg8::gemm_phase<pg8::EpiDown, pg8::ListOrder, AL, SP>(F.lds + RING_OFF, g, S, E);
        if (BOTH(9)) GRID_BAR();
    }
    if (IN(2) && (REP_PHASE) == 51 && blockIdx.x == 3 && F.tid == 0) __hip_atomic_store(F.ctl + CW_CODE, 1u, RLX_AGENT);
    if (IN(10)) { if ((REP_PHASE) == 10) combine_phase(F, true); combine_phase(F); }
#undef IN
#undef BOTH
}

extern "C" void kernel_launch(void* const* d_in, const int* in_sizes, int n_in, void* d_out, int out_size, void* d_ws, size_t ws_size, hipStream_t stream) {
    static int grid = 0;
    if (grid == 0) {
        if (n_in != 18 || in_sizes[0] != M * DMODEL || out_size != M * DMODEL || ws_size < WS_END) { fprintf(stderr, "kernel_launch: built for 18 inputs, x/out of %d floats, >= %zu bytes of workspace; got n_in %d, in0 %d, out %d, ws %zu; nothing launched\n", M * DMODEL, (size_t)WS_END, n_in, n_in > 0 ? in_sizes[0] : -1, out_size, ws_size); grid = -1; return; }
        int dev = 0, cus = 0, per_cu = 0;
        if (hipGetDevice(&dev) != hipSuccess || hipDeviceGetAttribute(&cus, hipDeviceAttributeMultiprocessorCount, dev) != hipSuccess) { fprintf(stderr, "kernel_launch: hipGetDevice / hipDeviceGetAttribute failed; nothing launched\n"); grid = -1; return; }
        if (hipFuncSetAttribute((const void*)mk_fwd, hipFuncAttributeMaxDynamicSharedMemorySize, LDS_BYTES) != hipSuccess) { fprintf(stderr, "kernel_launch: hipFuncSetAttribute failed; nothing launched\n"); grid = -1; return; }
        if (hipOccupancyMaxActiveBlocksPerMultiprocessor(&per_cu, (const void*)mk_fwd, NWAVES * 64, LDS_BYTES) != hipSuccess || per_cu < 1) { fprintf(stderr, "kernel_launch: occupancy query reports %d workgroups per CU; nothing launched\n", per_cu); (void)hipGetLastError(); grid = -1; return; }
        (void)hipGetLastError();
        grid = cus;
    }
    if (grid < 0) return;
    if (hipMemsetAsync((char*)d_ws + WS_CTL, 0, CTL_ZERO_BYTES, stream) != hipSuccess) { fprintf(stderr, "kernel_launch: hipMemsetAsync of the control words failed; nothing launched\n"); return; }
    Args a{};
    for (int i = 0; i < 18; ++i) a.in[i] = (const float*)d_in[i];
    a.out = (float*)d_out; a.ws = (unsigned char*)d_ws;
    const int nl = MK_SPLIT ? N_PHASES : 1;
    for (int li = 0; li < nl; ++li) {
        a.ph_lo = MK_SPLIT ? li : 0; a.ph_hi = MK_SPLIT ? li + 1 : N_PHASES;
        hipLaunchKernelGGL(mk_fwd, dim3(grid), dim3(NWAVES * 64), LDS_BYTES, stream, a);
        const hipError_t le = hipPeekAtLastError();
        if (le != hipSuccess) { fprintf(stderr, "kernel_launch: launch %d failed: %s (grid %d x %d threads, %d B LDS)\n", li, hipGetErrorName(le), grid, NWAVES * 64, LDS_BYTES); break; }
    }
}
```

```cpp
#define MK_SPLIT 0
#include <hip/hip_runtime.h>
#include <hip/hip_bf16.h>
#include <cstdio>
#include <cstdint>
#include <cmath>
constexpr int NWAVES = 8;
#ifndef MK_SPLIT
#define MK_SPLIT 0
#endif
constexpr int N_PHASES = 11;
#ifndef REP_PHASE
#define REP_PHASE -1
#endif

constexpr int BATCH = 2, SEQ = 8192, DMODEL = 1024, M = BATCH * SEQ;
constexpr int DATT = 512, HD = 64, NH = 8, NIH = 4, IDIM = 64, TOPK = 256, DPOOL = 512, NEXP = 32, TOPE = 4, DEXP = 1024;
constexpr int NIN = 4420;
constexpr int NINP = 4608;
constexpr float EPS = 1e-6f;
constexpr int MP_TILES = 288, MPAD = MP_TILES * 256;

constexpr size_t MiB = 1u << 20;
constexpr size_t WS_CTL = 0, CTL_ZERO_BYTES = 1 * MiB;
constexpr size_t WS_WIN = 2 * MiB;
constexpr size_t WS_WAB = 12 * MiB;
constexpr size_t WS_WOUT = 16 * MiB;
constexpr size_t WS_WPOOL = 18 * MiB;
constexpr size_t WS_W1 = 20 * MiB;
constexpr size_t WS_W2 = 148 * MiB;
constexpr size_t WS_H = 212 * MiB;
constexpr size_t WS_Q = 244 * MiB, WS_K = 260 * MiB, WS_V = 276 * MiB;
constexpr size_t WS_IQ = 292 * MiB;
constexpr size_t WS_IK = 300 * MiB;
constexpr size_t WS_IW = 302 * MiB;
constexpr size_t WS_U = 303 * MiB;
constexpr size_t WS_DIFF = 319 * MiB;
constexpr size_t WS_GA = 335 * MiB, WS_GB = 367 * MiB;
constexpr size_t WS_MASK = 399 * MiB;
constexpr size_t WS_YAP = 415 * MiB;
constexpr size_t WS_MERGED = 447 * MiB;
constexpr size_t WS_H2 = 479 * MiB;
constexpr size_t WS_TOKE = 511 * MiB;
constexpr size_t WS_ROWW = 512 * MiB;
constexpr size_t WS_XP = 514 * MiB;
constexpr size_t WS_ACT = 658 * MiB;
constexpr size_t WS_TMP = 802 * MiB;
constexpr size_t WS_END = 834 * MiB;

constexpr int CW_TMO = 0, CW_CODE = 1;
constexpr int CW_CNT = 64;
constexpr int CW_BAR = 4096;
constexpr int CW_MOE = 8192;

constexpr int RING_OFF = 0, RING_BYTES = 147456;
constexpr int LDSCTL_OFF = RING_BYTES, MISC_OFF = LDSCTL_OFF + 320;
constexpr int XTRA_OFF = LDSCTL_OFF + 1024;
constexpr int LDS_BYTES = 163840;
static_assert(XTRA_OFF + 14336 <= LDS_BYTES, "LDS map");

#define GAS __attribute__((address_space(1)))
#define LAS __attribute__((address_space(3)))
typedef unsigned short bf16;
typedef unsigned v4u __attribute__((ext_vector_type(4)));
typedef unsigned v2u __attribute__((ext_vector_type(2)));
typedef float f32x4 __attribute__((ext_vector_type(4)));
typedef short bf16x8 __attribute__((ext_vector_type(8)));
typedef float f32x16 __attribute__((ext_vector_type(16)));
typedef GAS unsigned gu32;
#define RLX_AGENT __ATOMIC_RELAXED, __HIP_MEMORY_SCOPE_AGENT
#define LDS_WAIT() asm volatile("s_waitcnt lgkmcnt(0)" ::: "memory")
#define VM_WAIT() asm volatile("s_waitcnt vmcnt(0)" ::: "memory")
__device__ __forceinline__ unsigned f2bf(float f) { unsigned u = __builtin_bit_cast(unsigned, f); return (u + 0x7fffu + ((u >> 16) & 1u)) >> 16; }
__device__ __forceinline__ unsigned pk2(float lo, float hi) { return f2bf(lo) | (f2bf(hi) << 16); }
__device__ __forceinline__ float bflo(unsigned w) { return __uint_as_float(w << 16); }
__device__ __forceinline__ float bfhi(unsigned w) { return __uint_as_float(w & 0xffff0000u); }
namespace pg8 {
#define PG8_LAS __attribute__((address_space(3)))
typedef unsigned short bf16_t;
typedef short bf16x8 __attribute__((ext_vector_type(8)));
typedef float f32x4 __attribute__((ext_vector_type(4)));
typedef unsigned u32x4 __attribute__((ext_vector_type(4)));
constexpr int BM = 256, BK = 64, HALF = 128, HTB = HALF * BK * 2  , STAGE_BYTES = 8 * HTB, NXCD = 8, WGM = 8;

__host__ __device__ __forceinline__ int lds_byte(int r, int c) { const int st = (r >> 4) * 2 + (c >> 5), rr = r & 15, cc = c & 31, ob = rr * 64 + cc * 2; return st * 1024 + (ob ^ (((ob >> 9) & 1) << 5)); }
__host__ __device__ __forceinline__ void stage_rc(int b, int& R, int& C) { const int st = b / 1024, sb = b % 1024, swz = sb ^ (((sb >> 9) & 1) << 5); R = (st >> 1) * 16 + swz / 64; C = (st & 1) * 32 + (swz % 64) / 2; }
__host__ __device__ __forceinline__ int perm32(int rho) { const int n = rho >> 4, i = rho & 15; return 8 * (i >> 2) + 4 * n + (i & 3); }

struct Unit { int pm, pn; };
struct Gemm { const bf16_t* A; const bf16_t* Bt; int M, N, K; };

struct StaticOrder {
    int nM, nN, nwg, G, c;
    __host__ __device__ void init(int M, int N, int G_, int c_) { nM = M / BM; nN = N / BM; nwg = nM * nN; G = G_; c = c_; }
    __host__ __device__ bool next(int i, Unit& u) const {
        const long L = (long)i * G + c; if (L >= nwg) return false;
        int wgid = (int)L; { const int q = nwg / NXCD, r = nwg % NXCD, xcd = wgid % NXCD, off = wgid / NXCD; wgid = (xcd < r ? xcd * (q + 1) : r * (q + 1) + (xcd - r) * q) + off; }
        const int nig = WGM * nN, gid = wgid / nig, fm = gid * WGM, gsz = (nM - fm) < WGM ? (nM - fm) : WGM;
        u.pm = fm + ((wgid % nig) % gsz); u.pn = (wgid % nig) / gsz; return true;
    }
    __device__ __forceinline__ void a_ready(const Unit&) const {}
    __device__ __forceinline__ void done(const Unit&) const {}
    __device__ __forceinline__ const char* abase(const Gemm& g, const Unit& u, size_t tstep) const { return (const char*)g.A + (size_t)u.pm * tstep; }
    __device__ __forceinline__ const char* bbase(const Gemm& g, const Unit& u, size_t tstep) const { return (const char*)g.Bt + (size_t)u.pn * tstep; }
};
__device__ __forceinline__ unsigned cvt_pk_bf16(float lo, float hi) { unsigned r; asm volatile("v_cvt_pk_bf16_f32 %0, %1, %2" : "=v"(r) : "v"(lo), "v"(hi)); return r; }
typedef float f32x2 __attribute__((ext_vector_type(2)));
typedef unsigned u32x2 __attribute__((ext_vector_type(2)));
__device__ __forceinline__ float sigmoidf_fast(float x) { return __builtin_amdgcn_rcpf(1.0f + __builtin_amdgcn_exp2f(-1.4426950408889634f * x)); }
__device__ __forceinline__ float bf_lo(unsigned w) { return __uint_as_float(w << 16); }
__device__ __forceinline__ float bf_hi(unsigned w) { return __uint_as_float(w & 0xffff0000u); }

struct EpiInProj {
    static constexpr bool PERM = true, AFTER_DRAIN = false;
    unsigned char* ws;
    static constexpr unsigned oq = (unsigned)WS_Q, ok = (unsigned)WS_K, ov = (unsigned)WS_V, oiq = (unsigned)WS_IQ, oik = (unsigned)WS_IK, ou = (unsigned)WS_U, oga = (unsigned)WS_GA, ogb = (unsigned)WS_GB, oiw = (unsigned)WS_IW;
    __device__ __forceinline__ void operator()(const f32x4 (&acc)[2][2][4][2], const Unit& un, int wr, int wc, int fr, int fq) const {
        const int pn = un.pn, row0 = un.pm * BM + wr * 64 + fr;
        if (pn == 7) {
#pragma unroll
            for (int ai = 0; ai < 2; ++ai)
#pragma unroll
                for (int m = 0; m < 4; ++m) { const size_t row = (size_t)(row0 + ai * HALF + m * 16);
                    const f32x4 v0 = acc[ai][0][m][0], v1 = acc[ai][0][m][1];
                    if (wc < 2) { u32x4 w; w.x = cvt_pk_bf16(v0[0], v0[1]); w.y = cvt_pk_bf16(v0[2], v0[3]); w.z = cvt_pk_bf16(v1[0], v1[1]); w.w = cvt_pk_bf16(v1[2], v1[3]);
                        *(u32x4*)((bf16_t*)(ws + oik) + (row >> 5) * 2048 + (2 * wc + (fq >> 1)) * 512 + ((fq & 1) * 32 + (row & 31)) * 8) = w; }
                    else if (wc == 2 && fq == 0) { *(f32x4*)((float*)(ws + oiw) + row * 4) = v0; } }
            return;
        }
        unsigned boff; int ldc, colt; bool sig = false;
        if (pn < 6) { boff = pn < 2 ? oq : (pn < 4 ? ok : ov); ldc = 512; colt = (pn & 1) * 256; }
        else if (pn == 6) { boff = oiq; ldc = 256; colt = 0; }
        else if (pn < 10) { boff = ou; ldc = 512; colt = (pn - 8) * 256; }
        else { sig = true; boff = pn < 14 ? oga : ogb; ldc = 1024; colt = ((pn - 10) & 3) * 256; }
        bf16_t* base = (bf16_t*)(ws + boff);
        const int col0 = colt + wc * 32 + 8 * fq;
#pragma unroll
        for (int ai = 0; ai < 2; ++ai)
#pragma unroll
            for (int m = 0; m < 4; ++m) { bf16_t* rowp = base + (size_t)(row0 + ai * HALF + m * 16) * ldc + col0;
#pragma unroll
                for (int bj = 0; bj < 2; ++bj) { f32x4 v0 = acc[ai][bj][m][0], v1 = acc[ai][bj][m][1];
                    if (sig) {
#pragma unroll
                        for (int j = 0; j < 4; ++j) { v0[j] = sigmoidf_fast(v0[j]); v1[j] = sigmoidf_fast(v1[j]); } }
                    u32x4 w; w.x = cvt_pk_bf16(v0[0], v0[1]); w.y = cvt_pk_bf16(v0[2], v0[3]); w.z = cvt_pk_bf16(v1[0], v1[1]); w.w = cvt_pk_bf16(v1[2], v1[3]);
                    *(u32x4*)(rowp + bj * HALF) = w; } }
    }
};
struct EpiPool {
    static constexpr bool PERM = true, AFTER_DRAIN = false;
    bf16_t* yap; const float* pb; const float* ps;
    __device__ __forceinline__ void operator()(const f32x4 (&acc)[2][2][4][2], const Unit& un, int wr, int wc, int fr, int fq) const {
        const int row0 = un.pm * BM + wr * 64 + fr, col0 = un.pn * BM + wc * 32 + 8 * fq;
        f32x4 bv[2][2], sv[2][2];
#pragma unroll
        for (int bj = 0; bj < 2; ++bj)
#pragma unroll
            for (int n = 0; n < 2; ++n) { bv[bj][n] = *(const f32x4*)(pb + col0 + bj * HALF + 4 * n); sv[bj][n] = *(const f32x4*)(ps + col0 + bj * HALF + 4 * n); }
#pragma unroll
        for (int ai = 0; ai < 2; ++ai)
#pragma unroll
            for (int m = 0; m < 4; ++m) { bf16_t* rowp = yap + (size_t)(row0 + ai * HALF + m * 16) * 512 + col0;
#pragma unroll
                for (int bj = 0; bj < 2; ++bj) { const f32x4 v0 = (acc[ai][bj][m][0] + bv[bj][0]) * sv[bj][0], v1 = (acc[ai][bj][m][1] + bv[bj][1]) * sv[bj][1];
                    u32x4 w; w.x = cvt_pk_bf16(v0[0], v0[1]); w.y = cvt_pk_bf16(v0[2], v0[3]); w.z = cvt_pk_bf16(v1[0], v1[1]); w.w = cvt_pk_bf16(v1[2], v1[3]);
                    *(u32x4*)(rowp + bj * HALF) = w; } }
    }
};
struct EpiGate {
    static constexpr bool PERM = true, AFTER_DRAIN = false;
    const bf16_t* g; const bf16_t* add; bf16_t* out;
    __device__ __forceinline__ void operator()(const f32x4 (&acc)[2][2][4][2], const Unit& un, int wr, int wc, int fr, int fq) const {
        const int row0 = un.pm * BM + wr * 64 + fr, col0 = un.pn * BM + wc * 32 + 8 * fq;
#pragma unroll
        for (int ai = 0; ai < 2; ++ai)
#pragma unroll
            for (int m = 0; m < 4; ++m)
#pragma unroll
                for (int bj = 0; bj < 2; ++bj) { const size_t off = (size_t)(row0 + ai * HALF + m * 16) * 1024 + col0 + bj * HALF;
                    const u32x4 a = *(const u32x4*)(g + off); u32x4 t = {0u, 0u, 0u, 0u}; if (add) t = *(const u32x4*)(add + off);
                    const f32x4 p0 = acc[ai][bj][m][0], p1 = acc[ai][bj][m][1];
                    u32x4 w;
                    w.x = cvt_pk_bf16(bf_lo(t.x) + bf_lo(a.x) * p0[0], bf_hi(t.x) + bf_hi(a.x) * p0[1]);
                    w.y = cvt_pk_bf16(bf_lo(t.y) + bf_lo(a.y) * p0[2], bf_hi(t.y) + bf_hi(a.y) * p0[3]);
                    w.z = cvt_pk_bf16(bf_lo(t.z) + bf_lo(a.z) * p1[0], bf_hi(t.z) + bf_hi(a.z) * p1[1]);
                    w.w = cvt_pk_bf16(bf_lo(t.w) + bf_lo(a.w) * p1[2], bf_hi(t.w) + bf_hi(a.w) * p1[3]);
                    *(u32x4*)(out + off) = w; }
    }
};
struct EpiResF32 {
    static constexpr bool PERM = false, AFTER_DRAIN = false;
    const float* base; float* C;
    __device__ __forceinline__ void operator()(const f32x4 (&acc)[2][2][4][2], const Unit& un, int wr, int wc, int fr, int fq) const {
        const int row0 = un.pm * BM + wr * 64 + fr, col0 = un.pn * BM + wc * 32 + 4 * fq;
#pragma unroll
        for (int ai = 0; ai < 2; ++ai)
#pragma unroll
            for (int m = 0; m < 4; ++m) { const size_t off = (size_t)(row0 + ai * HALF + m * 16) * 1024 + col0;
#pragma unroll
                for (int bj = 0; bj < 2; ++bj)
#pragma unroll
                    for (int n = 0; n < 2; ++n) *(f32x4*)(C + off + bj * HALF + n * 16) = *(const f32x4*)(base + off + bj * HALF + n * 16) + acc[ai][bj][m][n]; }
    }
};
struct EpiSwiglu {
    static constexpr bool PERM = true, AFTER_DRAIN = false;
    const float* b1; bf16_t* act;
    __device__ __forceinline__ void operator()(const f32x4 (&acc)[2][2][4][2], const Unit& un, int wr, int wc, int fr, int fq) const {
        const int e = un.pn >> 3, n8 = un.pn & 7, row0 = un.pm * BM + wr * 64 + fr, col0 = n8 * HALF + wc * 32 + 8 * fq;
        const float* bp = b1 + (size_t)e * 2048 + col0;
        const f32x4 bg0 = *(const f32x4*)(bp), bg1 = *(const f32x4*)(bp + 4), bl0 = *(const f32x4*)(bp + 1024), bl1 = *(const f32x4*)(bp + 1028);
#pragma unroll
        for (int ai = 0; ai < 2; ++ai)
#pragma unroll
            for (int m = 0; m < 4; ++m) {
                f32x4 g0 = acc[ai][0][m][0] + bg0, g1 = acc[ai][0][m][1] + bg1, l0 = acc[ai][1][m][0] + bl0, l1 = acc[ai][1][m][1] + bl1, o0, o1;
#pragma unroll
                for (int j = 0; j < 4; ++j) {
                    const float ga = fminf(g0[j], 7.0f), gb = fminf(g1[j], 7.0f);
                    const float la = fminf(fmaxf(l0[j], -7.0f), 7.0f), lb = fminf(fmaxf(l1[j], -7.0f), 7.0f);
                    o0[j] = (la + 1.0f) * ga * sigmoidf_fast(1.702f * ga); o1[j] = (lb + 1.0f) * gb * sigmoidf_fast(1.702f * gb); }
                u32x4 w; w.x = cvt_pk_bf16(o0[0], o0[1]); w.y = cvt_pk_bf16(o0[2], o0[3]); w.z = cvt_pk_bf16(o1[0], o1[1]); w.w = cvt_pk_bf16(o1[2], o1[3]);
                *(u32x4*)(act + (size_t)(row0 + ai * HALF + m * 16) * 1024 + col0) = w; }
    }
};
struct EpiDown {
    static constexpr bool PERM = true, AFTER_DRAIN = false;
    const float* b2; const float* roww; bf16_t* Y;
    __device__ __forceinline__ void operator()(const f32x4 (&acc)[2][2][4][2], const Unit& un, int wr, int wc, int fr, int fq) const {
        const int e = un.pn >> 2, n4 = un.pn & 3, row0 = un.pm * BM + wr * 64 + fr, col0 = n4 * BM + wc * 32 + 8 * fq;
        const float* bp = b2 + (size_t)e * 1024 + col0;
        f32x4 bv[2][2];
#pragma unroll
        for (int bj = 0; bj < 2; ++bj)
#pragma unroll
            for (int n = 0; n < 2; ++n) bv[bj][n] = *(const f32x4*)(bp + bj * HALF + 4 * n);
#pragma unroll
        for (int ai = 0; ai < 2; ++ai)
#pragma unroll
            for (int m = 0; m < 4; ++m) { const int row = row0 + ai * HALF + m * 16; const float rw = roww[row];
#pragma unroll
                for (int bj = 0; bj < 2; ++bj) { const f32x4 v0 = (acc[ai][bj][m][0] + bv[bj][0]) * rw, v1 = (acc[ai][bj][m][1] + bv[bj][1]) * rw;
                    u32x4 w; w.x = cvt_pk_bf16(v0[0], v0[1]); w.y = cvt_pk_bf16(v0[2], v0[3]); w.z = cvt_pk_bf16(v1[0], v1[1]); w.w = cvt_pk_bf16(v1[2], v1[3]);
                    *(u32x4*)(Y + (size_t)row * 1024 + col0 + bj * HALF) = w; } }
    }
};
struct ListOrder {
    const PG8_LAS unsigned* list;
    __device__ __forceinline__ bool next(int i, Unit& u) const { const unsigned w = (unsigned)__builtin_amdgcn_readfirstlane((int)list[i]); if (w == 0xffffffffu) return false; u.pm = (int)(w & 0xffffu); u.pn = (int)(w >> 16); return true; }
    __device__ __forceinline__ void a_ready(const Unit&) const {}
    __device__ __forceinline__ void done(const Unit&) const {}
    __device__ __forceinline__ const char* abase(const Gemm& g, const Unit& u, size_t tstep) const { return (const char*)g.A + (size_t)u.pm * tstep; }
    __device__ __forceinline__ const char* bbase(const Gemm& g, const Unit& u, size_t tstep) const { return (const char*)g.Bt + (size_t)u.pn * tstep; }
};
template <class Epi, class Sched, bool ALIGN_EPI = false, bool SP2 = false>
__device__ __forceinline__ void gemm_phase(PG8_LAS unsigned char* lds, const Gemm g, const Sched& S, const Epi& E) {
    const int tid = threadIdx.x, wid = __builtin_amdgcn_readfirstlane(tid >> 6), lane = tid & 63, wr = wid >> 2, wc = wid & 3, fr = lane & 15, fq = lane >> 4;
    const int K = g.K, nt = K / BK;
    unsigned voffA[2], voffB[2];
#pragma unroll
    for (int i = 0; i < 2; ++i) { int R, C; stage_rc(tid * 16 + i * 8192, R, C); const int Rb = Epi::PERM ? ((R & ~31) + perm32(R & 31)) : R;
        voffA[i] = (unsigned)(R * K + C) * 2u; voffB[i] = (unsigned)(Rb * K + C) * 2u; }
    const size_t kstep = (size_t)(BK * 2);
    const size_t hstep = (size_t)HALF * K * 2;
    const size_t tstep = 2 * hstep;
    const unsigned ldsw = (unsigned)wid * 1024u;
    const int aoff = lds_byte(wr * 64 + fr, fq * 8), boff = lds_byte(wc * 32 + fr, fq * 8);
#define PG8_SA(b, h) (((b) * 2 + (h)) * HTB)
#define PG8_SB(b, h) ((4 + (b) * 2 + (h)) * HTB)
#define PG8_STAGE(bufoff, gbase, voff) do { _Pragma("unroll") for (int _i = 0; _i < 2; ++_i) \
        __builtin_amdgcn_global_load_lds((const unsigned*)((const char*)(gbase) + (voff)[_i]), (PG8_LAS unsigned*)(lds + (bufoff) + ldsw + _i * 8192), 16, 0, 0); } while (0)
#define PG8_LDA(dst, b, h) do { _Pragma("unroll") for (int m = 0; m < 4; ++m) _Pragma("unroll") for (int k = 0; k < 2; ++k) dst[m][k] = *(const PG8_LAS bf16x8*)(lds + PG8_SA(b, h) + aoff + m * 2048 + k * 1024); } while (0)
#define PG8_LDB(dst, b, h) do { _Pragma("unroll") for (int n = 0; n < 2; ++n) _Pragma("unroll") for (int k = 0; k < 2; ++k) dst[n][k] = *(const PG8_LAS bf16x8*)(lds + PG8_SB(b, h) + boff + n * 2048 + k * 1024); } while (0)
#define PG8_MMA(ai, bj, At, Bt) do { __builtin_amdgcn_s_setprio(1); _Pragma("unroll") for (int m = 0; m < 4; ++m) _Pragma("unroll") for (int n = 0; n < 2; ++n) _Pragma("unroll") for (int k = 0; k < 2; ++k) \
        acc[ai][bj][m][n] = __builtin_amdgcn_mfma_f32_16x16x32_bf16(Bt[n][k], At[m][k], acc[ai][bj][m][n], 0, 0, 0); __builtin_amdgcn_s_setprio(0); } while (0)
#define PG8_WAIT_V(n) asm volatile("s_waitcnt vmcnt(" #n ")" ::: "memory")
#define PG8_WAIT_L(n) asm volatile("s_waitcnt lgkmcnt(" #n ")" ::: "memory")
#define PG8_BAR __builtin_amdgcn_s_barrier()
#define PG8_SCHED __builtin_amdgcn_sched_barrier(0)
    Unit cur, nxt; int ui = 0;
    if (!S.next(0, cur)) return;
    f32x4 acc[2][2][4][2];
#pragma unroll
    for (int a = 0; a < 2; ++a)
#pragma unroll
        for (int b = 0; b < 2; ++b)
#pragma unroll
            for (int m = 0; m < 4; ++m)
#pragma unroll
                for (int n = 0; n < 2; ++n) acc[a][b][m][n] = (f32x4){0.f, 0.f, 0.f, 0.f};
    bf16x8 At[4][2], B0[2][2], B1[2][2];
    const char* cA = S.abase(g, cur, tstep); const char* cB = S.bbase(g, cur, tstep);
    S.a_ready(cur);
    if constexpr (SP2) {
        PG8_STAGE(PG8_SB(0, 0), cB, voffB); PG8_STAGE(PG8_SB(0, 1), cB + hstep, voffB); PG8_STAGE(PG8_SA(0, 0), cA, voffA); PG8_STAGE(PG8_SA(0, 1), cA + hstep, voffA);
        if (wr == 1) PG8_BAR;
        PG8_WAIT_V(2); PG8_BAR;
        PG8_STAGE(PG8_SB(1, 0), cB + kstep, voffB); PG8_STAGE(PG8_SA(1, 0), cA + kstep, voffA); PG8_STAGE(PG8_SB(1, 1), cB + hstep + kstep, voffB);
        PG8_WAIT_V(6); PG8_BAR;
    } else {
        PG8_STAGE(PG8_SB(0, 0), cB, voffB); PG8_STAGE(PG8_SA(0, 0), cA, voffA); PG8_STAGE(PG8_SB(0, 1), cB + hstep, voffB); PG8_STAGE(PG8_SA(0, 1), cA + hstep, voffA);
        if (wr == 1) PG8_BAR;
        PG8_WAIT_V(4); PG8_BAR;
        PG8_STAGE(PG8_SB(1, 0), cB + kstep, voffB); PG8_STAGE(PG8_SA(1, 0), cA + kstep, voffA); PG8_STAGE(PG8_SB(1, 1), cB + hstep + kstep, voffB);
        PG8_WAIT_V(6); PG8_BAR;
    }
    for (;;) {
        const bool has_next = S.next(ui + 1, nxt);
        const char* nA = has_next ? S.abase(g, nxt, tstep) : cA; const char* nB = has_next ? S.bbase(g, nxt, tstep) : cB;
        for (int t = 0; t < nt; t += 2) {
            const bool last = (t == nt - 2);
            const char* a1 = cA + (size_t)(t + 1) * kstep;
            const char* a2 = last ? nA : cA + (size_t)(t + 2) * kstep; const char* b2 = last ? nB : cB + (size_t)(t + 2) * kstep;
            const char* a3 = a2 + kstep; const char* b3 = b2 + kstep;
            if (last && has_next) S.a_ready(nxt);
            if constexpr (SP2) {
            PG8_LDB(B0, 0, 0); PG8_LDB(B1, 0, 1); PG8_SCHED; PG8_LDA(At, 0, 0); PG8_STAGE(PG8_SA(1, 1), a1 + hstep, voffA);
            PG8_WAIT_V(8); PG8_WAIT_L(0); PG8_BAR; PG8_MMA(0, 0, At, B0); PG8_MMA(0, 1, At, B1); PG8_BAR; PG8_SCHED;
            PG8_LDA(At, 0, 1); PG8_STAGE(PG8_SB(0, 0), b2, voffB); PG8_STAGE(PG8_SB(0, 1), b2 + hstep, voffB); PG8_STAGE(PG8_SA(0, 0), a2, voffA);
            PG8_WAIT_V(8); PG8_WAIT_L(0); PG8_BAR; PG8_MMA(1, 0, At, B0); PG8_MMA(1, 1, At, B1); PG8_BAR; PG8_SCHED;
            PG8_LDB(B0, 1, 0); PG8_LDB(B1, 1, 1); PG8_SCHED; PG8_LDA(At, 1, 0); PG8_STAGE(PG8_SA(0, 1), a2 + hstep, voffA);
            PG8_WAIT_V(8); PG8_WAIT_L(0); PG8_BAR; PG8_MMA(0, 0, At, B0); PG8_MMA(0, 1, At, B1); PG8_BAR; PG8_SCHED;
            PG8_LDA(At, 1, 1); PG8_STAGE(PG8_SB(1, 0), b3, voffB); PG8_STAGE(PG8_SB(1, 1), b3 + hstep, voffB); PG8_STAGE(PG8_SA(1, 0), a3, voffA);
            PG8_WAIT_V(8); PG8_WAIT_L(0); PG8_BAR; PG8_MMA(1, 0, At, B0); PG8_MMA(1, 1, At, B1); PG8_BAR; PG8_SCHED;
            } else {
            PG8_LDB(B0, 0, 0); PG8_SCHED; PG8_LDA(At, 0, 0); PG8_STAGE(PG8_SA(1, 1), a1 + hstep, voffA);
            PG8_WAIT_L(8); PG8_BAR; PG8_WAIT_L(0); PG8_MMA(0, 0, At, B0); PG8_BAR; PG8_SCHED;
            PG8_LDB(B1, 0, 1); PG8_STAGE(PG8_SB(0, 0), b2, voffB);
            PG8_BAR; PG8_WAIT_L(0); PG8_MMA(0, 1, At, B1); PG8_BAR;
            PG8_LDA(At, 0, 1); PG8_STAGE(PG8_SA(0, 0), a2, voffA);
            PG8_BAR; PG8_WAIT_L(0); PG8_MMA(1, 0, At, B0); PG8_BAR; PG8_SCHED;
            PG8_STAGE(PG8_SB(0, 1), b2 + hstep, voffB);
            PG8_WAIT_V(6); PG8_BAR; PG8_MMA(1, 1, At, B1); PG8_BAR;
            PG8_LDB(B0, 1, 0); PG8_SCHED; PG8_LDA(At, 1, 0); PG8_STAGE(PG8_SA(0, 1), a2 + hstep, voffA);
            PG8_WAIT_L(8); PG8_BAR; PG8_WAIT_L(0); PG8_MMA(0, 0, At, B0); PG8_BAR; PG8_SCHED;
            PG8_LDB(B1, 1, 1); PG8_STAGE(PG8_SB(1, 0), b3, voffB);
            PG8_BAR; PG8_WAIT_L(0); PG8_MMA(0, 1, At, B1); PG8_BAR;
            PG8_LDA(At, 1, 1); PG8_STAGE(PG8_SA(1, 0), a3, voffA);
            PG8_BAR; PG8_WAIT_L(0); PG8_MMA(1, 0, At, B0); PG8_BAR; PG8_SCHED;
            PG8_STAGE(PG8_SB(1, 1), b3 + hstep, voffB);
            PG8_WAIT_V(6); PG8_BAR; PG8_MMA(1, 1, At, B1); PG8_BAR;
            }
        }
        if constexpr (ALIGN_EPI) { if (wr == 0) PG8_BAR; }
        if constexpr (!Epi::AFTER_DRAIN) { E(acc, cur, wr, wc, fr, fq); S.done(cur); }
        if (!has_next) break;
#pragma unroll
        for (int a = 0; a < 2; ++a)
#pragma unroll
            for (int b = 0; b < 2; ++b)
#pragma unroll
                for (int m = 0; m < 4; ++m)
#pragma unroll
                    for (int n = 0; n < 2; ++n) acc[a][b][m][n] = (f32x4){0.f, 0.f, 0.f, 0.f};
        cur = nxt; cA = nA; cB = nB; ++ui;
        if constexpr (ALIGN_EPI) { if (wr == 1) PG8_BAR; }
    }
    PG8_WAIT_V(0);
    if constexpr (!ALIGN_EPI) { if (wr == 0) PG8_BAR; }
    PG8_BAR;
    if constexpr (Epi::AFTER_DRAIN) { E.fused(acc, cur, wr, wc, fr, fq, lds, wid, lane); S.done(cur); }
#undef PG8_SA
#undef PG8_SB
#undef PG8_STAGE
#undef PG8_LDA
#undef PG8_LDB
#undef PG8_MMA
#undef PG8_WAIT_V
#undef PG8_WAIT_L
#undef PG8_BAR
#undef PG8_SCHED
}
}
namespace attn_body {
using bf16=__hip_bfloat16;
using bf16x8=__attribute__((ext_vector_type(8)))short;
using s16x4=__attribute__((ext_vector_type(4)))short;
using f32x16=__attribute__((ext_vector_type(16)))float;
using u32x4=__attribute__((ext_vector_type(4)))unsigned;
constexpr int BATCH=2,NHEAD=8,SEQ=8192,D=64,DM=NHEAD*D,OPITCH=512;
constexpr int NW=8,QBLK=32,QB=QBLK*NW,KVBLK=64,NQB=SEQ/QB;
__device__ __forceinline__ int crow(int r,int hi){return (r&3)+8*(r>>2)+4*hi;}
#define SBAR() __builtin_amdgcn_sched_barrier(0)
constexpr int NSLOT=3, SLOTB=8192;
constexpr int LDS_K=0, LDS_V=NSLOT*SLOTB, LDS_WS=2*NSLOT*SLOTB, LDS_OST=LDS_WS+NW*64*4, LDS_BYTES=LDS_OST+NW*4096;
constexpr float C2=0.125f*1.4426950408889634f;
__device__ __forceinline__ void glds16(const void*gsrc,unsigned lds_dst){unsigned keep;
  asm volatile("s_mov_b32 %0, m0\n\ts_mov_b32 m0, %2\n\ts_nop 0\n\tglobal_load_lds_dwordx4 %1, off\n\ts_mov_b32 m0, %0":"=&s"(keep):"v"(gsrc),"s"(lds_dst):"memory");}
__device__ __forceinline__ unsigned long long gld8(const unsigned long long*sbase,unsigned voff){unsigned long long r; asm volatile("global_load_dwordx2 %0, %1, %2":"=&v"(r):"v"(voff),"s"(sbase):"memory"); return r;}
typedef float f32x2_t __attribute__((ext_vector_type(2))); typedef __bf16 bf16x2_t __attribute__((ext_vector_type(2)));
__device__ __forceinline__ unsigned cvtpk_s(float lo,float hi){f32x2_t v={lo,hi};bf16x2_t b=__builtin_convertvector(v,bf16x2_t);return __builtin_bit_cast(unsigned,b);}

__device__ __forceinline__ void qkt(f32x16&p0,f32x16&p1,const char*Kslot,const bf16x8*qr,int r32,int hi){
  const f32x16 negm=f32x16{};
  const char*kb=Kslot+hi*1024+r32*16;
  #pragma unroll
  for(int d0=0;d0<4;++d0){
    const bf16x8 b0=*reinterpret_cast<const bf16x8*>(kb+d0*2048);
    const bf16x8 b1=*reinterpret_cast<const bf16x8*>(kb+d0*2048+512);
    if(d0==0){p0=__builtin_amdgcn_mfma_f32_32x32x16_bf16(b0,qr[0],negm,0,0,0);p1=__builtin_amdgcn_mfma_f32_32x32x16_bf16(b1,qr[0],negm,0,0,0);}
    else{p0=__builtin_amdgcn_mfma_f32_32x32x16_bf16(b0,qr[d0],p0,0,0,0);p1=__builtin_amdgcn_mfma_f32_32x32x16_bf16(b1,qr[d0],p1,0,0,0);}}
}
typedef __attribute__((address_space(3))) const char* lds_cptr;
typedef short v4i16_t __attribute__((ext_vector_type(4)));
__device__ __forceinline__ void kload8(bf16x8*kf,lds_cptr kp){
  kf[0]=*(const __attribute__((address_space(3))) bf16x8*)(kp);      kf[1]=*(const __attribute__((address_space(3))) bf16x8*)(kp+512);
  kf[2]=*(const __attribute__((address_space(3))) bf16x8*)(kp+2048); kf[3]=*(const __attribute__((address_space(3))) bf16x8*)(kp+2560);
  kf[4]=*(const __attribute__((address_space(3))) bf16x8*)(kp+4096); kf[5]=*(const __attribute__((address_space(3))) bf16x8*)(kp+4608);
  kf[6]=*(const __attribute__((address_space(3))) bf16x8*)(kp+6144); kf[7]=*(const __attribute__((address_space(3))) bf16x8*)(kp+6656);
}
__device__ __forceinline__ void kload2(bf16x8*kf,lds_cptr kp,int j){ kf[2*j]=*(const __attribute__((address_space(3))) bf16x8*)(kp+j*2048); kf[2*j+1]=*(const __attribute__((address_space(3))) bf16x8*)(kp+j*2048+512); }
__device__ __forceinline__ s16x4 vtr(lds_cptr p){ return __builtin_bit_cast(s16x4,__builtin_amdgcn_ds_read_tr16_b64_v4i16((__attribute__((address_space(3))) v4i16_t*)p)); }
__device__ __forceinline__ void pv(f32x16*o,int vb,bf16x8 pa0,bf16x8 pa1,bf16x8 pa2,bf16x8 pa3){
  #pragma unroll
  for(int d0=0;d0<2;++d0){s16x4 lo[4],hi[4];
    #pragma unroll
    for(int ks=0;ks<4;++ks){
      asm volatile("ds_read_b64_tr_b16 %0,%1 offset:%c2":"=&v"(lo[ks]):"v"(vb),"i"(d0*4096+ks*1024):"memory");
      asm volatile("ds_read_b64_tr_b16 %0,%1 offset:%c2":"=&v"(hi[ks]):"v"(vb),"i"(d0*4096+ks*1024+512):"memory");}
    asm volatile("s_waitcnt lgkmcnt(0)":::"memory");SBAR();
    #define PK(k) (bf16x8){lo[k][0],lo[k][1],lo[k][2],lo[k][3],hi[k][0],hi[k][1],hi[k][2],hi[k][3]}
    o[d0]=__builtin_amdgcn_mfma_f32_32x32x16_bf16(pa0,PK(0),o[d0],0,0,0);
    o[d0]=__builtin_amdgcn_mfma_f32_32x32x16_bf16(pa1,PK(1),o[d0],0,0,0);
    o[d0]=__builtin_amdgcn_mfma_f32_32x32x16_bf16(pa2,PK(2),o[d0],0,0,0);
    o[d0]=__builtin_amdgcn_mfma_f32_32x32x16_bf16(pa3,PK(3),o[d0],0,0,0);
    #undef PK
  }
}
#define MSK(v,w,r) __uint_as_float(__float_as_uint(v)&(unsigned)__builtin_amdgcn_sbfe((int)(w),((r)&3)+8*((r)>>2),1))

__device__ __forceinline__ void attn_unit(int b,int h,int qb,const bf16*Q,const bf16*__restrict__ K,const bf16*__restrict__ V,bf16*O,const unsigned long long*MK,float cshift,char*shm){
  const int tid=threadIdx.x,lane=tid&63,r32=lane&31,hi=lane>>5; const int wid=__builtin_amdgcn_readfirstlane(tid>>6);
  const long rowbase=(long)b*SEQ; const int q0=qb*QB;
  const bf16*Qw=Q+(rowbase+q0+wid*QBLK)*DM+h*D;
  const bf16*Kh=K+rowbase*DM+h*D,*Vh=V+rowbase*DM+h*D;
  const unsigned lds0=(unsigned)(uintptr_t)shm;
  float*wsf=(float*)(shm+LDS_WS)+wid*64;
  const bf16*ksrc=Kh+(long)lane*DM+wid*8;
  const bf16*vsrc=Vh+(long)(16*(wid&3)+(lane>>2))*DM+(wid>>2)*32+(lane&3)*8;
  const unsigned kdst=lds0+LDS_K+wid*1024, vdst=lds0+LDS_V+wid*1024;
  #define DMA_K(t,slot) glds16(ksrc+(long)(t)*KVBLK*DM,(unsigned)__builtin_amdgcn_readfirstlane(kdst+(slot)))
  #define DMA_V(t,slot) glds16(vsrc+(long)(t)*KVBLK*DM,(unsigned)__builtin_amdgcn_readfirstlane(vdst+(slot)))
  const int vb0=(int)(lds0+LDS_V)+((lane>>4)&1)*32+(lane&3)*8+(4*hi+((lane&15)>>2))*64;
  const char*Kbase=shm+LDS_K; bf16x8 kf[8];
  const lds_cptr shm3=(lds_cptr)shm; const lds_cptr kp0=shm3+LDS_K+hi*1024+r32*16; const lds_cptr vp0=shm3+LDS_V+((lane>>4)&1)*32+(lane&3)*8+(4*hi+((lane&15)>>2))*64;
  const int NT=(q0+QB)/KVBLK;
  const unsigned long long*mbase=MK+(size_t)b*(SEQ/KVBLK)*SEQ; const unsigned moff=(unsigned)(q0+wid*QBLK+r32)*8u;
  DMA_K(0,0);DMA_V(0,0);DMA_K(1,SLOTB);
  bf16x8 qr[4];
  #pragma unroll
  for(int d0=0;d0<4;++d0)qr[d0]=*reinterpret_cast<const bf16x8*>(&Qw[(long)r32*DM+d0*16+hi*8]);
  unsigned long long mC=gld8(mbase,moff), mN=gld8(mbase+SEQ,moff);
  float l_reg=0.f;f32x16 o[2];o[0]=f32x16{};o[1]=f32x16{};const f32x16 negm=f32x16{};
  (void)cshift;
  #define WAIT_BAR(N) asm volatile("s_waitcnt vmcnt(" #N ") lgkmcnt(0)\n\ts_barrier":"+v"(mN),"+v"(mC)::"memory")
  f32x16 pA0,pA1,pB0,pB1;
  int sl_prev=0,sl_cur=0,sl_next=SLOTB;
  #define ROT() do{sl_prev=sl_cur;sl_cur=sl_next;sl_next=(sl_next==(NSLOT-1)*SLOTB)?0:sl_next+SLOTB;}while(0)
  DMA_K(2,2*SLOTB);
  WAIT_BAR(3);
  qkt(pA0,pA1,Kbase,qr,r32,hi);asm volatile("s_nop 15\n\ts_nop 7":"+v"(pA0),"+v"(pA1));
  _Pragma("unroll") for(int r=0;r<16;++r){pA0[r]=__builtin_amdgcn_exp2f(pA0[r]);pA1[r]=__builtin_amdgcn_exp2f(pA1[r]);}
  WAIT_BAR(0);
  { const unsigned ma_=(unsigned)mC>>(4*hi), mb_=(unsigned)(mC>>32)>>(4*hi);
    _Pragma("unroll") for(int r=0;r<16;++r){pA0[r]=MSK(pA0[r],ma_,r);pA1[r]=MSK(pA1[r],mb_,r);} }
  DMA_K(3,0);DMA_V(1,SLOTB);
  ROT();
  kload8(kf,kp0+sl_cur);
  WAIT_BAR(2);
  s16x4 vlo[8],vhi[8]; u32x4 pw0,pw1,pw2,pw3;
  #define PKW(P,B) cvtpk_s(P[B],P[B+1])
  #define PAF(k) __builtin_bit_cast(bf16x8,pw##k)
  #define VFR(i) (bf16x8){vlo[i][0],vlo[i][1],vlo[i][2],vlo[i][3],vhi[i][0],vhi[i][1],vhi[i][2],vhi[i][3]}
  #define PIN(x) asm volatile("":"+v"(x))
  #define GAPA(MF,A0,A1,A2,A3,W0,W1,PW) do{ MF; sacc+=A0; sacc+=A1; sacc+=A2; sacc+=A3; PIN(sacc); W0; W1; PIN(PW); SBAR(); }while(0)
  #define EX(v) __builtin_amdgcn_exp2f(v)
  #define GAPB(MF,X,B,W) do{ MF; X[B]=MSK(EX(X[B]),W,B); X[B+1]=MSK(EX(X[B+1]),W,B+1); X[B+2]=MSK(EX(X[B+2]),W,B+2); X[B+3]=MSK(EX(X[B+3]),W,B+3); PIN(X); SBAR(); }while(0)
  #define VRD(i) do{ vlo[i]=vtr(vp_+(((i)>>2)*4096+((i)&3)*1024)); vhi[i]=vtr(vp_+(((i)>>2)*4096+((i)&3)*1024+512)); }while(0)
  #define KRD(G,j) do{ if(G){ kload2(kf,kp0+sl_next,j); SBAR(); } }while(0)
  #define STEP(C0,C1,P0,P1,t,GK,GV,GL) do{ SBAR(); \
    const unsigned ma_=(unsigned)mN>>(4*hi), mb_=(unsigned)(mN>>32)>>(4*hi); \
    if((t)+1<NT){ mN=gld8(mbase+(size_t)((t)+1)*SEQ,moff); } \
    const lds_cptr vp_=vp0+sl_prev; \
    VRD(0); SBAR(); float sacc=(P0[0]+P0[1]); \
    GAPA(C0=__builtin_amdgcn_mfma_f32_32x32x16_bf16(kf[0],qr[0],negm,0,0,0), P0[2],P0[3],P0[4],P0[5],     pw0[0]=PKW(P0,0), pw0[1]=PKW(P0,2), pw0); \
    VRD(4); SBAR(); GAPA(C1=__builtin_amdgcn_mfma_f32_32x32x16_bf16(kf[1],qr[0],negm,0,0,0), P0[6],P0[7],P0[8],P0[9],     pw0[2]=PKW(P0,4), pw0[3]=PKW(P0,6), pw0); \
    VRD(1); SBAR(); GAPA(C0=__builtin_amdgcn_mfma_f32_32x32x16_bf16(kf[2],qr[1],C0,0,0,0),   P0[10],P0[11],P0[12],P0[13], pw1[0]=PKW(P0,8), pw1[1]=PKW(P0,10), pw1); \
    VRD(5); SBAR(); GAPA(C1=__builtin_amdgcn_mfma_f32_32x32x16_bf16(kf[3],qr[1],C1,0,0,0),   P0[14],P0[15],P1[0],P1[1],   pw1[2]=PKW(P0,12),pw1[3]=PKW(P0,14), pw1); \
    VRD(2); SBAR(); GAPA(C0=__builtin_amdgcn_mfma_f32_32x32x16_bf16(kf[4],qr[2],C0,0,0,0),   P1[2],P1[3],P1[4],P1[5],     pw2[0]=PKW(P1,0), pw2[1]=PKW(P1,2), pw2); \
    VRD(6); SBAR(); GAPA(C1=__builtin_amdgcn_mfma_f32_32x32x16_bf16(kf[5],qr[2],C1,0,0,0),   P1[6],P1[7],P1[8],P1[9],     pw2[2]=PKW(P1,4), pw2[3]=PKW(P1,6), pw2); \
    VRD(3); SBAR(); GAPA(C0=__builtin_amdgcn_mfma_f32_32x32x16_bf16(kf[6],qr[3],C0,0,0,0),   P1[10],P1[11],P1[12],P1[13], pw3[0]=PKW(P1,8), pw3[1]=PKW(P1,10), pw3); \
    VRD(7); SBAR(); GAPA(C1=__builtin_amdgcn_mfma_f32_32x32x16_bf16(kf[7],qr[3],C1,0,0,0),   P1[14],P1[15],0.f,0.f,       pw3[2]=PKW(P1,12),pw3[3]=PKW(P1,14), pw3); \
    l_reg+=sacc; \
    if(GK){DMA_K((t)+3,sl_cur);} if(GV){DMA_V((t)+1,sl_next);} \
    SBAR(); \
    GAPB(o[0]=__builtin_amdgcn_mfma_f32_32x32x16_bf16(PAF(0),VFR(0),o[0],0,0,0), C0,0,ma_); \
    GAPB(o[1]=__builtin_amdgcn_mfma_f32_32x32x16_bf16(PAF(0),VFR(4),o[1],0,0,0), C0,4,ma_); \
    KRD(GL,0); GAPB(o[0]=__builtin_amdgcn_mfma_f32_32x32x16_bf16(PAF(1),VFR(1),o[0],0,0,0), C0,8,ma_); \
    KRD(GL,1); GAPB(o[1]=__builtin_amdgcn_mfma_f32_32x32x16_bf16(PAF(1),VFR(5),o[1],0,0,0), C0,12,ma_); \
    KRD(GL,2); GAPB(o[0]=__builtin_amdgcn_mfma_f32_32x32x16_bf16(PAF(2),VFR(2),o[0],0,0,0), C1,0,mb_); \
    KRD(GL,3); GAPB(o[1]=__builtin_amdgcn_mfma_f32_32x32x16_bf16(PAF(2),VFR(6),o[1],0,0,0), C1,4,mb_); \
    GAPB(o[0]=__builtin_amdgcn_mfma_f32_32x32x16_bf16(PAF(3),VFR(3),o[0],0,0,0), C1,8,mb_); \
    GAPB(o[1]=__builtin_amdgcn_mfma_f32_32x32x16_bf16(PAF(3),VFR(7),o[1],0,0,0), C1,12,mb_); \
    }while(0)
  int t=1;
  for(;t+5<NT;t+=2){
    STEP(pB0,pB1,pA0,pA1,t,true,true,true);     WAIT_BAR(2); ROT();
    STEP(pA0,pA1,pB0,pB1,t+1,true,true,true);   WAIT_BAR(2); ROT();
  }
  #define ENDW(tt) do{ if((tt)+3<NT){WAIT_BAR(2);} else if((tt)+2<NT){WAIT_BAR(1);} else {WAIT_BAR(0);} }while(0)
  for(;t+1<NT;t+=2){
    STEP(pB0,pB1,pA0,pA1,t,(t+3<NT),(t+1<NT),(t+1<NT));       ENDW(t);   ROT();
    STEP(pA0,pA1,pB0,pB1,t+1,(t+4<NT),(t+2<NT),(t+2<NT));     ENDW(t+1); ROT();
  }
  STEP(pB0,pB1,pA0,pA1,NT-1,false,false,false);
  { float sacc=pB0[0]+pB0[1]; _Pragma("unroll") for(int r=2;r<16;++r)sacc+=pB0[r]; _Pragma("unroll") for(int r=0;r<16;++r)sacc+=pB1[r]; l_reg+=sacc;
    pw0=(u32x4){PKW(pB0,0),PKW(pB0,2),PKW(pB0,4),PKW(pB0,6)};pw1=(u32x4){PKW(pB0,8),PKW(pB0,10),PKW(pB0,12),PKW(pB0,14)};pw2=(u32x4){PKW(pB1,0),PKW(pB1,2),PKW(pB1,4),PKW(pB1,6)};pw3=(u32x4){PKW(pB1,8),PKW(pB1,10),PKW(pB1,12),PKW(pB1,14)};
    SBAR(); pv(o,vb0+sl_cur,PAF(0),PAF(1),PAF(2),PAF(3)); }
  #undef PKW
  #undef PAF
  #undef VFR
  #undef PIN
  #undef GAPA
  #undef GAPB
  #undef EX
  #undef VRD
  #undef KRD
  #undef STEP
  #undef ENDW
  {auto rr=__builtin_amdgcn_permlane32_swap(__float_as_uint(l_reg),__float_as_uint(l_reg),false,false);l_reg=__uint_as_float(rr[0])+__uint_as_float(rr[1]);}
  if(hi==0)wsf[32+r32]=l_reg;asm volatile("s_waitcnt lgkmcnt(0)":::"memory");
  float rli[16];
  #pragma unroll
  for(int r=0;r<16;++r)rli[r]=__builtin_amdgcn_rcpf(wsf[32+crow(r,hi)]);
  bf16*Ow=O+(rowbase+q0+wid*QBLK)*OPITCH+h*D;
  { bf16*stg=(bf16*)(shm+LDS_OST)+wid*2048;
    #pragma unroll
    for(int r=0;r<16;++r){const int orow=crow(r,hi);
      #pragma unroll
      for(int d0=0;d0<2;++d0)stg[orow*64+d0*32+r32]=__float2bfloat16(o[d0][r]*rli[r]);}
    asm volatile("s_waitcnt lgkmcnt(0)":::"memory");
    #pragma unroll
    for(int i=0;i<4;++i){const int row=i*8+(lane>>3),ch=lane&7; const u32x4 v=*(const u32x4*)(stg+row*64+ch*8); *(u32x4*)(Ow+(long)row*OPITCH+ch*8)=v;} }
  asm volatile("s_waitcnt lgkmcnt(0)\n\ts_barrier":::"memory");
  #undef DMA_K
  #undef DMA_V
  #undef ROT
  #undef WAIT_BAR
}
#undef MSK
constexpr int ATTN_LDS_BYTES=LDS_BYTES;
#undef SBAR
}
#define XB_TMO      128
#define XB_XCNT(j)  (256  + 64 * (j))
#define XB_XSUB(j)  (1280 + 64 * (j))
#define XB_XGEN(j)  (2304 + 64 * (j))
#define XB_TOP      3328
#define XB_TOPGEN   3392
#define XCD_BAR_WORDS 3456
#define XB_SPIN_CAP (1u << 18)

__device__ __forceinline__ unsigned xb_ld(unsigned* p)              { return __hip_atomic_load(p, __ATOMIC_RELAXED, __HIP_MEMORY_SCOPE_AGENT); }
__device__ __forceinline__ unsigned xb_add(unsigned* p, unsigned v) { return __hip_atomic_fetch_add(p, v, __ATOMIC_RELAXED, __HIP_MEMORY_SCOPE_AGENT); }
__device__ __forceinline__ unsigned xb_xcc_id() { return (unsigned)__builtin_amdgcn_s_getreg((3 << 11) | 20) & 0xFu; }
#define XB_SPIN(cond, bar) do { unsigned _sp = 0; while (cond) { __builtin_amdgcn_s_sleep(1); \
    if ((++_sp & 255u) == 0u) { if (xb_ld(&(bar)[XB_TMO])) break; if (_sp > XB_SPIN_CAP) { atomicAdd(&(bar)[XB_TMO], 1u); break; } } } } while (0)

struct XcdBarrier {
    unsigned* bar; unsigned x;
    volatile LAS unsigned* st;
};

__device__ __forceinline__ XcdBarrier xcd_barrier_post(unsigned* bar, volatile LAS unsigned* st) {
    XcdBarrier b; b.bar = bar; b.x = xb_xcc_id(); b.st = st;
    if (threadIdx.x == 0) (void)xb_add(&bar[XB_XCNT(b.x)], 1u);
    return b;
}
__device__ __forceinline__ void xcd_barrier_complete(unsigned* bar, unsigned x, unsigned& nloc, unsigned& nx) {
    const unsigned G = gridDim.x * gridDim.y * gridDim.z;
    unsigned sum, cnt, mine, sp = 0u;
    for (;;) {
        sum = 0u; cnt = 0u; mine = 0u;
#pragma unroll
        for (unsigned j = 0; j < 16; ++j) { const unsigned c = xb_ld(&bar[XB_XCNT(j)]); sum += c; cnt += (c > 0u) ? 1u : 0u; mine = (j == x) ? c : mine; }
        if (sum == G) break;
        __builtin_amdgcn_s_sleep(1);
        if ((++sp & 255u) == 0u) { if (xb_ld(&bar[XB_TMO])) break; if (sp > XB_SPIN_CAP) { atomicAdd(&bar[XB_TMO], 1u); break; } }
    }
    nloc = mine > 0u ? mine : 1u; nx = cnt > 0u ? cnt : 1u;
}

__device__ __forceinline__ void xcd_barrier(const XcdBarrier& b) {
    asm volatile("s_waitcnt vmcnt(0)" ::: "memory");
    __syncthreads();
    if (threadIdx.x == 0) {
        unsigned* bar = b.bar;
        __builtin_amdgcn_s_waitcnt(0);
        unsigned nloc = b.st[0], nx = b.st[1];
        if (nloc == 0u) { xcd_barrier_complete(bar, b.x, nloc, nx); b.st[0] = nloc; b.st[1] = nx; }
        const unsigned old = xb_add(&bar[XB_XSUB(b.x)], 1u);
        const unsigned gen = old / nloc;
        if (old + 1u == (gen + 1u) * nloc) {
            __builtin_amdgcn_fence(__ATOMIC_RELEASE, "agent");
            asm volatile("s_waitcnt vmcnt(0)" ::: "memory");
            const unsigned og = xb_add(&bar[XB_TOP], 1u);
            const unsigned tg = og / nx;
            if (og + 1u == (tg + 1u) * nx) xb_add(&bar[XB_TOPGEN], 1u);
            else XB_SPIN(xb_ld(&bar[XB_TOPGEN]) == tg, bar);
            __builtin_amdgcn_fence(__ATOMIC_ACQUIRE, "agent");
            xb_add(&bar[XB_XGEN(b.x)], 1u);
            asm volatile("s_waitcnt vmcnt(0)" ::: "memory");
        } else {
            XB_SPIN(xb_ld(&bar[XB_XGEN(b.x)]) == gen, bar);
            __builtin_amdgcn_fence(__ATOMIC_ACQUIRE, "agent");
            asm volatile("s_waitcnt vmcnt(0)" ::: "memory");
        }
    }
    __syncthreads();
}
struct Frame {
    LAS unsigned char* lds;
    volatile LAS unsigned* MISC;
    gu32* ctl;
    int tid, lane, wave;
    int vcu, G;
    unsigned char* ws;
    const float* in[18]; float* out;
};
__device__ __forceinline__ float wave_sum(float v) {
#pragma unroll
    for (int o = 1; o < 64; o <<= 1) v += __shfl_xor(v, o);
    return v;
}
__device__ __forceinline__ float wave_max(float v) {
#pragma unroll
    for (int o = 1; o < 64; o <<= 1) v = fmaxf(v, __shfl_xor(v, o));
    return v;
}
template <int MODE> __device__ __forceinline__ int tr_row(int n) {
    if (MODE == 0) return n < 1860 ? n : n + 188;
    if (MODE == 1) return n < 1024 ? 256 * (n >> 7) + (n & 127) : 256 * ((n - 1024) >> 7) + 128 + ((n - 1024) & 127);
    if (MODE == 4) return 256 * (n >> 7) + (n & 127);
    if (MODE == 5) return 256 * (n >> 7) + 128 + (n & 127);
    return n;
}
template <int MODE> __device__ __forceinline__ void tr_item(const float* W, int N, bf16* WT, int ldt, int koff, LAS float* scr, int kb, int nb, int lane) {
    const int k0 = 64 * kb, n0 = 64 * nb, cq = 4 * (lane & 15), r0 = lane >> 4; const bool colok = (n0 + cq) < N;
    f32x4 v[16];
#pragma unroll
    for (int j = 0; j < 16; ++j) v[j] = colok ? *(const GAS f32x4*)(W + (size_t)(k0 + r0 + 4 * j) * N + n0 + cq) : (f32x4){0.f, 0.f, 0.f, 0.f};
#pragma unroll
    for (int j = 0; j < 16; ++j) { LAS float* d = scr + (r0 + 4 * j) * 65 + cq; d[0] = v[j].x; d[1] = v[j].y; d[2] = v[j].z; d[3] = v[j].w; }
    LDS_WAIT(); asm volatile("" ::: "memory");
    const int c = lane & 7;
#pragma unroll
    for (int j = 0; j < 8; ++j) { const int n = (lane >> 3) + 8 * j; const LAS float* s = scr + (8 * c) * 65 + n;
        v4u o; o.x = pk2(s[0 * 65], s[1 * 65]); o.y = pk2(s[2 * 65], s[3 * 65]); o.z = pk2(s[4 * 65], s[5 * 65]); o.w = pk2(s[6 * 65], s[7 * 65]);
        if (n0 + n < N) *(GAS v4u*)(WT + (size_t)tr_row<MODE>(n0 + n) * ldt + koff + k0 + 8 * c) = o; }
    LDS_WAIT(); asm volatile("" ::: "memory");
}
__device__ __forceinline__ void rms_row_to_bf16(const float* xrow, const float* g, bf16* orow, int lane) {
    const GAS f32x4* xr = (const GAS f32x4*)xrow + lane; const GAS f32x4* gr = (const GAS f32x4*)g + lane;
    f32x4 v[4]; float s = 0.f;
#pragma unroll
    for (int j = 0; j < 4; ++j) { v[j] = xr[64 * j]; s += (v[j].x * v[j].x + v[j].y * v[j].y) + (v[j].z * v[j].z + v[j].w * v[j].w); }
    const float r = 1.0f / sqrtf(wave_sum(s) * (1.f / 1024.f) + EPS);
    GAS unsigned long long* o8 = (GAS unsigned long long*)orow + lane;
#pragma unroll
    for (int j = 0; j < 4; ++j) { const f32x4 gv = gr[64 * j]; o8[64 * j] = (unsigned long long)pk2(v[j].x * r * gv.x, v[j].y * r * gv.y) | ((unsigned long long)pk2(v[j].z * r * gv.z, v[j].w * r * gv.w) << 32); }
}
__device__ __forceinline__ void p0_prologue(Frame& F) {
    LAS float* scr = (LAS float*)(F.lds + RING_OFF + F.wave * 16640);
    const int gw = F.vcu * NWAVES + F.wave, NGW = F.G * NWAVES;
    bf16* Win_t = (bf16*)(F.ws + WS_WIN); bf16* Wab_t = (bf16*)(F.ws + WS_WAB); bf16* Wout_t = (bf16*)(F.ws + WS_WOUT); bf16* Wpool_t = (bf16*)(F.ws + WS_WPOOL);
    bf16* W1_t = (bf16*)(F.ws + WS_W1); bf16* W2_t = (bf16*)(F.ws + WS_W2);
    constexpr int I_W1 = 32 * 16 * 32, I_W2 = 32 * 16 * 16, I_IN = 16 * 70, I_OUT = 16 * 16, I_WA = 8 * 16, I_WB = 8 * 16, I_POOL = 16;
    constexpr int NITEMS = I_W1 + I_W2 + I_IN + I_OUT + I_WA + I_WB + I_POOL;
    for (int it = gw; it < NITEMS; it += NGW) {
        int r = it;
        if (r < I_W1) { const int e = r >> 9, rr = r & 511; tr_item<1>(F.in[14] + (size_t)e * 1024 * 2048, 2048, W1_t + (size_t)e * 2048 * 1024, 1024, 0, scr, rr >> 5, rr & 31, F.lane); continue; } r -= I_W1;
        if (r < I_W2) { const int e = r >> 8, rr = r & 255; tr_item<2>(F.in[16] + (size_t)e * 1024 * 1024, 1024, W2_t + (size_t)e * 1024 * 1024, 1024, 0, scr, rr >> 4, rr & 15, F.lane); continue; } r -= I_W2;
        if (r < I_IN) { tr_item<0>(F.in[2], NIN, Win_t, 1024, 0, scr, r / 70, r % 70, F.lane); continue; } r -= I_IN;
        if (r < I_OUT) { tr_item<2>(F.in[10], 1024, Wout_t, 1024, 0, scr, r >> 4, r & 15, F.lane); continue; } r -= I_OUT;
        if (r < I_WA) { tr_item<2>(F.in[8], 1024, Wab_t, 512, 0, scr, r >> 4, r & 15, F.lane); continue; } r -= I_WA;
        if (r < I_WB) { tr_item<2>(F.in[9], 1024, Wab_t + 1024 * 512, 512, 0, scr, r >> 4, r & 15, F.lane); continue; } r -= I_WB;
        { const int g = r >> 2, rr = r & 3; tr_item<2>(F.in[5] + (size_t)g * 128 * 128, 128, Wpool_t + (size_t)(128 * g) * 512, 512, 128 * g, scr, rr >> 1, rr & 1, F.lane); }
    }
    const int gt = F.vcu * (NWAVES * 64) + F.tid, NGT = F.G * NWAVES * 64; const v4u z = {0u, 0u, 0u, 0u};
    for (int i = gt; i < 512 * 64; i += NGT) { const int row = i >> 6, ch = i & 63; if ((ch >> 4) != (row >> 7)) *(GAS v4u*)(Wpool_t + (size_t)row * 512 + ch * 8) = z; }
    for (int i = gt; i < 188 * 128; i += NGT) { const int row = 1860 + (i >> 7), ch = i & 127; *(GAS v4u*)(Win_t + (size_t)row * 1024 + ch * 8) = z; }
    bf16* H = (bf16*)(F.ws + WS_H);
    { const GAS f32x4* gr = (const GAS f32x4*)F.in[1] + F.lane; f32x4 gv[4];
#pragma unroll
      for (int j = 0; j < 4; ++j) gv[j] = gr[64 * j];
      for (int m0 = gw; m0 < M; m0 += 4 * NGW) { f32x4 v[4][4];
#pragma unroll
          for (int u = 0; u < 4; ++u) { const GAS f32x4* xr = (const GAS f32x4*)(F.in[0] + (size_t)(m0 + u * NGW) * 1024) + F.lane;
#pragma unroll
              for (int j = 0; j < 4; ++j) v[u][j] = xr[64 * j]; }
#pragma unroll
          for (int u = 0; u < 4; ++u) { float ss = 0.f;
#pragma unroll
              for (int j = 0; j < 4; ++j) ss += (v[u][j].x * v[u][j].x + v[u][j].y * v[u][j].y) + (v[u][j].z * v[u][j].z + v[u][j].w * v[u][j].w);
              const float r = 1.0f / sqrtf(wave_sum(ss) * (1.f / 1024.f) + EPS); GAS unsigned long long* o8 = (GAS unsigned long long*)(H + (size_t)(m0 + u * NGW) * 1024) + F.lane;
#pragma unroll
              for (int j = 0; j < 4; ++j) { const f32x4 y = v[u][j] * r * gv[j]; o8[64 * j] = (unsigned long long)pk2(y.x, y.y) | ((unsigned long long)pk2(y.z, y.w) << 32); } } } }
}
__device__ __forceinline__ void qknorm_rows(Frame& F, bool dry = false) {
    const int gw = F.vcu * NWAVES + F.wave, NGW = F.G * NWAVES, lane = F.lane;
    bf16* Q = (bf16*)(F.ws + WS_Q); bf16* K = (bf16*)(F.ws + WS_K);
    const int d0 = (lane & 7) * 8;
    float gq[8], gk[8];
#pragma unroll
    for (int j = 0; j < 8; ++j) { gq[j] = F.in[3][d0 + j] * attn_body::C2; gk[j] = F.in[4][d0 + j]; }
    for (int m0 = gw; m0 < 2 * M; m0 += 4 * NGW) {
        v4u w[4]; bf16* p[4]; bool isq[4];
#pragma unroll
        for (int u = 0; u < 4; ++u) { const int m = m0 + u * NGW; isq[u] = m < M; p[u] = (isq[u] ? Q + (size_t)m * 512 : K + (size_t)(m - M) * 512) + lane * 8; w[u] = (m < 2 * M) ? *(const GAS v4u*)p[u] : (v4u){0u, 0u, 0u, 0u}; }
#pragma unroll
        for (int u = 0; u < 4; ++u) { if (m0 + u * NGW >= 2 * M) break;
            float x[8] = {bflo(w[u].x), bfhi(w[u].x), bflo(w[u].y), bfhi(w[u].y), bflo(w[u].z), bfhi(w[u].z), bflo(w[u].w), bfhi(w[u].w)};
            float s = 0.f;
#pragma unroll
            for (int j = 0; j < 8; ++j) s += x[j] * x[j];
            s += __shfl_xor(s, 1); s += __shfl_xor(s, 2); s += __shfl_xor(s, 4);
            const float r = 1.0f / sqrtf(s * (1.f / 64.f) + EPS);
#pragma unroll
            for (int j = 0; j < 8; ++j) x[j] = x[j] * r * (isq[u] ? gq[j] : gk[j]);
            v4u o; o.x = pk2(x[0], x[1]); o.y = pk2(x[2], x[3]); o.z = pk2(x[4], x[5]); o.w = pk2(x[6], x[7]);
            *(GAS v4u*)p[u] = dry ? w[u] : o; }
    }
}
__device__ __forceinline__ void pool_diff_rows(Frame& F) {
    const int gw = F.vcu * NWAVES + F.wave, NGW = F.G * NWAVES, lane = F.lane;
    const bf16* U = (const bf16*)(F.ws + WS_U); bf16* Dd = (bf16*)(F.ws + WS_DIFF);
    const int win = 2 << (lane >> 4);
    for (int m0 = gw; m0 < M; m0 += 2 * NGW) {
        v4u w[2][16]; int cnt[2];
#pragma unroll
        for (int u = 0; u < 2; ++u) { const int m = m0 + u * NGW, t = m & (SEQ - 1); cnt[u] = (t + 1 < win) ? t + 1 : win;
#pragma unroll
            for (int j = 0; j < 16; ++j) w[u][j] = (j < cnt[u]) ? *(const GAS v4u*)(U + (size_t)(m - j) * 512 + lane * 8) : (v4u){0u, 0u, 0u, 0u}; }
#pragma unroll
        for (int u = 0; u < 2; ++u) { const int m = m0 + u * NGW;
            float a[8] = {0.f, 0.f, 0.f, 0.f, 0.f, 0.f, 0.f, 0.f};
#pragma unroll
            for (int j = 0; j < 16; ++j) { a[0] += bflo(w[u][j].x); a[1] += bfhi(w[u][j].x); a[2] += bflo(w[u][j].y); a[3] += bfhi(w[u][j].y); a[4] += bflo(w[u][j].z); a[5] += bfhi(w[u][j].z); a[6] += bflo(w[u][j].w); a[7] += bfhi(w[u][j].w); }
            const float inv = 1.0f / (float)cnt[u]; v4u o;
            o.x = pk2(a[0] * inv - bflo(w[u][0].x), a[1] * inv - bfhi(w[u][0].x)); o.y = pk2(a[2] * inv - bflo(w[u][0].y), a[3] * inv - bfhi(w[u][0].y));
            o.z = pk2(a[4] * inv - bflo(w[u][0].z), a[5] * inv - bfhi(w[u][0].z)); o.w = pk2(a[6] * inv - bflo(w[u][0].w), a[7] * inv - bfhi(w[u][0].w));
            *(GAS v4u*)(Dd + (size_t)m * 512 + lane * 8) = o; }
    }
}
__device__ __forceinline__ int tk_fidx(int q) { return (((q >> 3) * 2 + (q & 1)) * 4) + ((q & 7) >> 1); }
__device__ __forceinline__ float relu_f(float x) { const int b = __builtin_bit_cast(int, x); return __builtin_bit_cast(float, b > 0 ? b : 0); }
__device__ __forceinline__ unsigned wave_incl_scan(unsigned v, int lane) {
    v += (unsigned)__builtin_amdgcn_update_dpp(0, (int)v, 0x111, 0xf, 0xf, false);
    v += (unsigned)__builtin_amdgcn_update_dpp(0, (int)v, 0x112, 0xf, 0xf, false);
    v += (unsigned)__builtin_amdgcn_update_dpp(0, (int)v, 0x114, 0xf, 0xf, false);
    v += (unsigned)__builtin_amdgcn_update_dpp(0, (int)v, 0x118, 0xf, 0xf, false);
    const unsigned t0 = (unsigned)__builtin_amdgcn_readlane((int)v, 15), t1 = (unsigned)__builtin_amdgcn_readlane((int)v, 31), t2 = (unsigned)__builtin_amdgcn_readlane((int)v, 47);
    return v + (lane >= 16 ? t0 : 0u) + (lane >= 32 ? t1 : 0u) + (lane >= 48 ? t2 : 0u);
}
struct TkState {
    LAS unsigned char* lds;
    __device__ __forceinline__ LAS unsigned* x(int words) const { return (LAS unsigned*)(lds + XTRA_OFF) + words; }
    __device__ __forceinline__ LAS unsigned* hist_() const { return (LAS unsigned*)(lds + RING_OFF); }
    __device__ __forceinline__ LAS unsigned long long* clist_() const { return (LAS unsigned long long*)(lds + XTRA_OFF + 4096); }
    __device__ __forceinline__ const LAS bf16x8* afl_() const { return (const LAS bf16x8*)(lds + RING_OFF + 131072); }
#define TK_F(name, off) __device__ __forceinline__ LAS unsigned* name() const { return x(off); }
    TK_F(sl_lb_, 0)
    TK_F(sl_p1_, 32)
    TK_F(sl_p2_, 64)
    TK_F(sl_lo_, 96)
    TK_F(sl_hi_, 128)
    TK_F(sl_kth_, 160)
    TK_F(need_, 192)
    TK_F(neq_, 224)
    TK_F(ccnt_, 256)
    TK_F(cmin_, 288)
    TK_F(cmax_, 320)
    TK_F(flag_, 352)
    TK_F(wl_, 448)
#undef TK_F
};
constexpr int TK_CAP = 32;
template <int MODE> __device__ __forceinline__ void tk_scan(const TkState& T, int wave, int lane_in, bool MID) {
    int lane = lane_in; asm volatile("" : "+v"(lane));
    for (int qq = 0; qq < 4; ++qq) {
        const int q = 4 * wave + qq, fi = tk_fidx(q); LAS unsigned* hq = T.hist_() + q * 1024;
        bool up;
        int base;
        unsigned pre = 0u;
        if (MODE == 2) { pre = MID ? T.sl_p1_()[fi] : T.sl_p2_()[fi]; const bool neg = MID ? (pre >= 512u) : (pre >= (512u << 11)); up = neg; base = neg ? 16 * lane : 1024 - 16 * (lane + 1); }
        else { up = lane >= 32; base = up ? 512 + 16 * (lane - 32) : 512 - 16 * (lane + 1); }
        unsigned dr[16], d[16];
#pragma unroll
        for (int i = 0; i < 4; ++i) { const v4u v = *(const LAS v4u*)(hq + base + 4 * i); dr[4 * i] = v.x; dr[4 * i + 1] = v.y; dr[4 * i + 2] = v.z; dr[4 * i + 3] = v.w;
            if (MODE != 1) *(LAS v4u*)(hq + base + 4 * i) = (v4u){0u, 0u, 0u, 0u}; }
#pragma unroll
        for (int i = 0; i < 16; ++i) d[i] = up ? dr[i] : dr[15 - i];
        unsigned s = 0u;
#pragma unroll
        for (int i = 0; i < 16; ++i) s += (MODE == 2) ? ((d[i] & 0xffffu) + (d[i] >> 16)) : d[i];
        const unsigned inc = wave_incl_scan(s, lane);
        const unsigned nd = (MODE == 1) ? (unsigned)TOPK : T.need_()[q];
        const unsigned long long bal = __ballot(inc >= nd);
        if (MODE == 1 && bal == 0ull) continue;
        const int Ls = __builtin_amdgcn_readfirstlane(bal ? (int)__ffsll((long long)bal) - 1 : 63);
        unsigned run = inc - s, fpos = 0u, fneed = 1u, fcnt = 1u; bool found = false;
#pragma unroll
        for (int i = 0; i < 16; ++i) {
            if (MODE != 2) { const unsigned c = d[i]; if (!found && run + c >= nd) { found = true; fpos = (unsigned)i; fneed = nd - run; fcnt = c; } run += c; }
            else { const unsigned c0 = up ? (d[i] & 0xffffu) : (d[i] >> 16), c1 = up ? (d[i] >> 16) : (d[i] & 0xffffu);
                if (!found && run + c0 >= nd) { found = true; fpos = 2u * i; fneed = nd - run; fcnt = c0; } run += c0;
                if (!found && run + c1 >= nd) { found = true; fpos = 2u * i + 1u; fneed = nd - run; fcnt = c1; } run += c1; }
        }
        unsigned fbin;
        if (MODE != 2) fbin = up ? (unsigned)base + fpos : (unsigned)base + 15u - fpos;
        else { const unsigned dw = up ? (unsigned)base + (fpos >> 1) : (unsigned)base + 15u - (fpos >> 1); fbin = 2u * dw + (up ? (fpos & 1u) : 1u - (fpos & 1u)); }
        fbin = (unsigned)__builtin_amdgcn_readlane((int)fbin, Ls); fneed = (unsigned)__builtin_amdgcn_readlane((int)fneed, Ls); fcnt = (unsigned)__builtin_amdgcn_readlane((int)fcnt, Ls);
        if (lane == 0) {
            if (MODE == 1) T.sl_lb_()[fi] = fbin < 512u ? (fbin << 22) : ((fbin << 22) | 0x3fffffu);
            if (MODE == 0) { T.sl_p1_()[fi] = fbin; T.need_()[q] = fneed; T.neq_()[q] = fcnt; }
            if (MODE == 2 && MID) { const unsigned p21 = (pre << 11) | fbin, a = p21 << 11, bb = a | 0x7ffu; const bool neg = pre >= 512u;
                T.sl_p2_()[fi] = p21; T.sl_lo_()[fi] = neg ? bb : a; T.sl_hi_()[fi] = neg ? a : bb; T.need_()[q] = fneed; T.neq_()[q] = fcnt; }
            if (MODE == 2 && !MID) { const unsigned kth = (pre << 11) | fbin; T.sl_lo_()[fi] = kth; T.sl_hi_()[fi] = kth; T.need_()[q] = fneed; T.neq_()[q] = fcnt; }
        }
    }
}
#define TK_WL8(v, b) asm volatile("s_nop 4\n\tv_writelane_b32 %0, %1, 0\n\tv_writelane_b32 %0, %2, 1\n\tv_writelane_b32 %0, %3, 2\n\tv_writelane_b32 %0, %4, 3\n\tv_writelane_b32 %0, %5, 4\n\tv_writelane_b32 %0, %6, 5\n\tv_writelane_b32 %0, %7, 6\n\tv_writelane_b32 %0, %8, 7" \
    : "+v"(v) : "s"((unsigned)b[0]), "s"((unsigned)(b[0] >> 32)), "s"((unsigned)b[1]), "s"((unsigned)(b[1] >> 32)), "s"((unsigned)b[2]), "s"((unsigned)(b[2] >> 32)), "s"((unsigned)b[3]), "s"((unsigned)(b[3] >> 32)))
template <int PASS> __device__ __forceinline__ void topk_pass(const bf16x8 (&af)[4][4], const LAS f32x4* wl4, const bf16* IKb, int nb, const TkState& T, int wave, int lane_in, bool low, bf16x8 (&bfirst)[4], unsigned one = 1u) {
    int lane = lane_in; asm volatile("" : "+v"(lane));
    const int hi = lane >> 5, n32 = lane & 31;
    const unsigned sh_m = low ? 11u : 22u, sh_b = low ? 0u : 11u;
    LAS unsigned* GT = T.hist_(); LAS unsigned* EQ = T.hist_() + 32 * 257;
    const bf16* kp0 = IKb + (size_t)lane * 8;
    bf16x8 bc[4];
#pragma unroll
    for (int kk = 0; kk < 4; ++kk) bc[kk] = bfirst[kk];
    const LAS v4u* pa = (const LAS v4u*)(PASS == 2 ? T.sl_lo_() : (low ? T.sl_p2_() : T.sl_p1_()));
    const LAS v4u* pb = (const LAS v4u*)T.sl_hi_();
    for (int blk = wave; blk < nb; blk += 8) {
        constexpr int DB = (PASS == 2) ? 0 : 1;
        f32x4 wq2[2][4]; v4u pfv2[2], pgv2[2];
#define TK_LDW(qg) do { _Pragma("unroll") for (int jj = 0; jj < 4; ++jj) wq2[(qg) & DB][jj] = wl4[((qg) * 2 + hi) * 4 + jj]; if (PASS != 0) pfv2[(qg) & DB] = pa[(qg) * 2 + hi]; if (PASS == 2) pgv2[(qg) & DB] = pb[(qg) * 2 + hi]; } while (0)
        f32x16 acc[2];
#define TK_MMA(dst, qg) do { dst = f32x16{}; _Pragma("unroll") for (int kk = 0; kk < 4; ++kk) dst = __builtin_amdgcn_mfma_f32_32x32x16_bf16(af[qg][kk], bc[kk], dst, 0, 0, 0); } while (0)
        if (DB) TK_LDW(0);
        TK_MMA(acc[0], 0);
#pragma unroll
        for (int qg = 0; qg < 4; ++qg) {
            if (!DB) TK_LDW(qg);
            if (qg < 3) { if (DB) TK_LDW(qg + 1); TK_MMA(acc[(qg + 1) & 1], qg + 1); }
            const f32x4 (&wq)[4] = wq2[qg & DB]; const v4u pfv = pfv2[qg & DB]; const v4u pgv = pgv2[qg & DB];
            if (qg == 2 && blk + 8 < nb) {
#pragma unroll
                for (int kk = 0; kk < 4; ++kk) bc[kk] = *(const GAS bf16x8*)(kp0 + (size_t)(blk + 8) * 2048 + 512 * kk); }
            const f32x16& a = acc[qg & 1];
#define TK_PIN4(x) asm volatile("" : "+v"(x[0]), "+v"(x[1]), "+v"(x[2]), "+v"(x[3]))
            float sc[4], r0[4], r1[4], r2[4], r3[4];
#pragma unroll
            for (int jj = 0; jj < 4; ++jj) { r0[jj] = relu_f(a[4 * jj + 0]); r1[jj] = relu_f(a[4 * jj + 1]); r2[jj] = relu_f(a[4 * jj + 2]); r3[jj] = relu_f(a[4 * jj + 3]); }
            TK_PIN4(r0); TK_PIN4(r1); TK_PIN4(r2); TK_PIN4(r3);
#pragma unroll
            for (int jj = 0; jj < 4; ++jj) sc[jj] = fmaf(wq[jj][0], r0[jj], 0.f);
            TK_PIN4(sc);
#pragma unroll
            for (int jj = 0; jj < 4; ++jj) sc[jj] = fmaf(wq[jj][1], r1[jj], sc[jj]);
            TK_PIN4(sc);
#pragma unroll
            for (int jj = 0; jj < 4; ++jj) sc[jj] = fmaf(wq[jj][2], r2[jj], sc[jj]);
            TK_PIN4(sc);
#pragma unroll
            for (int jj = 0; jj < 4; ++jj) sc[jj] = fmaf(wq[jj][3], r3[jj], sc[jj]);
            TK_PIN4(sc);
#undef TK_PIN4
            LAS unsigned* hq0 = T.hist_() + (8 * qg + hi) * 1024;
            if (PASS == 0) {
#pragma unroll
                for (int jj = 0; jj < 4; ++jj) __hip_atomic_fetch_add(hq0 + jj * 2048 + (__float_as_uint(sc[jj]) >> 22), one, __ATOMIC_RELAXED, __HIP_MEMORY_SCOPE_WORKGROUP); }
            if (PASS == 1) {
#pragma unroll
                for (int jj = 0; jj < 4; ++jj) { const unsigned u = __float_as_uint(sc[jj]); if ((u >> sh_m) == pfv[jj]) { const unsigned bin = (u >> sh_b) & 0x7ffu; __hip_atomic_fetch_add(hq0 + jj * 2048 + (bin >> 1), one << ((bin & 1u) * 16u), __ATOMIC_RELAXED, __HIP_MEMORY_SCOPE_WORKGROUP); } } }
            if (PASS == 2) {
                unsigned long long bg[4], be[4]; unsigned long long anye = 0ull;
#pragma unroll
                for (int jj = 0; jj < 4; ++jj) {
                    bg[jj] = __ballot(sc[jj] > __uint_as_float(pgv[jj])); be[jj] = __ballot(sc[jj] >= __uint_as_float(pfv[jj])) & ~bg[jj];
                    anye |= be[jj]; }
                unsigned vg = 0u;
                TK_WL8(vg, bg);
                if (lane < 8) GT[(8 * qg + lane) * 257 + blk] = vg;
                if (anye != 0ull) {
                    unsigned ve = 0u;
                    TK_WL8(ve, be);
                    if (lane < 8) EQ[(8 * qg + lane) * 257 + blk] = ve;
                    if (!low) {
#pragma unroll
                        for (int jj = 0; jj < 4; ++jj) { if ((be[jj] >> lane) & 1ull) { const int q = 8 * qg + 2 * jj + hi; const unsigned u = __float_as_uint(sc[jj]);
                            const unsigned slot = __hip_atomic_fetch_add(T.ccnt_() + q, 1u, __ATOMIC_RELAXED, __HIP_MEMORY_SCOPE_WORKGROUP);
                            __hip_atomic_fetch_min(T.cmin_() + q, u, __ATOMIC_RELAXED, __HIP_MEMORY_SCOPE_WORKGROUP); __hip_atomic_fetch_max(T.cmax_() + q, u, __ATOMIC_RELAXED, __HIP_MEMORY_SCOPE_WORKGROUP);
                            if (slot < (unsigned)TK_CAP) T.clist_()[q * TK_CAP + slot] = ((unsigned long long)u << 32) | (unsigned)(32 * blk + n32); } } }
                }
            }
        }
#undef TK_MMA
#undef TK_LDW
#undef TK_LDA
    }
    if (wave < nb) {
#pragma unroll
        for (int kk = 0; kk < 4; ++kk) bfirst[kk] = *(const GAS bf16x8*)(kp0 + (size_t)wave * 2048 + 512 * kk); }
}
__device__ __forceinline__ void tk_keep_first(LAS unsigned* eqr, unsigned nd, int lane) {
    unsigned w[4], pc = 0u;
#pragma unroll
    for (int i = 0; i < 4; ++i) { w[i] = eqr[4 * lane + i]; pc += (unsigned)__builtin_popcount(w[i]); }
    const unsigned inc = wave_incl_scan(pc, lane);
    unsigned before = inc - pc;
#pragma unroll
    for (int i = 0; i < 4; ++i) { const unsigned p = (unsigned)__builtin_popcount(w[i]); const int take = (int)nd - (int)before;
        if (take <= 0) w[i] = 0u; else if (take < (int)p) { unsigned x = w[i], r = 0u; for (int k = 0; k < take; ++k) { const unsigned lsb = x & (0u - x); r |= lsb; x ^= lsb; } w[i] = r; }
        before += p; eqr[4 * lane + i] = w[i]; }
}
__device__ __forceinline__ void topk_unit(Frame& F, int b, int c, int half) {
    const bf16* IQ = (const bf16*)(F.ws + WS_IQ); const bf16* IK = (const bf16*)(F.ws + WS_IK); const float* IW = (const float*)(F.ws + WS_IW);
    unsigned long long* MK = (unsigned long long*)(F.ws + WS_MASK);
    TkState T; T.lds = F.lds;
    LAS float* wl = (LAS float*)T.wl_();
    LAS unsigned* GT = T.hist_(); LAS unsigned* EQ = T.hist_() + 32 * 257;
    int tid = F.tid; asm volatile("" : "+v"(tid));
    const int lane = tid & 63, wave = F.wave;
    const int t0 = 64 * c + 32 * half, L = 64 * (c + 1), nb = L / 32; const size_t tokb = (size_t)b * SEQ;
    const int ntile = 4 * (c / 4 + 1);
#pragma unroll
    for (int i = 0; i < 16; ++i) ((LAS v4u*)T.hist_())[tid + 512 * i] = (v4u){0u, 0u, 0u, 0u};
    if (tid < 32) { T.sl_lb_()[tid] = 0xff800000u  ; T.need_()[tid] = (unsigned)TOPK; T.neq_()[tid] = 0u; T.ccnt_()[tid] = 0u; T.cmin_()[tid] = 0xffffffffu; T.cmax_()[tid] = 0u; if (tid == 0) T.flag_()[0] = 0u; }
    if (tid < 128) { const int q = tid >> 2, hd = tid & 3; wl[tk_fidx(q) * 4 + hd] = IW[(tokb + t0 + q) * 4 + hd] * 0.0625f; }
    __syncthreads();
    if (L > TOPK) {
        const LAS f32x4* wr = (const LAS f32x4*)wl;
        bf16x8 af[4][4];
#pragma unroll
        for (int qg = 0; qg < 4; ++qg)
#pragma unroll
            for (int kk = 0; kk < 4; ++kk) af[qg][kk] = *(const GAS bf16x8*)(IQ + (tokb + t0 + 8 * qg) * 256 + (lane & 31) * 64 + 16 * kk + 8 * (lane >> 5));
        const bf16* IKb = IK + tokb * 64;
        bf16x8 bfirst[4];
        if (wave < nb) {
#pragma unroll
            for (int kk = 0; kk < 4; ++kk) bfirst[kk] = *(const GAS bf16x8*)(IKb + (size_t)lane * 8 + (size_t)wave * 2048 + 512 * kk); }
        if ((REP_PHASE) == 22) topk_pass<0>(af, wr, IKb, nb, T, wave, lane, false, bfirst, 0u);
        topk_pass<0>(af, wr, IKb, nb, T, wave, lane, false, bfirst); __syncthreads(); tk_scan<0>(T, wave, lane, true); __syncthreads();
        for (int round = 0; round < 2; ++round) {
            const bool low = round != 0;
            if (low) { if (T.flag_()[0] == 0u && (REP_PHASE) != 50) break;
                __syncthreads();
#pragma unroll
                for (int i = 0; i < 16; ++i) ((LAS v4u*)T.hist_())[tid + 512 * i] = (v4u){0u, 0u, 0u, 0u};
                __syncthreads(); }
            if ((REP_PHASE) == 23) topk_pass<1>(af, wr, IKb, nb, T, wave, lane, low, bfirst, 0u);
            topk_pass<1>(af, wr, IKb, nb, T, wave, lane, low, bfirst); __syncthreads(); tk_scan<2>(T, wave, lane, !low); __syncthreads();
            for (int rep_ = 0; rep_ < ((REP_PHASE) == 20 ? 2 : 1); ++rep_) { if (rep_) { __syncthreads(); if (tid < 32) { T.ccnt_()[tid] = 0u; } __syncthreads(); } topk_pass<2>(af, wr, IKb, nb, T, wave, lane, low, bfirst); }
            __syncthreads();
            for (int qq = 0; qq < 4; ++qq) { const int q = 4 * wave + qq; const unsigned nd = T.need_()[q], nc = T.neq_()[q];
                if (nd >= nc) continue;
                if (low || T.cmin_()[q] == T.cmax_()[q]) { tk_keep_first(EQ + q * 257, nd, lane); continue; }
                if (nc <= (unsigned)TK_CAP && (TK_CAP) > 0) {
                    const unsigned long long me = (lane < (int)nc) ? T.clist_()[q * TK_CAP + lane] : 0ull; const float mv = __uint_as_float((unsigned)(me >> 32)); const unsigned mi = (unsigned)me; unsigned rank = 0u;
                    for (unsigned j = 0; j < nc; ++j) { const unsigned long long o = T.clist_()[q * TK_CAP + j]; const float ov = __uint_as_float((unsigned)(o >> 32)); const unsigned oi = (unsigned)o; rank += (ov > mv || (ov == mv && oi < mi)) ? 1u : 0u; }
                    if (lane < (int)nc && rank >= nd) __hip_atomic_fetch_and(EQ + q * 257 + (mi >> 5), ~(1u << (mi & 31u)), __ATOMIC_RELAXED, __HIP_MEMORY_SCOPE_WORKGROUP);
                    continue; }
                if (lane == 0) T.flag_()[0] = 1u;
            }
            __syncthreads();
            if ((REP_PHASE) == 50 && low) { if (tid < 32) T.ccnt_()[tid] = 0u; __syncthreads(); }
            for (int idx = tid; idx < 32 * ntile; idx += NWAVES * 64) { const int q = idx & 31, t = idx >> 5;
                const unsigned w0 = GT[q * 257 + 2 * t] | EQ[q * 257 + 2 * t], w1 = GT[q * 257 + 2 * t + 1] | EQ[q * 257 + 2 * t + 1];
                const unsigned long long wv = (unsigned long long)w0 | ((unsigned long long)w1 << 32); unsigned long long* dst = MK + ((size_t)b * 128 + t) * SEQ + t0 + q;
                if ((REP_PHASE) == 50 && low) { if (*dst != wv) __hip_atomic_store(F.ctl + CW_CODE, 1u, RLX_AGENT); __hip_atomic_fetch_add(T.ccnt_() + q, (unsigned)__builtin_popcountll(wv), __ATOMIC_RELAXED, __HIP_MEMORY_SCOPE_WORKGROUP); }
                else *dst = wv; }
            __syncthreads();
            if ((REP_PHASE) == 50 && low) { if (tid < 32 && T.ccnt_()[tid] != (unsigned)TOPK) __hip_atomic_store(F.ctl + CW_CODE, 1u, RLX_AGENT); __syncthreads(); }
        }
    } else {
        for (int idx = tid; idx < 32 * ntile; idx += NWAVES * 64) { const int q = idx & 31, t = idx >> 5;
            const unsigned w0 = (2 * t < nb) ? 0xffffffffu : 0u, w1 = (2 * t + 1 < nb) ? 0xffffffffu : 0u;
            MK[((size_t)b * 128 + t) * SEQ + t0 + q] = (unsigned long long)w0 | ((unsigned long long)w1 << 32); }
        __syncthreads();
    }
}
__device__ __forceinline__ void check_indexer(Frame& F) {
    const int gw = F.vcu * NWAVES + F.wave, lane = F.lane; LAS float* qv = (LAS float*)(F.lds + RING_OFF) + F.wave * 256;
    const bf16* IQ = (const bf16*)(F.ws + WS_IQ); const bf16* IK = (const bf16*)(F.ws + WS_IK); const float* IW = (const float*)(F.ws + WS_IW);
    const unsigned long long* MK = (const unsigned long long*)(F.ws + WS_MASK);
    for (int smp = gw; smp < 2048; smp += F.G * NWAVES) { const int b = smp & 1, t = (smp >> 1) * 8 + 3, c = t >> 6, L = 64 * (c + 1); const size_t tok = (size_t)b * SEQ + t;
#pragma unroll
        for (int i = 0; i < 4; ++i) { const unsigned short v = IQ[tok * 256 + lane * 4 + i]; qv[lane * 4 + i] = __uint_as_float((unsigned)v << 16); }
        LDS_WAIT(); asm volatile("" ::: "memory");
        const float w0 = IW[tok * 4 + 0] * 0.0625f, w1 = IW[tok * 4 + 1] * 0.0625f, w2 = IW[tok * 4 + 2] * 0.0625f, w3 = IW[tok * 4 + 3] * 0.0625f;
        float mins = INFINITY, maxu = -INFINITY; int cnt = 0; bool bad = false;
        for (int s = lane; s < 4 * (c / 4 + 1) * 64; s += 64) { const bool sel = (MK[((size_t)b * 128 + (s >> 6)) * SEQ + t] >> (s & 63)) & 1ull;
            if (s >= L) { bad |= sel; continue; }
            cnt += sel ? 1 : 0;
            if (L <= TOPK) { bad |= !sel; continue; }
            const size_t row = (size_t)b * SEQ + s; const bf16* kb = IK + (row >> 5) * 2048 + (row & 31) * 8; float d[4] = {0.f, 0.f, 0.f, 0.f};
            for (int ch = 0; ch < 8; ++ch) { const v4u kv = *(const GAS v4u*)(kb + (ch >> 1) * 512 + (ch & 1) * 256);
                const float kf[8] = {bflo(kv.x), bfhi(kv.x), bflo(kv.y), bfhi(kv.y), bflo(kv.z), bfhi(kv.z), bflo(kv.w), bfhi(kv.w)};
#pragma unroll
                for (int h = 0; h < 4; ++h)
#pragma unroll
                    for (int j = 0; j < 8; ++j) d[h] = fmaf(qv[h * 64 + ch * 8 + j], kf[j], d[h]); }
            const float sc = w0 * fmaxf(d[0], 0.f) + w1 * fmaxf(d[1], 0.f) + w2 * fmaxf(d[2], 0.f) + w3 * fmaxf(d[3], 0.f);
            if (sel) mins = fminf(mins, sc); else maxu = fmaxf(maxu, sc); }
        for (int o = 1; o < 64; o <<= 1) { mins = fminf(mins, __shfl_xor(mins, o)); maxu = fmaxf(maxu, __shfl_xor(maxu, o)); cnt += __shfl_xor(cnt, o); }
        if (L > TOPK) { bad |= (cnt != TOPK); const float tol = 2e-4f * (fabsf(mins) + fabsf(maxu)) + 1e-7f; bad |= (maxu > mins + tol); } else bad |= (cnt != L);
        if (__any(bad) && lane == 0) __hip_atomic_store(F.ctl + CW_CODE, 1u, RLX_AGENT);
        LDS_WAIT(); asm volatile("" ::: "memory");
    }
}
__device__ __forceinline__ void check_attention(Frame& F) {
    const int gw = F.vcu * NWAVES + F.wave, lane = F.lane;
    const bf16* Q = (const bf16*)(F.ws + WS_Q); const bf16* K = (const bf16*)(F.ws + WS_K); const bf16* V = (const bf16*)(F.ws + WS_V); const bf16* YA = (const bf16*)(F.ws + WS_YAP);
    const unsigned long long* MK = (const unsigned long long*)(F.ws + WS_MASK);
    for (int smp = gw; smp < 4096; smp += F.G * NWAVES) { const int b = smp & 1, h = (smp >> 1) & 7, t = (smp >> 4) * 32 + ((smp * 7) & 31), c = t >> 6; const size_t tok = (size_t)b * SEQ + t;
        const float q = __uint_as_float((unsigned)Q[tok * 512 + h * 64 + lane] << 16); float l = 0.f, o = 0.f;
        for (int tt = 0; tt < 4 * (c / 4 + 1); ++tt) { unsigned long long m = MK[((size_t)b * 128 + tt) * SEQ + t];
            while (m) { const int s = tt * 64 + (int)__builtin_ctzll(m); m &= m - 1; const size_t row = (size_t)b * SEQ + s;
                const float kd = __uint_as_float((unsigned)K[row * 512 + h * 64 + lane] << 16), vd = __uint_as_float((unsigned)V[row * 512 + h * 64 + lane] << 16);
                const float p = __builtin_amdgcn_exp2f(wave_sum(q * kd)); l += p; o = fmaf(p, vd, o); } }
        const float ref = o / l, got = __uint_as_float((unsigned)YA[tok * 512 + h * 64 + lane] << 16); const float scale = wave_max(fabsf(ref));
        const bool bad = !(fabsf(got - ref) <= 0.03f * scale + 1e-4f);
        if (__any(bad) && lane == 0) __hip_atomic_store(F.ctl + CW_CODE, 1u, RLX_AGENT);
    }
}
typedef float f32x16r __attribute__((ext_vector_type(16)));
__device__ __forceinline__ void router_phase(Frame& F, bool dry = false) {
    LAS float* tab = (LAS float*)(F.lds + RING_OFF);
    LAS float* xch = (LAS float*)(F.lds + RING_OFF + 131072);
    LAS float* ssq = (LAS float*)(F.lds + XTRA_OFF);
    LAS float* rs = ssq + 512;
    LAS unsigned* lc = (LAS unsigned*)(rs + 64);
    LAS unsigned* basep = lc + 32;
    LAS unsigned* rec_e = basep + 32; LAS unsigned* rec_r = rec_e + 256; LAS float* rec_w = (LAS float*)(rec_r + 256);
    const int tid = F.tid, lane = F.lane, wave = F.wave, m32 = lane & 31, kh = lane >> 5, tile = wave >> 2, kq = wave & 3;
    const float* x1 = F.out; const float* g2 = F.in[11]; const float* rw = F.in[12]; const float* rb = F.in[13];
    bf16* H2 = (bf16*)(F.ws + WS_H2); int* TOKE = (int*)(F.ws + WS_TOKE); int* TOKP = TOKE + M * 4; float* TOKW = (float*)(TOKP + M * 4);
    for (int i0 = tid; i0 < 1024 * 8; i0 += 4 * NWAVES * 64) { f32x4 v[4]; float g[4];
#pragma unroll
        for (int u = 0; u < 4; ++u) { const int i = i0 + u * NWAVES * 64; v[u] = *(const GAS f32x4*)(rw + (size_t)(i >> 3) * 32 + 4 * (i & 7)); g[u] = g2[i >> 3]; }
#pragma unroll
        for (int u = 0; u < 4; ++u) { const int i = i0 + u * NWAVES * 64, k = i >> 3, n0 = 4 * (i & 7); LAS float* d = tab + ((k >> 2) * 32 + n0) * 4 + (k & 3);
            d[0] = v[u].x * g[u]; d[4] = v[u].y * g[u]; d[8] = v[u].z * g[u]; d[12] = v[u].w * g[u]; } }
    if (tid < 32) lc[tid] = 0u;
    __syncthreads();
    for (int tb = blockIdx.x; tb < M / 64; tb += F.G) {
        {
            const size_t tok = (size_t)tb * 64 + tile * 32 + m32; const GAS f32x4* xr = (const GAS f32x4*)(x1 + tok * 1024) + 64 * kq + kh;
            const LAS f32x4* br = (const LAS f32x4*)tab + (size_t)(64 * kq + kh) * 32 + m32;
            f32x16r acc = {}; float ss = 0.f;
#pragma unroll 1
            for (int j0 = 0; j0 < 32; j0 += 8) { f32x4 xv[8];
#pragma unroll
                for (int u = 0; u < 8; ++u) xv[u] = xr[2 * (j0 + u)];
#pragma unroll
                for (int u = 0; u < 8; ++u) { const f32x4 bv = br[2 * (j0 + u) * 32]; const f32x4 x4 = xv[u];
                    ss += (x4.x * x4.x + x4.y * x4.y) + (x4.z * x4.z + x4.w * x4.w);
                    acc = __builtin_amdgcn_mfma_f32_32x32x2f32(x4.x, bv.x, acc, 0, 0, 0); acc = __builtin_amdgcn_mfma_f32_32x32x2f32(x4.y, bv.y, acc, 0, 0, 0);
                    acc = __builtin_amdgcn_mfma_f32_32x32x2f32(x4.z, bv.z, acc, 0, 0, 0); acc = __builtin_amdgcn_mfma_f32_32x32x2f32(x4.w, bv.w, acc, 0, 0, 0); } }
            ssq[(tile * 4 + kq) * 64 + lane] = ss;
            LAS float* xw = xch + ((tile * 2 + (kq >> 1)) * 16) * 64 + lane;
            if (kq & 1) {
#pragma unroll
                for (int r = 0; r < 16; ++r) xw[r * 64] = acc[r]; }
            __syncthreads();
            if (!(kq & 1)) {
#pragma unroll
                for (int r = 0; r < 16; ++r) acc[r] += xw[r * 64]; }
            if (tid < 64) { float q = 0.f;
#pragma unroll
                for (int u = 0; u < 4; ++u) q += ssq[((tid >> 5) * 4 + u) * 64 + (tid & 31)] + ssq[((tid >> 5) * 4 + u) * 64 + 32 + (tid & 31)];
                rs[tid] = 1.0f / sqrtf(q * (1.f / 1024.f) + EPS); }
            __syncthreads();
            LAS float* xw2 = xch + ((tile * 2) * 16) * 64 + lane;
            if (kq == 2) {
#pragma unroll
                for (int r = 0; r < 16; ++r) xw2[r * 64] = acc[r]; }
            __syncthreads();
            if (kq == 0) {
#pragma unroll
                for (int r = 0; r < 16; ++r) acc[r] += xw2[r * 64]; }
            __syncthreads();
            if (kq == 0) { const float bias = rb[m32];
#pragma unroll
                for (int r = 0; r < 16; ++r) { const int tk = (r & 3) + 8 * (r >> 2) + 4 * kh; xch[(tile * 32 + tk) * 33 + m32] = acc[r] * rs[tile * 32 + tk] + bias; } }
            __syncthreads();
        }
        if (tid < 64) {
            const LAS float* lg = xch + tid * 33; float bv[4] = {-INFINITY, -INFINITY, -INFINITY, -INFINITY}; int be[4] = {0, 0, 0, 0};
#pragma unroll
            for (int n = 0; n < 32; ++n) { float v = lg[n]; int e = n;
#pragma unroll
                for (int s2 = 0; s2 < 4; ++s2) { if (v > bv[s2]) { const float tv = bv[s2]; const int te = be[s2]; bv[s2] = v; be[s2] = e; v = tv; e = te; } } }
            const float p1 = __expf(bv[1] - bv[0]), p2 = __expf(bv[2] - bv[0]), p3 = __expf(bv[3] - bv[0]); const float inv = 1.0f / (1.0f + p1 + p2 + p3);
            const float pw[4] = {inv, p1 * inv, p2 * inv, p3 * inv};
            if (!dry) {
#pragma unroll
            for (int s2 = 0; s2 < 4; ++s2) { const unsigned rk = __hip_atomic_fetch_add(lc + be[s2], 1u, __ATOMIC_RELAXED, __HIP_MEMORY_SCOPE_WORKGROUP);
                rec_e[tid * 4 + s2] = (unsigned)be[s2]; rec_r[tid * 4 + s2] = rk; rec_w[tid * 4 + s2] = pw[s2]; } }
        }
        { const GAS f32x4* gr = (const GAS f32x4*)g2 + lane; f32x4 gv[4];
#pragma unroll
          for (int j = 0; j < 4; ++j) gv[j] = gr[64 * j];
          for (int h = 0; h < 2; ++h) { f32x4 v[4][4];
#pragma unroll
            for (int u = 0; u < 4; ++u) { const size_t t = (size_t)tb * 64 + wave * 8 + h * 4 + u; const GAS f32x4* xr = (const GAS f32x4*)(x1 + t * 1024) + lane;
#pragma unroll
                for (int j = 0; j < 4; ++j) v[u][j] = xr[64 * j]; }
#pragma unroll
            for (int u = 0; u < 4; ++u) { const int tl = wave * 8 + h * 4 + u; const size_t t = (size_t)tb * 64 + tl; const float r = rs[tl]; GAS unsigned long long* o8 = (GAS unsigned long long*)(H2 + t * 1024) + lane;
#pragma unroll
                for (int j = 0; j < 4; ++j) { const f32x4 y = v[u][j] * r * gv[j]; o8[64 * j] = (unsigned long long)pk2(y.x, y.y) | ((unsigned long long)pk2(y.z, y.w) << 32); } } } }
        __syncthreads();
        if (tid < 32) basep[tid] = __hip_atomic_fetch_add(F.ctl + CW_CNT + tid, lc[tid], RLX_AGENT);
        __syncthreads();
        if (tid < 256 && !dry) { const size_t p = (size_t)tb * 256 + tid; const unsigned me = rec_e[tid]; TOKE[p] = (int)me; TOKP[p] = (int)(basep[me] + rec_r[tid]); TOKW[p] = rec_w[tid]; }
        __syncthreads();
        if (tid < 32) lc[tid] = 0u;
        __syncthreads();
    }
}
__device__ __forceinline__ void moe_tables(Frame& F, LAS unsigned*& tpre, LAS unsigned*& cntl) {
    cntl = (LAS unsigned*)(F.lds + XTRA_OFF + 8192); tpre = cntl + 32;
    if (F.tid < 32) cntl[F.tid] = __hip_atomic_load(F.ctl + CW_CNT + F.tid, RLX_AGENT);
    __syncthreads();
    if (F.tid == 0) { unsigned a = 0u; for (int e = 0; e < 32; ++e) { tpre[e] = a; a += (cntl[e] + 255u) >> 8; } tpre[32] = a; }
    __syncthreads();
}
__device__ __forceinline__ LAS unsigned* moe_build_units(Frame& F, const LAS unsigned* tpre, int NT) {
    LAS unsigned* list = (LAS unsigned*)(F.lds + XTRA_OFF + 8192 + 512);
    if (F.tid < 24) { unsigned w = 0xffffffffu; const int U = (int)tpre[32] * NT; const long Lg = (long)F.tid * F.G + blockIdx.x;
        if (F.tid < 20 && Lg < U) { int wg = (int)Lg; { const int q = U / 8, r = U % 8, xcd = wg % 8, off = wg / 8; wg = (xcd < r ? xcd * (q + 1) : r * (q + 1) + (xcd - r) * q) + off; }
            int e = 0; while (e < 31 && wg >= (int)tpre[e + 1] * NT) ++e;
            const int rr = wg - (int)tpre[e] * NT, mt = (int)(tpre[e + 1] - tpre[e]); const int n = rr / mt, m = rr % mt;
            w = (unsigned)(tpre[e] + m) | ((unsigned)(e * NT + n) << 16); }
        list[F.tid] = w; }
    __syncthreads();
    return list;
}
__device__ __forceinline__ void gather_phase(Frame& F) {
    LAS unsigned* tpre; LAS unsigned* cntl; moe_tables(F, tpre, cntl);
    const int gw = F.vcu * NWAVES + F.wave, NGW = F.G * NWAVES, lane = F.lane;
    const bf16* H2 = (const bf16*)(F.ws + WS_H2); bf16* XP = (bf16*)(F.ws + WS_XP); float* ROWW = (float*)(F.ws + WS_ROWW);
    const int* TOKE = (const int*)(F.ws + WS_TOKE); const int* TOKP = TOKE + M * 4; const float* TOKW = (const float*)(TOKP + M * 4); int* TOKR = (int*)(TOKW + M * 4);
    for (int p0 = gw * 32; p0 < M * 4; p0 += NGW * 32) {
        const int p = p0 + (lane & 31); const int e = TOKE[p]; const int myrow = (int)tpre[e] * 256 + TOKP[p];
        if (lane < 32) { TOKR[p] = myrow; ROWW[myrow] = TOKW[p]; }
        for (int i = 0; i < 32; i += 4) { v4u a[4], bq[4]; int rw[4];
#pragma unroll
            for (int u = 0; u < 4; ++u) { rw[u] = __builtin_amdgcn_readlane(myrow, i + u); const GAS v4u* src = (const GAS v4u*)(H2 + (size_t)((p0 + i + u) >> 2) * 1024); a[u] = src[lane]; bq[u] = src[lane + 64]; }
#pragma unroll
            for (int u = 0; u < 4; ++u) { GAS v4u* dst = (GAS v4u*)(XP + (size_t)rw[u] * 1024); dst[lane] = a[u]; dst[lane + 64] = bq[u]; } }
    }
    for (int i = gw; i < 32 * 256; i += NGW) { const int e = i >> 8; const int row = (int)tpre[e] * 256 + (int)cntl[e] + (i & 255);
        if (row < (int)tpre[e + 1] * 256) { GAS v4u* dst = (GAS v4u*)(XP + (size_t)row * 1024); dst[lane] = (v4u){0u, 0u, 0u, 0u}; dst[lane + 64] = (v4u){0u, 0u, 0u, 0u}; if (lane == 0) ROWW[row] = 0.f; } }
}
__device__ __forceinline__ void combine_phase(Frame& F, bool dry = false) {
    const int gw = F.vcu * NWAVES + F.wave, NGW = F.G * NWAVES, lane = F.lane;
    const bf16* Y = (const bf16*)(F.ws + WS_XP); const int* TOKR = (const int*)(F.ws + WS_TOKE) + 3 * M * 4;
    const bool poison = ((REP_PHASE) == 50 || (REP_PHASE) == 51 || (REP_PHASE) == 52 || (REP_PHASE) == 53) && __hip_atomic_load(F.ctl + CW_CODE, RLX_AGENT) != 0u;
    for (int t0 = gw; t0 < M; t0 += 2 * NGW) {
        GAS f32x4* o[2]; f32x4 v[2][4]; v2u y[2][4][4]; int row[2][4];
#pragma unroll
        for (int u = 0; u < 2; ++u) { const int t = t0 + u * NGW; o[u] = (GAS f32x4*)(F.out + (size_t)t * 1024) + lane;
#pragma unroll
            for (int s = 0; s < 4; ++s) row[u][s] = TOKR[t * 4 + s]; }
#pragma unroll
        for (int u = 0; u < 2; ++u) {
#pragma unroll
            for (int j = 0; j < 4; ++j) v[u][j] = o[u][64 * j];
#pragma unroll
            for (int s = 0; s < 4; ++s) { const GAS v2u* yp = (const GAS v2u*)(Y + (size_t)row[u][s] * 1024) + lane;
#pragma unroll
                for (int j = 0; j < 4; ++j) y[u][s][j] = yp[64 * j]; } }
#pragma unroll
        for (int u = 0; u < 2; ++u) { const f32x4 v0[4] = {v[u][0], v[u][1], v[u][2], v[u][3]};
#pragma unroll
            for (int s = 0; s < 4; ++s)
#pragma unroll
                for (int j = 0; j < 4; ++j) { v[u][j].x += bflo(y[u][s][j].x); v[u][j].y += bfhi(y[u][s][j].x); v[u][j].z += bflo(y[u][s][j].y); v[u][j].w += bfhi(y[u][s][j].y); }
#pragma unroll
            for (int j = 0; j < 4; ++j) o[u][64 * j] = poison ? (f32x4){__builtin_nanf(""), __builtin_nanf(""), __builtin_nanf(""), __builtin_nanf("")} : ((dry && v[u][j].x == v[u][j].x) ? v0[j] : v[u][j]); }
    }
}
struct Args { const float* in[18]; float* out; unsigned char* ws; int ph_lo, ph_hi; };
static_assert(sizeof(Args) == 18 * 8 + 8 + 8 + 8, "Args has no padding bytes");
__global__ void __launch_bounds__(NWAVES * 64, 2) mk_fwd(Args args) {
    extern __shared__ __attribute__((aligned(16))) unsigned char lds[];
    Frame F;
    F.lds = (LAS unsigned char*)lds;
    F.MISC = (volatile LAS unsigned*)(F.lds + MISC_OFF);
    F.tid = threadIdx.x; F.lane = F.tid & 63; F.wave = __builtin_amdgcn_readfirstlane(F.tid >> 6);
    F.G = gridDim.x; { const int bx = blockIdx.x; F.vcu = (F.G % 8 == 0) ? (bx % 8) * (F.G / 8) + bx / 8 : bx; }
    F.ws = args.ws; F.ctl = (gu32*)(args.ws + WS_CTL); F.out = args.out;
#pragma unroll
    for (int i = 0; i < 18; ++i) F.in[i] = args.in[i];
    for (int u = F.tid; u < (LDS_BYTES - LDSCTL_OFF) / 4; u += NWAVES * 64) ((LAS unsigned*)(F.lds + LDSCTL_OFF))[u] = 0u;
    __syncthreads();
    XcdBarrier bar; bar.bar = (unsigned*)(F.ctl + CW_BAR); bar.x = 0; bar.st = nullptr;
    if (!MK_SPLIT) bar = xcd_barrier_post((unsigned*)(F.ctl + CW_BAR), F.MISC + 8);
#define GRID_BAR() do { if (MK_SPLIT) { if (F.tid == 0) __hip_atomic_store(F.ctl + CW_TMO, 0xBADBA0u, RLX_AGENT); } else { xcd_barrier(bar); if ((REP_PHASE) == 40) xcd_barrier(bar); } } while (0)
    const int lo = args.ph_lo, hi = args.ph_hi;
#define IN(k) (lo <= (k) && (k) < hi)
#define BOTH(k) (IN(k) && IN((k) + 1))
    constexpr bool AL = true, SP = true;
#ifndef REP_PHASE
#define REP_PHASE -1
#endif
#define REPS(k) for (int rep_ = 0; rep_ < ((REP_PHASE) == (k) ? 2 : 1); ++rep_)
    if (IN(0)) { REPS(0) p0_prologue(F); if (BOTH(0)) GRID_BAR(); }
    if (IN(1)) {
        pg8::Gemm g{(const bf16*)(F.ws + WS_H), (const bf16*)(F.ws + WS_WIN), M, NINP, DMODEL}; pg8::StaticOrder S; S.init(M, NINP, F.G, (int)blockIdx.x);
        pg8::EpiInProj E{F.ws};
        REPS(1) pg8::gemm_phase<pg8::EpiInProj, pg8::StaticOrder, AL, SP>(F.lds + RING_OFF, g, S, E);
        if (BOTH(1)) GRID_BAR();
    }
    if (IN(2)) {
        if ((REP_PHASE) == 32) qknorm_rows(F, true);
        qknorm_rows(F); REPS(30) pool_diff_rows(F);
        REPS(2) for (int v = F.vcu; v < 256; v += F.G) { const int b = v >> 7, half = (v >> 6) & 1, cc = v & 63; for (int k = 0; k < ((REP_PHASE) == 24 ? 3 : (REP_PHASE) == 25 ? 4 : 2); ++k) topk_unit(F, b, k >= 2 ? 4 : (k ? cc : 127 - cc), half); }
        if (BOTH(2)) GRID_BAR();
    }
    if (IN(3)) {
        { pg8::Gemm g{(const bf16*)(F.ws + WS_DIFF), (const bf16*)(F.ws + WS_WPOOL), M, DPOOL, DPOOL}; pg8::StaticOrder S; S.init(M, DPOOL, F.G, (int)blockIdx.x);
          pg8::EpiPool E{(bf16*)(F.ws + WS_YAP + 16 * MiB), F.in[6], F.in[7]};
          REPS(31) pg8::gemm_phase<pg8::EpiPool, pg8::StaticOrder, AL, SP>(F.lds + RING_OFF, g, S, E); }
        const float cshift = attn_body::C2 * 64.0f * wave_max(fabsf(F.in[3][F.lane])) * wave_max(fabsf(F.in[4][F.lane]));
        REPS(3) for (int v = F.vcu; v < 256; v += F.G) { const int bh = v >> 4, s = v & 15;
            for (int i = 0; i < 2; ++i) attn_body::attn_unit(bh >> 3, bh & 7, i == 0 ? 31 - s : s, (const attn_body::bf16*)(F.ws + WS_Q), (const attn_body::bf16*)(F.ws + WS_K), (const attn_body::bf16*)(F.ws + WS_V),
                                                             (attn_body::bf16*)(F.ws + WS_YAP), (const unsigned long long*)(F.ws + WS_MASK), cshift, (char*)lds + RING_OFF); }
        if (BOTH(3)) GRID_BAR();
    }
    if (IN(4)) {
        if ((REP_PHASE) == 52) { check_attention(F); __syncthreads(); }
        if ((REP_PHASE) == 53) { check_indexer(F); __syncthreads(); }
        pg8::StaticOrder S; S.init(M, DMODEL, F.G, (int)blockIdx.x);
        { pg8::Gemm g{(const bf16*)(F.ws + WS_YAP), (const bf16*)(F.ws + WS_WAB), M, DMODEL, 512};
          pg8::EpiGate E{(const bf16*)(F.ws + WS_GA), nullptr, (bf16*)(F.ws + WS_TMP)};
          pg8::gemm_phase<pg8::EpiGate, pg8::StaticOrder, AL, SP>(F.lds + RING_OFF, g, S, E); }
        { pg8::Gemm g{(const bf16*)(F.ws + WS_YAP + 16 * MiB), (const bf16*)(F.ws + WS_WAB + 1 * MiB), M, DMODEL, 512};
          pg8::EpiGate E{(const bf16*)(F.ws + WS_GB), (const bf16*)(F.ws + WS_TMP), (bf16*)(F.ws + WS_MERGED)};
          pg8::gemm_phase<pg8::EpiGate, pg8::StaticOrder, AL, SP>(F.lds + RING_OFF, g, S, E); }
        if (BOTH(4)) GRID_BAR();
    }
    if (IN(5)) {
        pg8::Gemm g{(const bf16*)(F.ws + WS_MERGED), (const bf16*)(F.ws + WS_WOUT), M, DMODEL, DMODEL}; pg8::StaticOrder S; S.init(M, DMODEL, F.G, (int)blockIdx.x);
        pg8::EpiResF32 E{F.in[0], F.out};
        REPS(5) pg8::gemm_phase<pg8::EpiResF32, pg8::StaticOrder, AL, SP>(F.lds + RING_OFF, g, S, E);
        if (BOTH(5)) GRID_BAR();
    }
    if (IN(6)) { if ((REP_PHASE) == 6) router_phase(F, true); router_phase(F); if (BOTH(6)) GRID_BAR(); }
    if (IN(7)) { REPS(7) gather_phase(F); if (BOTH(7)) GRID_BAR(); }
    if (IN(8)) {
        LAS unsigned* tpre; LAS unsigned* cntl; moe_tables(F, tpre, cntl);
        pg8::ListOrder S{moe_build_units(F, tpre, 8)};
        pg8::Gemm g{(const bf16*)(F.ws + WS_XP), (const bf16*)(F.ws + WS_W1), MPAD, NEXP * 2048, DMODEL};
        pg8::EpiSwiglu E{F.in[15], (bf16*)(F.ws + WS_ACT)};
        REPS(8) pg8::gemm_phase<pg8::EpiSwiglu, pg8::ListOrder, AL, SP>(F.lds + RING_OFF, g, S, E);
        if (BOTH(8)) GRID_BAR();
    }
    if (IN(9)) {
        LAS unsigned* tpre; LAS unsigned* cntl; moe_tables(F, tpre, cntl);
        pg8::ListOrder S{moe_build_units(F, tpre, 4)};
        pg8::Gemm g{(const bf16*)(F.ws + WS_ACT), (const bf16*)(F.ws + WS_W2), MPAD, NEXP * 1024, DEXP};
        pg8::EpiDown E{F.in[17], (const float*)(F.ws + WS_ROWW), (bf16*)(F.ws + WS_XP)};
        REPS(9) pg8::gemm_phase<pg8::EpiDown, pg8::ListOrder, AL, SP>(F.lds + RING_OFF, g, S, E);
        if (BOTH(9)) GRID_BAR();
    }
    if (IN(2) && (REP_PHASE) == 51 && blockIdx.x == 3 && F.tid == 0) __hip_atomic_store(F.ctl + CW_CODE, 1u, RLX_AGENT);
    if (IN(10)) { if ((REP_PHASE) == 10) combine_phase(F, true); combine_phase(F); }
#undef IN
#undef BOTH
}

extern "C" void kernel_launch(void* const* d_in, const int* in_sizes, int n_in, void* d_out, int out_size, void* d_ws, size_t ws_size, hipStream_t stream) {
    static int grid = 0;
    if (grid == 0) {
        if (n_in != 18 || in_sizes[0] != M * DMODEL || out_size != M * DMODEL || ws_size < WS_END) { fprintf(stderr, "kernel_launch: built for 18 inputs, x/out of %d floats, >= %zu bytes of workspace; got n_in %d, in0 %d, out %d, ws %zu; nothing launched\n", M * DMODEL, (size_t)WS_END, n_in, n_in > 0 ? in_sizes[0] : -1, out_size, ws_size); grid = -1; return; }
        int dev = 0, cus = 0, per_cu = 0;
        if (hipGetDevice(&dev) != hipSuccess || hipDeviceGetAttribute(&cus, hipDeviceAttributeMultiprocessorCount, dev) != hipSuccess) { fprintf(stderr, "kernel_launch: hipGetDevice / hipDeviceGetAttribute failed; nothing launched\n"); grid = -1; return; }
        if (hipFuncSetAttribute((const void*)mk_fwd, hipFuncAttributeMaxDynamicSharedMemorySize, LDS_BYTES) != hipSuccess) { fprintf(stderr, "kernel_launch: hipFuncSetAttribute failed; nothing launched\n"); grid = -1; return; }
        if (hipOccupancyMaxActiveBlocksPerMultiprocessor(&per_cu, (const void*)mk_fwd, NWAVES * 64, LDS_BYTES) != hipSuccess || per_cu < 1) { fprintf(stderr, "kernel_launch: occupancy query reports %d workgroups per CU; nothing launched\n", per_cu); (void)hipGetLastError(); grid = -1; return; }
        (void)hipGetLastError();
        grid = cus;
    }
    if (grid < 0) return;
    if (hipMemsetAsync((char*)d_ws + WS_CTL, 0, CTL_ZERO_BYTES, stream) != hipSuccess) { fprintf(stderr, "kernel_launch: hipMemsetAsync of the control words failed; nothing launched\n"); return; }
    Args a{};
    for (int i = 0; i < 18; ++i) a.in[i] = (const float*)d_in[i];
    a.out = (float*)d_out; a.ws = (unsigned char*)d_ws;
    const int nl = MK_SPLIT ? N_PHASES : 1;
    for (int li = 0; li < nl; ++li) {
        a.ph_lo = MK_SPLIT ? li : 0; a.ph_hi = MK_SPLIT ? li + 1 : N_PHASES;
        hipLaunchKernelGGL(mk_fwd, dim3(grid), dim3(NWAVES * 64), LDS_BYTES, stream, a);
        const hipError_t le = hipPeekAtLastError();
        if (le != hipSuccess) { fprintf(stderr, "kernel_launch: launch %d failed: %s (grid %d x %d threads, %d B LDS)\n", li, hipGetErrorName(le), grid, NWAVES * 64, LDS_BYTES); break; }
    }
}
```

```cpp
#define MK_SPLIT 0
#include <hip/hip_runtime.h>
#include <hip/hip_bf16.h>
#include <cstdio>
#include <cstdint>
#include <cmath>
constexpr int NWAVES = 8;
#ifndef MK_SPLIT
#define MK_SPLIT 0
#endif
constexpr int N_PHASES = 11;
#ifndef REP_PHASE
#define REP_PHASE -1
#endif

constexpr int BATCH = 2, SEQ = 8192, DMODEL = 1024, M = BATCH * SEQ;
constexpr int DATT = 512, HD = 64, NH = 8, NIH = 4, IDIM = 64, TOPK = 256, DPOOL = 512, NEXP = 32, TOPE = 4, DEXP = 1024;
constexpr int NIN = 4420;
constexpr int NINP = 4608;
constexpr float EPS = 1e-6f;
constexpr int MP_TILES = 288, MPAD = MP_TILES * 256;

constexpr size_t MiB = 1u << 20;
constexpr size_t WS_CTL = 0, CTL_ZERO_BYTES = 1 * MiB;
constexpr size_t WS_WIN = 2 * MiB;
constexpr size_t WS_WAB = 12 * MiB;
constexpr size_t WS_WOUT = 16 * MiB;
constexpr size_t WS_WPOOL = 18 * MiB;
constexpr size_t WS_W1 = 20 * MiB;
constexpr size_t WS_W2 = 148 * MiB;
constexpr size_t WS_H = 212 * MiB;
constexpr size_t WS_Q = 244 * MiB, WS_K = 260 * MiB, WS_V = 276 * MiB;
constexpr size_t WS_IQ = 292 * MiB;
constexpr size_t WS_IK = 300 * MiB;
constexpr size_t WS_IW = 302 * MiB;
constexpr size_t WS_U = 303 * MiB;
constexpr size_t WS_DIFF = 319 * MiB;
constexpr size_t WS_GA = 335 * MiB, WS_GB = 367 * MiB;
constexpr size_t WS_MASK = 399 * MiB;
constexpr size_t WS_YAP = 415 * MiB;
constexpr size_t WS_MERGED = 447 * MiB;
constexpr size_t WS_H2 = 479 * MiB;
constexpr size_t WS_TOKE = 511 * MiB;
constexpr size_t WS_ROWW = 512 * MiB;
constexpr size_t WS_XP = 514 * MiB;
constexpr size_t WS_ACT = 658 * MiB;
constexpr size_t WS_TMP = 802 * MiB;
constexpr size_t WS_END = 834 * MiB;

constexpr int CW_TMO = 0, CW_CODE = 1;
constexpr int CW_CNT = 64;
constexpr int CW_BAR = 4096;
constexpr int CW_MOE = 8192;

constexpr int RING_OFF = 0, RING_BYTES = 147456;
constexpr int LDSCTL_OFF = RING_BYTES, MISC_OFF = LDSCTL_OFF + 320;
constexpr int XTRA_OFF = LDSCTL_OFF + 1024;
constexpr int LDS_BYTES = 163840;
static_assert(XTRA_OFF + 14336 <= LDS_BYTES, "LDS map");

#define GAS __attribute__((address_space(1)))
#define LAS __attribute__((address_space(3)))
typedef unsigned short bf16;
typedef unsigned v4u __attribute__((ext_vector_type(4)));
typedef unsigned v2u __attribute__((ext_vector_type(2)));
typedef float f32x4 __attribute__((ext_vector_type(4)));
typedef short bf16x8 __attribute__((ext_vector_type(8)));
typedef float f32x16 __attribute__((ext_vector_type(16)));
typedef GAS unsigned gu32;
#define RLX_AGENT __ATOMIC_RELAXED, __HIP_MEMORY_SCOPE_AGENT
#define LDS_WAIT() asm volatile("s_waitcnt lgkmcnt(0)" ::: "memory")
#define VM_WAIT() asm volatile("s_waitcnt vmcnt(0)" ::: "memory")
__device__ __forceinline__ unsigned f2bf(float f) { unsigned u = __builtin_bit_cast(unsigned, f); return (u + 0x7fffu + ((u >> 16) & 1u)) >> 16; }
__device__ __forceinline__ unsigned pk2(float lo, float hi) { return f2bf(lo) | (f2bf(hi) << 16); }
__device__ __forceinline__ float bflo(unsigned w) { return __uint_as_float(w << 16); }
__device__ __forceinline__ float bfhi(unsigned w) { return __uint_as_float(w & 0xffff0000u); }
namespace pg8 {
#define PG8_LAS __attribute__((address_space(3)))
typedef unsigned short bf16_t;
typedef short bf16x8 __attribute__((ext_vector_type(8)));
typedef float f32x4 __attribute__((ext_vector_type(4)));
typedef unsigned u32x4 __attribute__((ext_vector_type(4)));
constexpr int BM = 256, BK = 64, HALF = 128, HTB = HALF * BK * 2  , STAGE_BYTES = 8 * HTB, NXCD = 8, WGM = 8;

__host__ __device__ __forceinline__ int lds_byte(int r, int c) { const int st = (r >> 4) * 2 + (c >> 5), rr = r & 15, cc = c & 31, ob = rr * 64 + cc * 2; return st * 1024 + (ob ^ (((ob >> 9) & 1) << 5)); }
__host__ __device__ __forceinline__ void stage_rc(int b, int& R, int& C) { const int st = b / 1024, sb = b % 1024, swz = sb ^ (((sb >> 9) & 1) << 5); R = (st >> 1) * 16 + swz / 64; C = (st & 1) * 32 + (swz % 64) / 2; }
__host__ __device__ __forceinline__ int perm32(int rho) { const int n = rho >> 4, i = rho & 15; return 8 * (i >> 2) + 4 * n + (i & 3); }

struct Unit { int pm, pn; };
struct Gemm { const bf16_t* A; const bf16_t* Bt; int M, N, K; };

struct StaticOrder {
    int nM, nN, nwg, G, c;
    __host__ __device__ void init(int M, int N, int G_, int c_) { nM = M / BM; nN = N / BM; nwg = nM * nN; G = G_; c = c_; }
    __host__ __device__ bool next(int i, Unit& u) const {
        const long L = (long)i * G + c; if (L >= nwg) return false;
        int wgid = (int)L; { const int q = nwg / NXCD, r = nwg % NXCD, xcd = wgid % NXCD, off = wgid / NXCD; wgid = (xcd < r ? xcd * (q + 1) : r * (q + 1) + (xcd - r) * q) + off; }
        const int nig = WGM * nN, gid = wgid / nig, fm = gid * WGM, gsz = (nM - fm) < WGM ? (nM - fm) : WGM;
        u.pm = fm + ((wgid % nig) % gsz); u.pn = (wgid % nig) / gsz; return true;
    }
    __device__ __forceinline__ void a_ready(const Unit&) const {}
    __device__ __forceinline__ void done(const Unit&) const {}
    __device__ __forceinline__ const char* abase(const Gemm& g, const Unit& u, size_t tstep) const { return (const char*)g.A + (size_t)u.pm * tstep; }
    __device__ __forceinline__ const char* bbase(const Gemm& g, const Unit& u, size_t tstep) const { return (const char*)g.Bt + (size_t)u.pn * tstep; }
};
__device__ __forceinline__ unsigned cvt_pk_bf16(float lo, float hi) { unsigned r; asm volatile("v_cvt_pk_bf16_f32 %0, %1, %2" : "=v"(r) : "v"(lo), "v"(hi)); return r; }
typedef float f32x2 __attribute__((ext_vector_type(2)));
typedef unsigned u32x2 __attribute__((ext_vector_type(2)));
__device__ __forceinline__ float sigmoidf_fast(float x) { return __builtin_amdgcn_rcpf(1.0f + __builtin_amdgcn_exp2f(-1.4426950408889634f * x)); }
__device__ __forceinline__ float bf_lo(unsigned w) { return __uint_as_float(w << 16); }
__device__ __forceinline__ float bf_hi(unsigned w) { return __uint_as_float(w & 0xffff0000u); }

struct EpiInProj {
    static constexpr bool PERM = true, AFTER_DRAIN = false;
    unsigned char* ws;
    static constexpr unsigned oq = (unsigned)WS_Q, ok = (unsigned)WS_K, ov = (unsigned)WS_V, oiq = (unsigned)WS_IQ, oik = (unsigned)WS_IK, ou = (unsigned)WS_U, oga = (unsigned)WS_GA, ogb = (unsigned)WS_GB, oiw = (unsigned)WS_IW;
    __device__ __forceinline__ void operator()(const f32x4 (&acc)[2][2][4][2], const Unit& un, int wr, int wc, int fr, int fq) const {
        const int pn = un.pn, row0 = un.pm * BM + wr * 64 + fr;
        if (pn == 7) {
#pragma unroll
            for (int ai = 0; ai < 2; ++ai)
#pragma unroll
                for (int m = 0; m < 4; ++m) { const size_t row = (size_t)(row0 + ai * HALF + m * 16);
                    const f32x4 v0 = acc[ai][0][m][0], v1 = acc[ai][0][m][1];
                    if (wc < 2) { u32x4 w; w.x = cvt_pk_bf16(v0[0], v0[1]); w.y = cvt_pk_bf16(v0[2], v0[3]); w.z = cvt_pk_bf16(v1[0], v1[1]); w.w = cvt_pk_bf16(v1[2], v1[3]);
                        *(u32x4*)((bf16_t*)(ws + oik) + (row >> 5) * 2048 + (2 * wc + (fq >> 1)) * 512 + ((fq & 1) * 32 + (row & 31)) * 8) = w; }
                    else if (wc == 2 && fq == 0) { *(f32x4*)((float*)(ws + oiw) + row * 4) = v0; } }
            return;
        }
        unsigned boff; int ldc, colt; bool sig = false;
        if (pn < 6) { boff = pn < 2 ? oq : (pn < 4 ? ok : ov); ldc = 512; colt = (pn & 1) * 256; }
        else if (pn == 6) { boff = oiq; ldc = 256; colt = 0; }
        else if (pn < 10) { boff = ou; ldc = 512; colt = (pn - 8) * 256; }
        else { sig = true; boff = pn < 14 ? oga : ogb; ldc = 1024; colt = ((pn - 10) & 3) * 256; }
        bf16_t* base = (bf16_t*)(ws + boff);
        const int col0 = colt + wc * 32 + 8 * fq;
#pragma unroll
        for (int ai = 0; ai < 2; ++ai)
#pragma unroll
            for (int m = 0; m < 4; ++m) { bf16_t* rowp = base + (size_t)(row0 + ai * HALF + m * 16) * ldc + col0;
#pragma unroll
                for (int bj = 0; bj < 2; ++bj) { f32x4 v0 = acc[ai][bj][m][0], v1 = acc[ai][bj][m][1];
                    if (sig) {
#pragma unroll
                        for (int j = 0; j < 4; ++j) { v0[j] = sigmoidf_fast(v0[j]); v1[j] = sigmoidf_fast(v1[j]); } }
                    u32x4 w; w.x = cvt_pk_bf16(v0[0], v0[1]); w.y = cvt_pk_bf16(v0[2], v0[3]); w.z = cvt_pk_bf16(v1[0], v1[1]); w.w = cvt_pk_bf16(v1[2], v1[3]);
                    *(u32x4*)(rowp + bj * HALF) = w; } }
    }
};
struct EpiPool {
    static constexpr bool PERM = true, AFTER_DRAIN = false;
    bf16_t* yap; const float* pb; const float* ps;
    __device__ __forceinline__ void operator()(const f32x4 (&acc)[2][2][4][2], const Unit& un, int wr, int wc, int fr, int fq) const {
        const int row0 = un.pm * BM + wr * 64 + fr, col0 = un.pn * BM + wc * 32 + 8 * fq;
        f32x4 bv[2][2], sv[2][2];
#pragma unroll
        for (int bj = 0; bj < 2; ++bj)
#pragma unroll
            for (int n = 0; n < 2; ++n) { bv[bj][n] = *(const f32x4*)(pb + col0 + bj * HALF + 4 * n); sv[bj][n] = *(const f32x4*)(ps + col0 + bj * HALF + 4 * n); }
#pragma unroll
        for (int ai = 0; ai < 2; ++ai)
#pragma unroll
            for (int m = 0; m < 4; ++m) { bf16_t* rowp = yap + (size_t)(row0 + ai * HALF + m * 16) * 512 + col0;
#pragma unroll
                for (int bj = 0; bj < 2; ++bj) { const f32x4 v0 = (acc[ai][bj][m][0] + bv[bj][0]) * sv[bj][0], v1 = (acc[ai][bj][m][1] + bv[bj][1]) * sv[bj][1];
                    u32x4 w; w.x = cvt_pk_bf16(v0[0], v0[1]); w.y = cvt_pk_bf16(v0[2], v0[3]); w.z = cvt_pk_bf16(v1[0], v1[1]); w.w = cvt_pk_bf16(v1[2], v1[3]);
                    *(u32x4*)(rowp + bj * HALF) = w; } }
    }
};
struct EpiGate {
    static constexpr bool PERM = true, AFTER_DRAIN = false;
    const bf16_t* g; const bf16_t* add; bf16_t* out;
    __device__ __forceinline__ void operator()(const f32x4 (&acc)[2][2][4][2], const Unit& un, int wr, int wc, int fr, int fq) const {
        const int row0 = un.pm * BM + wr * 64 + fr, col0 = un.pn * BM + wc * 32 + 8 * fq;
#pragma unroll
        for (int ai = 0; ai < 2; ++ai)
#pragma unroll
            for (int m = 0; m < 4; ++m)
#pragma unroll
                for (int bj = 0; bj < 2; ++bj) { const size_t off = (size_t)(row0 + ai * HALF + m * 16) * 1024 + col0 + bj * HALF;
                    const u32x4 a = *(const u32x4*)(g + off); u32x4 t = {0u, 0u, 0u, 0u}; if (add) t = *(const u32x4*)(add + off);
                    const f32x4 p0 = acc[ai][bj][m][0], p1 = acc[ai][bj][m][1];
                    u32x4 w;
                    w.x = cvt_pk_bf16(bf_lo(t.x) + bf_lo(a.x) * p0[0], bf_hi(t.x) + bf_hi(a.x) * p0[1]);
                    w.y = cvt_pk_bf16(bf_lo(t.y) + bf_lo(a.y) * p0[2], bf_hi(t.y) + bf_hi(a.y) * p0[3]);
                    w.z = cvt_pk_bf16(bf_lo(t.z) + bf_lo(a.z) * p1[0], bf_hi(t.z) + bf_hi(a.z) * p1[1]);
                    w.w = cvt_pk_bf16(bf_lo(t.w) + bf_lo(a.w) * p1[2], bf_hi(t.w) + bf_hi(a.w) * p1[3]);
                    *(u32x4*)(out + off) = w; }
    }
};
struct EpiResF32 {
    static constexpr bool PERM = false, AFTER_DRAIN = false;
    const float* base; float* C;
    __device__ __forceinline__ void operator()(const f32x4 (&acc)[2][2][4][2], const Unit& un, int wr, int wc, int fr, int fq) const {
        const int row0 = un.pm * BM + wr * 64 + fr, col0 = un.pn * BM + wc * 32 + 4 * fq;
#pragma unroll
        for (int ai = 0; ai < 2; ++ai)
#pragma unroll
            for (int m = 0; m < 4; ++m) { const size_t off = (size_t)(row0 + ai * HALF + m * 16) * 1024 + col0;
#pragma unroll
                for (int bj = 0; bj < 2; ++bj)
#pragma unroll
                    for (int n = 0; n < 2; ++n) *(f32x4*)(C + off + bj * HALF + n * 16) = *(const f32x4*)(base + off + bj * HALF + n * 16) + acc[ai][bj][m][n]; }
    }
};
struct EpiSwiglu {
    static constexpr bool PERM = true, AFTER_DRAIN = false;
    const float* b1; bf16_t* act;
    __device__ __forceinline__ void operator()(const f32x4 (&acc)[2][2][4][2], const Unit& un, int wr, int wc, int fr, int fq) const {
        const int e = un.pn >> 3, n8 = un.pn & 7, row0 = un.pm * BM + wr * 64 + fr, col0 = n8 * HALF + wc * 32 + 8 * fq;
        const float* bp = b1 + (size_t)e * 2048 + col0;
        const f32x4 bg0 = *(const f32x4*)(bp), bg1 = *(const f32x4*)(bp + 4), bl0 = *(const f32x4*)(bp + 1024), bl1 = *(const f32x4*)(bp + 1028);
#pragma unroll
        for (int ai = 0; ai < 2; ++ai)
#pragma unroll
            for (int m = 0; m < 4; ++m) {
                f32x4 g0 = acc[ai][0][m][0] + bg0, g1 = acc[ai][0][m][1] + bg1, l0 = acc[ai][1][m][0] + bl0, l1 = acc[ai][1][m][1] + bl1, o0, o1;
#pragma unroll
                for (int j = 0; j < 4; ++j) {
                    const float ga = fminf(g0[j], 7.0f), gb = fminf(g1[j], 7.0f);
                    const float la = fminf(fmaxf(l0[j], -7.0f), 7.0f), lb = fminf(fmaxf(l1[j], -7.0f), 7.0f);
                    o0[j] = (la + 1.0f) * ga * sigmoidf_fast(1.702f * ga); o1[j] = (lb + 1.0f) * gb * sigmoidf_fast(1.702f * gb); }
                u32x4 w; w.x = cvt_pk_bf16(o0[0], o0[1]); w.y = cvt_pk_bf16(o0[2], o0[3]); w.z = cvt_pk_bf16(o1[0], o1[1]); w.w = cvt_pk_bf16(o1[2], o1[3]);
                *(u32x4*)(act + (size_t)(row0 + ai * HALF + m * 16) * 1024 + col0) = w; }
    }
};
struct EpiDown {
    static constexpr bool PERM = true, AFTER_DRAIN = false;
    const float* b2; const float* roww; bf16_t* Y;
    __device__ __forceinline__ void operator()(const f32x4 (&acc)[2][2][4][2], const Unit& un, int wr, int wc, int fr, int fq) const {
        const int e = un.pn >> 2, n4 = un.pn & 3, row0 = un.pm * BM + wr * 64 + fr, col0 = n4 * BM + wc * 32 + 8 * fq;
        const float* bp = b2 + (size_t)e * 1024 + col0;
        f32x4 bv[2][2];
#pragma unroll
        for (int bj = 0; bj < 2; ++bj)
#pragma unroll
            for (int n = 0; n < 2; ++n) bv[bj][n] = *(const f32x4*)(bp + bj * HALF + 4 * n);
#pragma unroll
        for (int ai = 0; ai < 2; ++ai)
#pragma unroll
            for (int m = 0; m < 4; ++m) { const int row = row0 + ai * HALF + m * 16; const float rw = roww[row];
#pragma unroll
                for (int bj = 0; bj < 2; ++bj) { const f32x4 v0 = (acc[ai][bj][m][0] + bv[bj][0]) * rw, v1 = (acc[ai][bj][m][1] + bv[bj][1]) * rw;
                    u32x4 w; w.x = cvt_pk_bf16(v0[0], v0[1]); w.y = cvt_pk_bf16(v0[2], v0[3]); w.z = cvt_pk_bf16(v1[0], v1[1]); w.w = cvt_pk_bf16(v1[2], v1[3]);
                    *(u32x4*)(Y + (size_t)row * 1024 + col0 + bj * HALF) = w; } }
    }
};
struct ListOrder {
    const PG8_LAS unsigned* list;
    __device__ __forceinline__ bool next(int i, Unit& u) const { const unsigned w = (unsigned)__builtin_amdgcn_readfirstlane((int)list[i]); if (w == 0xffffffffu) return false; u.pm = (int)(w & 0xffffu); u.pn = (int)(w >> 16); return true; }
    __device__ __forceinline__ void a_ready(const Unit&) const {}
    __device__ __forceinline__ void done(const Unit&) const {}
    __device__ __forceinline__ const char* abase(const Gemm& g, const Unit& u, size_t tstep) const { return (const char*)g.A + (size_t)u.pm * tstep; }
    __device__ __forceinline__ const char* bbase(const Gemm& g, const Unit& u, size_t tstep) const { return (const char*)g.Bt + (size_t)u.pn * tstep; }
};
template <class Epi, class Sched, bool ALIGN_EPI = false, bool SP2 = false, bool GATHER = false>
__device__ __forceinline__ void gemm_phase(PG8_LAS unsigned char* lds, const Gemm g, const Sched& S, const Epi& E, const int* rowtok = nullptr) {
    const int tid = threadIdx.x, wid = __builtin_amdgcn_readfirstlane(tid >> 6), lane = tid & 63, wr = wid >> 2, wc = wid & 3, fr = lane & 15, fq = lane >> 4;
    const int K = g.K, nt = K / BK;
    static_assert(!GATHER || SP2, "the gathered-A form is written for the two-super-phase loop only");
    unsigned voffA[2], voffB[2];
#pragma unroll
    for (int i = 0; i < 2; ++i) { int R, C; stage_rc(tid * 16 + i * 8192, R, C); const int Rb = Epi::PERM ? ((R & ~31) + perm32(R & 31)) : R;
        voffA[i] = (unsigned)(R * K + C) * 2u; voffB[i] = (unsigned)(Rb * K + C) * 2u; }
    const size_t kstep = (size_t)(BK * 2);
    const size_t hstep = (size_t)HALF * K * 2;
    const size_t tstep = 2 * hstep;
    const unsigned ldsw = (unsigned)wid * 1024u;
    const int aoff = lds_byte(wr * 64 + fr, fq * 8), boff = lds_byte(wc * 32 + fr, fq * 8);
#define PG8_SA(b, h) (((b) * 2 + (h)) * HTB)
#define PG8_SB(b, h) ((4 + (b) * 2 + (h)) * HTB)
#define PG8_STAGE(bufoff, gbase, voff) do { _Pragma("unroll") for (int _i = 0; _i < 2; ++_i) \
        __builtin_amdgcn_global_load_lds((const unsigned*)((const char*)(gbase) + (voff)[_i]), (PG8_LAS unsigned*)(lds + (bufoff) + ldsw + _i * 8192), 16, 0, 0); } while (0)
#define PG8_STA(bufoff, aptr, h, nx) do { if constexpr (GATHER) { const unsigned _v[2] = {(nx) ? gN[h][0] : gC[h][0], (nx) ? gN[h][1] : gC[h][1]}; PG8_STAGE(bufoff, aptr, _v); } \
        else { PG8_STAGE(bufoff, (aptr) + ((h) ? hstep : 0), voffA); } } while (0)
#define PG8_GLOAD(dst, u) do { if constexpr (GATHER) { _Pragma("unroll") for (int _h = 0; _h < 2; ++_h) _Pragma("unroll") for (int _i = 0; _i < 2; ++_i) \
        dst[_h][_i] = (unsigned)rowtok[(u).pm * BM + _h * HALF + (int)(voffA[_i] / (2u * (unsigned)K))] * (2u * (unsigned)K) + voffA[_i] % (2u * (unsigned)K); } } while (0)
#define PG8_LDA(dst, b, h) do { _Pragma("unroll") for (int m = 0; m < 4; ++m) _Pragma("unroll") for (int k = 0; k < 2; ++k) dst[m][k] = *(const PG8_LAS bf16x8*)(lds + PG8_SA(b, h) + aoff + m * 2048 + k * 1024); } while (0)
#define PG8_LDB(dst, b, h) do { _Pragma("unroll") for (int n = 0; n < 2; ++n) _Pragma("unroll") for (int k = 0; k < 2; ++k) dst[n][k] = *(const PG8_LAS bf16x8*)(lds + PG8_SB(b, h) + boff + n * 2048 + k * 1024); } while (0)
#define PG8_MMA(ai, bj, At, Bt) do { __builtin_amdgcn_s_setprio(1); _Pragma("unroll") for (int m = 0; m < 4; ++m) _Pragma("unroll") for (int n = 0; n < 2; ++n) _Pragma("unroll") for (int k = 0; k < 2; ++k) \
        acc[ai][bj][m][n] = __builtin_amdgcn_mfma_f32_16x16x32_bf16(Bt[n][k], At[m][k], acc[ai][bj][m][n], 0, 0, 0); __builtin_amdgcn_s_setprio(0); } while (0)
#define PG8_WAIT_V(n) asm volatile("s_waitcnt vmcnt(" #n ")" ::: "memory")
#define PG8_WAIT_L(n) asm volatile("s_waitcnt lgkmcnt(" #n ")" ::: "memory")
#define PG8_BAR __builtin_amdgcn_s_barrier()
#define PG8_SCHED __builtin_amdgcn_sched_barrier(0)
    Unit cur, nxt; int ui = 0;
    if (!S.next(0, cur)) return;
    f32x4 acc[2][2][4][2];
#pragma unroll
    for (int a = 0; a < 2; ++a)
#pragma unroll
        for (int b = 0; b < 2; ++b)
#pragma unroll
            for (int m = 0; m < 4; ++m)
#pragma unroll
                for (int n = 0; n < 2; ++n) acc[a][b][m][n] = (f32x4){0.f, 0.f, 0.f, 0.f};
    bf16x8 At[4][2], B0[2][2], B1[2][2];
    unsigned gC[2][2] = {{0u, 0u}, {0u, 0u}}, gN[2][2] = {{0u, 0u}, {0u, 0u}};
    const char* cA = GATHER ? (const char*)g.A : S.abase(g, cur, tstep); const char* cB = S.bbase(g, cur, tstep);
    PG8_GLOAD(gC, cur);
    S.a_ready(cur);
    if constexpr (SP2) {
        PG8_STAGE(PG8_SB(0, 0), cB, voffB); PG8_STAGE(PG8_SB(0, 1), cB + hstep, voffB); PG8_STA(PG8_SA(0, 0), cA, 0, false); PG8_STA(PG8_SA(0, 1), cA, 1, false);
        if (wr == 1) PG8_BAR;
        PG8_WAIT_V(2); PG8_BAR;
        PG8_STAGE(PG8_SB(1, 0), cB + kstep, voffB); PG8_STA(PG8_SA(1, 0), cA + kstep, 0, false); PG8_STAGE(PG8_SB(1, 1), cB + hstep + kstep, voffB);
        PG8_WAIT_V(6); PG8_BAR;
    } else {
        PG8_STAGE(PG8_SB(0, 0), cB, voffB); PG8_STAGE(PG8_SA(0, 0), cA, voffA); PG8_STAGE(PG8_SB(0, 1), cB + hstep, voffB); PG8_STAGE(PG8_SA(0, 1), cA + hstep, voffA);
        if (wr == 1) PG8_BAR;
        PG8_WAIT_V(4); PG8_BAR;
        PG8_STAGE(PG8_SB(1, 0), cB + kstep, voffB); PG8_STAGE(PG8_SA(1, 0), cA + kstep, voffA); PG8_STAGE(PG8_SB(1, 1), cB + hstep + kstep, voffB);
        PG8_WAIT_V(6); PG8_BAR;
    }
    for (;;) {
        const bool has_next = S.next(ui + 1, nxt);
        const char* nA = GATHER ? cA : (has_next ? S.abase(g, nxt, tstep) : cA); const char* nB = has_next ? S.bbase(g, nxt, tstep) : cB;
        if constexpr (GATHER) { if (has_next) PG8_GLOAD(gN, nxt); else { _Pragma("unroll") for (int _h = 0; _h < 2; ++_h) _Pragma("unroll") for (int _i = 0; _i < 2; ++_i) gN[_h][_i] = gC[_h][_i]; } }
        for (int t = 0; t < nt; t += 2) {
            const bool last = (t == nt - 2);
            const char* a1 = cA + (size_t)(t + 1) * kstep;
            const char* a2 = last ? nA : cA + (size_t)(t + 2) * kstep; const char* b2 = last ? nB : cB + (size_t)(t + 2) * kstep;
            const char* a3 = a2 + kstep; const char* b3 = b2 + kstep;
            if (last && has_next) S.a_ready(nxt);
            if constexpr (SP2) {
            PG8_LDB(B0, 0, 0); PG8_LDB(B1, 0, 1); PG8_SCHED; PG8_LDA(At, 0, 0); PG8_STA(PG8_SA(1, 1), a1, 1, false);
            PG8_WAIT_V(8); PG8_WAIT_L(0); PG8_BAR; PG8_MMA(0, 0, At, B0); PG8_MMA(0, 1, At, B1); PG8_BAR; PG8_SCHED;
            PG8_LDA(At, 0, 1); PG8_STAGE(PG8_SB(0, 0), b2, voffB); PG8_STAGE(PG8_SB(0, 1), b2 + hstep, voffB); PG8_STA(PG8_SA(0, 0), a2, 0, last);
            PG8_WAIT_V(8); PG8_WAIT_L(0); PG8_BAR; PG8_MMA(1, 0, At, B0); PG8_MMA(1, 1, At, B1); PG8_BAR; PG8_SCHED;
            PG8_LDB(B0, 1, 0); PG8_LDB(B1, 1, 1); PG8_SCHED; PG8_LDA(At, 1, 0); PG8_STA(PG8_SA(0, 1), a2, 1, last);
            PG8_WAIT_V(8); PG8_WAIT_L(0); PG8_BAR; PG8_MMA(0, 0, At, B0); PG8_MMA(0, 1, At, B1); PG8_BAR; PG8_SCHED;
            PG8_LDA(At, 1, 1); PG8_STAGE(PG8_SB(1, 0), b3, voffB); PG8_STAGE(PG8_SB(1, 1), b3 + hstep, voffB); PG8_STA(PG8_SA(1, 0), a3, 0, last);
            PG8_WAIT_V(8); PG8_WAIT_L(0); PG8_BAR; PG8_MMA(1, 0, At, B0); PG8_MMA(1, 1, At, B1); PG8_BAR; PG8_SCHED;
            } else {
            PG8_LDB(B0, 0, 0); PG8_SCHED; PG8_LDA(At, 0, 0); PG8_STAGE(PG8_SA(1, 1), a1 + hstep, voffA);
            PG8_WAIT_L(8); PG8_BAR; PG8_WAIT_L(0); PG8_MMA(0, 0, At, B0); PG8_BAR; PG8_SCHED;
            PG8_LDB(B1, 0, 1); PG8_STAGE(PG8_SB(0, 0), b2, voffB);
            PG8_BAR; PG8_WAIT_L(0); PG8_MMA(0, 1, At, B1); PG8_BAR;
            PG8_LDA(At, 0, 1); PG8_STAGE(PG8_SA(0, 0), a2, voffA);
            PG8_BAR; PG8_WAIT_L(0); PG8_MMA(1, 0, At, B0); PG8_BAR; PG8_SCHED;
            PG8_STAGE(PG8_SB(0, 1), b2 + hstep, voffB);
            PG8_WAIT_V(6); PG8_BAR; PG8_MMA(1, 1, At, B1); PG8_BAR;
            PG8_LDB(B0, 1, 0); PG8_SCHED; PG8_LDA(At, 1, 0); PG8_STAGE(PG8_SA(0, 1), a2 + hstep, voffA);
            PG8_WAIT_L(8); PG8_BAR; PG8_WAIT_L(0); PG8_MMA(0, 0, At, B0); PG8_BAR; PG8_SCHED;
            PG8_LDB(B1, 1, 1); PG8_STAGE(PG8_SB(1, 0), b3, voffB);
            PG8_BAR; PG8_WAIT_L(0); PG8_MMA(0, 1, At, B1); PG8_BAR;
            PG8_LDA(At, 1, 1); PG8_STAGE(PG8_SA(1, 0), a3, voffA);
            PG8_BAR; PG8_WAIT_L(0); PG8_MMA(1, 0, At, B0); PG8_BAR; PG8_SCHED;
            PG8_STAGE(PG8_SB(1, 1), b3 + hstep, voffB);
            PG8_WAIT_V(6); PG8_BAR; PG8_MMA(1, 1, At, B1); PG8_BAR;
            }
        }
        if constexpr (ALIGN_EPI) { if (wr == 0) PG8_BAR; }
        if constexpr (!Epi::AFTER_DRAIN) { E(acc, cur, wr, wc, fr, fq); S.done(cur); }
        if (!has_next) break;
#pragma unroll
        for (int a = 0; a < 2; ++a)
#pragma unroll
            for (int b = 0; b < 2; ++b)
#pragma unroll
                for (int m = 0; m < 4; ++m)
#pragma unroll
                    for (int n = 0; n < 2; ++n) acc[a][b][m][n] = (f32x4){0.f, 0.f, 0.f, 0.f};
        cur = nxt; cA = nA; cB = nB; ++ui;
        if constexpr (GATHER) { _Pragma("unroll") for (int _h = 0; _h < 2; ++_h) _Pragma("unroll") for (int _i = 0; _i < 2; ++_i) gC[_h][_i] = gN[_h][_i]; }
        if constexpr (ALIGN_EPI) { if (wr == 1) PG8_BAR; }
    }
    PG8_WAIT_V(0);
    if constexpr (!ALIGN_EPI) { if (wr == 0) PG8_BAR; }
    PG8_BAR;
    if constexpr (Epi::AFTER_DRAIN) { E.fused(acc, cur, wr, wc, fr, fq, lds, wid, lane); S.done(cur); }
#undef PG8_SA
#undef PG8_SB
#undef PG8_STAGE
#undef PG8_LDA
#undef PG8_STA
#undef PG8_GLOAD
#undef PG8_LDB
#undef PG8_MMA
#undef PG8_WAIT_V
#undef PG8_WAIT_L
#undef PG8_BAR
#undef PG8_SCHED
}
}
namespace attn_body {
using bf16=__hip_bfloat16;
using bf16x8=__attribute__((ext_vector_type(8)))short;
using s16x4=__attribute__((ext_vector_type(4)))short;
using f32x16=__attribute__((ext_vector_type(16)))float;
using u32x4=__attribute__((ext_vector_type(4)))unsigned;
constexpr int BATCH=2,NHEAD=8,SEQ=8192,D=64,DM=NHEAD*D,OPITCH=512;
constexpr int NW=8,QBLK=32,QB=QBLK*NW,KVBLK=64,NQB=SEQ/QB;
__device__ __forceinline__ int crow(int r,int hi){return (r&3)+8*(r>>2)+4*hi;}
#define SBAR() __builtin_amdgcn_sched_barrier(0)
constexpr int NSLOT=3, SLOTB=8192;
constexpr int LDS_K=0, LDS_V=NSLOT*SLOTB, LDS_WS=2*NSLOT*SLOTB, LDS_OST=LDS_WS+NW*64*4, LDS_BYTES=LDS_OST+NW*4096;
constexpr float C2=0.125f*1.4426950408889634f;
__device__ __forceinline__ void glds16(const void*gsrc,unsigned lds_dst){unsigned keep;
  asm volatile("s_mov_b32 %0, m0\n\ts_mov_b32 m0, %2\n\ts_nop 0\n\tglobal_load_lds_dwordx4 %1, off\n\ts_mov_b32 m0, %0":"=&s"(keep):"v"(gsrc),"s"(lds_dst):"memory");}
__device__ __forceinline__ unsigned long long gld8(const unsigned long long*sbase,unsigned voff){unsigned long long r; asm volatile("global_load_dwordx2 %0, %1, %2":"=&v"(r):"v"(voff),"s"(sbase):"memory"); return r;}
typedef float f32x2_t __attribute__((ext_vector_type(2))); typedef __bf16 bf16x2_t __attribute__((ext_vector_type(2)));
__device__ __forceinline__ unsigned cvtpk_s(float lo,float hi){f32x2_t v={lo,hi};bf16x2_t b=__builtin_convertvector(v,bf16x2_t);return __builtin_bit_cast(unsigned,b);}

__device__ __forceinline__ void qkt(f32x16&p0,f32x16&p1,const char*Kslot,const bf16x8*qr,int r32,int hi){
  const f32x16 negm=f32x16{};
  const char*kb=Kslot+hi*1024+r32*16;
  #pragma unroll
  for(int d0=0;d0<4;++d0){
    const bf16x8 b0=*reinterpret_cast<const bf16x8*>(kb+d0*2048);
    const bf16x8 b1=*reinterpret_cast<const bf16x8*>(kb+d0*2048+512);
    if(d0==0){p0=__builtin_amdgcn_mfma_f32_32x32x16_bf16(b0,qr[0],negm,0,0,0);p1=__builtin_amdgcn_mfma_f32_32x32x16_bf16(b1,qr[0],negm,0,0,0);}
    else{p0=__builtin_amdgcn_mfma_f32_32x32x16_bf16(b0,qr[d0],p0,0,0,0);p1=__builtin_amdgcn_mfma_f32_32x32x16_bf16(b1,qr[d0],p1,0,0,0);}}
}
typedef __attribute__((address_space(3))) const char* lds_cptr;
typedef short v4i16_t __attribute__((ext_vector_type(4)));
__device__ __forceinline__ void kload8(bf16x8*kf,lds_cptr kp){
  kf[0]=*(const __attribute__((address_space(3))) bf16x8*)(kp);      kf[1]=*(const __attribute__((address_space(3))) bf16x8*)(kp+512);
  kf[2]=*(const __attribute__((address_space(3))) bf16x8*)(kp+2048); kf[3]=*(const __attribute__((address_space(3))) bf16x8*)(kp+2560);
  kf[4]=*(const __attribute__((address_space(3))) bf16x8*)(kp+4096); kf[5]=*(const __attribute__((address_space(3))) bf16x8*)(kp+4608);
  kf[6]=*(const __attribute__((address_space(3))) bf16x8*)(kp+6144); kf[7]=*(const __attribute__((address_space(3))) bf16x8*)(kp+6656);
}
__device__ __forceinline__ void kload2(bf16x8*kf,lds_cptr kp,int j){ kf[2*j]=*(const __attribute__((address_space(3))) bf16x8*)(kp+j*2048); kf[2*j+1]=*(const __attribute__((address_space(3))) bf16x8*)(kp+j*2048+512); }
__device__ __forceinline__ s16x4 vtr(lds_cptr p){ return __builtin_bit_cast(s16x4,__builtin_amdgcn_ds_read_tr16_b64_v4i16((__attribute__((address_space(3))) v4i16_t*)p)); }
__device__ __forceinline__ void pv(f32x16*o,int vb,bf16x8 pa0,bf16x8 pa1,bf16x8 pa2,bf16x8 pa3){
  #pragma unroll
  for(int d0=0;d0<2;++d0){s16x4 lo[4],hi[4];
    #pragma unroll
    for(int ks=0;ks<4;++ks){
      asm volatile("ds_read_b64_tr_b16 %0,%1 offset:%c2":"=&v"(lo[ks]):"v"(vb),"i"(d0*4096+ks*1024):"memory");
      asm volatile("ds_read_b64_tr_b16 %0,%1 offset:%c2":"=&v"(hi[ks]):"v"(vb),"i"(d0*4096+ks*1024+512):"memory");}
    asm volatile("s_waitcnt lgkmcnt(0)":::"memory");SBAR();
    #define PK(k) (bf16x8){lo[k][0],lo[k][1],lo[k][2],lo[k][3],hi[k][0],hi[k][1],hi[k][2],hi[k][3]}
    o[d0]=__builtin_amdgcn_mfma_f32_32x32x16_bf16(pa0,PK(0),o[d0],0,0,0);
    o[d0]=__builtin_amdgcn_mfma_f32_32x32x16_bf16(pa1,PK(1),o[d0],0,0,0);
    o[d0]=__builtin_amdgcn_mfma_f32_32x32x16_bf16(pa2,PK(2),o[d0],0,0,0);
    o[d0]=__builtin_amdgcn_mfma_f32_32x32x16_bf16(pa3,PK(3),o[d0],0,0,0);
    #undef PK
  }
}
#define MSK(v,w,r) __uint_as_float(__float_as_uint(v)&(unsigned)__builtin_amdgcn_sbfe((int)(w),((r)&3)+8*((r)>>2),1))

__device__ __forceinline__ void attn_unit(int b,int h,int qb,const bf16*Q,const bf16*__restrict__ K,const bf16*__restrict__ V,bf16*O,const unsigned long long*MK,float cshift,char*shm){
  const int tid=threadIdx.x,lane=tid&63,r32=lane&31,hi=lane>>5; const int wid=__builtin_amdgcn_readfirstlane(tid>>6);
  const long rowbase=(long)b*SEQ; const int q0=qb*QB;
  const bf16*Qw=Q+(rowbase+q0+wid*QBLK)*DM+h*D;
  const bf16*Kh=K+rowbase*DM+h*D,*Vh=V+rowbase*DM+h*D;
  const unsigned lds0=(unsigned)(uintptr_t)shm;
  float*wsf=(float*)(shm+LDS_WS)+wid*64;
  const bf16*ksrc=Kh+(long)lane*DM+wid*8;
  const bf16*vsrc=Vh+(long)(16*(wid&3)+(lane>>2))*DM+(wid>>2)*32+(lane&3)*8;
  const unsigned kdst=lds0+LDS_K+wid*1024, vdst=lds0+LDS_V+wid*1024;
  #define DMA_K(t,slot) glds16(ksrc+(long)(t)*KVBLK*DM,(unsigned)__builtin_amdgcn_readfirstlane(kdst+(slot)))
  #define DMA_V(t,slot) glds16(vsrc+(long)(t)*KVBLK*DM,(unsigned)__builtin_amdgcn_readfirstlane(vdst+(slot)))
  const int vb0=(int)(lds0+LDS_V)+((lane>>4)&1)*32+(lane&3)*8+(4*hi+((lane&15)>>2))*64;
  const char*Kbase=shm+LDS_K; bf16x8 kf[8];
  const lds_cptr shm3=(lds_cptr)shm; const lds_cptr kp0=shm3+LDS_K+hi*1024+r32*16; const lds_cptr vp0=shm3+LDS_V+((lane>>4)&1)*32+(lane&3)*8+(4*hi+((lane&15)>>2))*64;
  const int NT=(q0+QB)/KVBLK;
  const unsigned long long*mbase=MK+(size_t)b*(SEQ/KVBLK)*SEQ; const unsigned moff=(unsigned)(q0+wid*QBLK+r32)*8u;
  DMA_K(0,0);DMA_V(0,0);DMA_K(1,SLOTB);
  bf16x8 qr[4];
  #pragma unroll
  for(int d0=0;d0<4;++d0)qr[d0]=*reinterpret_cast<const bf16x8*>(&Qw[(long)r32*DM+d0*16+hi*8]);
  unsigned long long mC=gld8(mbase,moff), mN=gld8(mbase+SEQ,moff);
  float l_reg=0.f;f32x16 o[2];o[0]=f32x16{};o[1]=f32x16{};const f32x16 negm=f32x16{};
  (void)cshift;
  #define WAIT_BAR(N) asm volatile("s_waitcnt vmcnt(" #N ") lgkmcnt(0)\n\ts_barrier":"+v"(mN),"+v"(mC)::"memory")
  f32x16 pA0,pA1,pB0,pB1;
  int sl_prev=0,sl_cur=0,sl_next=SLOTB;
  #define ROT() do{sl_prev=sl_cur;sl_cur=sl_next;sl_next=(sl_next==(NSLOT-1)*SLOTB)?0:sl_next+SLOTB;}while(0)
  DMA_K(2,2*SLOTB);
  WAIT_BAR(3);
  qkt(pA0,pA1,Kbase,qr,r32,hi);asm volatile("s_nop 15\n\ts_nop 7":"+v"(pA0),"+v"(pA1));
  _Pragma("unroll") for(int r=0;r<16;++r){pA0[r]=__builtin_amdgcn_exp2f(pA0[r]);pA1[r]=__builtin_amdgcn_exp2f(pA1[r]);}
  WAIT_BAR(0);
  { const unsigned ma_=(unsigned)mC>>(4*hi), mb_=(unsigned)(mC>>32)>>(4*hi);
    _Pragma("unroll") for(int r=0;r<16;++r){pA0[r]=MSK(pA0[r],ma_,r);pA1[r]=MSK(pA1[r],mb_,r);} }
  DMA_K(3,0);DMA_V(1,SLOTB);
  ROT();
  kload8(kf,kp0+sl_cur);
  WAIT_BAR(2);
  s16x4 vlo[8],vhi[8]; u32x4 pw0,pw1,pw2,pw3;
  #define PKW(P,B) cvtpk_s(P[B],P[B+1])
  #define PAF(k) __builtin_bit_cast(bf16x8,pw##k)
  #define VFR(i) (bf16x8){vlo[i][0],vlo[i][1],vlo[i][2],vlo[i][3],vhi[i][0],vhi[i][1],vhi[i][2],vhi[i][3]}
  #define PIN(x) asm volatile("":"+v"(x))
  #define GAPA(MF,A0,A1,A2,A3,W0,W1,PW) do{ MF; sacc+=A0; sacc+=A1; sacc+=A2; sacc+=A3; PIN(sacc); W0; W1; PIN(PW); SBAR(); }while(0)
  #define EX(v) __builtin_amdgcn_exp2f(v)
  #define GAPB(MF,X,B,W) do{ MF; X[B]=MSK(EX(X[B]),W,B); X[B+1]=MSK(EX(X[B+1]),W,B+1); X[B+2]=MSK(EX(X[B+2]),W,B+2); X[B+3]=MSK(EX(X[B+3]),W,B+3); PIN(X); SBAR(); }while(0)
  #define VRD(i) do{ vlo[i]=vtr(vp_+(((i)>>2)*4096+((i)&3)*1024)); vhi[i]=vtr(vp_+(((i)>>2)*4096+((i)&3)*1024+512)); }while(0)
  #define KRD(G,j) do{ if(G){ kload2(kf,kp0+sl_next,j); SBAR(); } }while(0)
  #define STEP(C0,C1,P0,P1,t,GK,GV,GL) do{ SBAR(); \
    const unsigned ma_=(unsigned)mN>>(4*hi), mb_=(unsigned)(mN>>32)>>(4*hi); \
    if((t)+1<NT){ mN=gld8(mbase+(size_t)((t)+1)*SEQ,moff); } \
    const lds_cptr vp_=vp0+sl_prev; \
    VRD(0); SBAR(); float sacc=(P0[0]+P0[1]); \
    GAPA(C0=__builtin_amdgcn_mfma_f32_32x32x16_bf16(kf[0],qr[0],negm,0,0,0), P0[2],P0[3],P0[4],P0[5],     pw0[0]=PKW(P0,0), pw0[1]=PKW(P0,2), pw0); \
    VRD(4); SBAR(); GAPA(C1=__builtin_amdgcn_mfma_f32_32x32x16_bf16(kf[1],qr[0],negm,0,0,0), P0[6],P0[7],P0[8],P0[9],     pw0[2]=PKW(P0,4), pw0[3]=PKW(P0,6), pw0); \
    VRD(1); SBAR(); GAPA(C0=__builtin_amdgcn_mfma_f32_32x32x16_bf16(kf[2],qr[1],C0,0,0,0),   P0[10],P0[11],P0[12],P0[13], pw1[0]=PKW(P0,8), pw1[1]=PKW(P0,10), pw1); \
    VRD(5); SBAR(); GAPA(C1=__builtin_amdgcn_mfma_f32_32x32x16_bf16(kf[3],qr[1],C1,0,0,0),   P0[14],P0[15],P1[0],P1[1],   pw1[2]=PKW(P0,12),pw1[3]=PKW(P0,14), pw1); \
    VRD(2); SBAR(); GAPA(C0=__builtin_amdgcn_mfma_f32_32x32x16_bf16(kf[4],qr[2],C0,0,0,0),   P1[2],P1[3],P1[4],P1[5],     pw2[0]=PKW(P1,0), pw2[1]=PKW(P1,2), pw2); \
    VRD(6); SBAR(); GAPA(C1=__builtin_amdgcn_mfma_f32_32x32x16_bf16(kf[5],qr[2],C1,0,0,0),   P1[6],P1[7],P1[8],P1[9],     pw2[2]=PKW(P1,4), pw2[3]=PKW(P1,6), pw2); \
    VRD(3); SBAR(); GAPA(C0=__builtin_amdgcn_mfma_f32_32x32x16_bf16(kf[6],qr[3],C0,0,0,0),   P1[10],P1[11],P1[12],P1[13], pw3[0]=PKW(P1,8), pw3[1]=PKW(P1,10), pw3); \
    VRD(7); SBAR(); GAPA(C1=__builtin_amdgcn_mfma_f32_32x32x16_bf16(kf[7],qr[3],C1,0,0,0),   P1[14],P1[15],0.f,0.f,       pw3[2]=PKW(P1,12),pw3[3]=PKW(P1,14), pw3); \
    l_reg+=sacc; \
    if(GK){DMA_K((t)+3,sl_cur);} if(GV){DMA_V((t)+1,sl_next);} \
    SBAR(); \
    GAPB(o[0]=__builtin_amdgcn_mfma_f32_32x32x16_bf16(PAF(0),VFR(0),o[0],0,0,0), C0,0,ma_); \
    GAPB(o[1]=__builtin_amdgcn_mfma_f32_32x32x16_bf16(PAF(0),VFR(4),o[1],0,0,0), C0,4,ma_); \
    KRD(GL,0); GAPB(o[0]=__builtin_amdgcn_mfma_f32_32x32x16_bf16(PAF(1),VFR(1),o[0],0,0,0), C0,8,ma_); \
    KRD(GL,1); GAPB(o[1]=__builtin_amdgcn_mfma_f32_32x32x16_bf16(PAF(1),VFR(5),o[1],0,0,0), C0,12,ma_); \
    KRD(GL,2); GAPB(o[0]=__builtin_amdgcn_mfma_f32_32x32x16_bf16(PAF(2),VFR(2),o[0],0,0,0), C1,0,mb_); \
    KRD(GL,3); GAPB(o[1]=__builtin_amdgcn_mfma_f32_32x32x16_bf16(PAF(2),VFR(6),o[1],0,0,0), C1,4,mb_); \
    GAPB(o[0]=__builtin_amdgcn_mfma_f32_32x32x16_bf16(PAF(3),VFR(3),o[0],0,0,0), C1,8,mb_); \
    GAPB(o[1]=__builtin_amdgcn_mfma_f32_32x32x16_bf16(PAF(3),VFR(7),o[1],0,0,0), C1,12,mb_); \
    }while(0)
  int t=1;
  for(;t+5<NT;t+=2){
    STEP(pB0,pB1,pA0,pA1,t,true,true,true);     WAIT_BAR(2); ROT();
    STEP(pA0,pA1,pB0,pB1,t+1,true,true,true);   WAIT_BAR(2); ROT();
  }
  #define ENDW(tt) do{ if((tt)+3<NT){WAIT_BAR(2);} else if((tt)+2<NT){WAIT_BAR(1);} else {WAIT_BAR(0);} }while(0)
  for(;t+1<NT;t+=2){
    STEP(pB0,pB1,pA0,pA1,t,(t+3<NT),(t+1<NT),(t+1<NT));       ENDW(t);   ROT();
    STEP(pA0,pA1,pB0,pB1,t+1,(t+4<NT),(t+2<NT),(t+2<NT));     ENDW(t+1); ROT();
  }
  STEP(pB0,pB1,pA0,pA1,NT-1,false,false,false);
  { float sacc=pB0[0]+pB0[1]; _Pragma("unroll") for(int r=2;r<16;++r)sacc+=pB0[r]; _Pragma("unroll") for(int r=0;r<16;++r)sacc+=pB1[r]; l_reg+=sacc;
    pw0=(u32x4){PKW(pB0,0),PKW(pB0,2),PKW(pB0,4),PKW(pB0,6)};pw1=(u32x4){PKW(pB0,8),PKW(pB0,10),PKW(pB0,12),PKW(pB0,14)};pw2=(u32x4){PKW(pB1,0),PKW(pB1,2),PKW(pB1,4),PKW(pB1,6)};pw3=(u32x4){PKW(pB1,8),PKW(pB1,10),PKW(pB1,12),PKW(pB1,14)};
    SBAR(); pv(o,vb0+sl_cur,PAF(0),PAF(1),PAF(2),PAF(3)); }
  #undef PKW
  #undef PAF
  #undef VFR
  #undef PIN
  #undef GAPA
  #undef GAPB
  #undef EX
  #undef VRD
  #undef KRD
  #undef STEP
  #undef ENDW
  {auto rr=__builtin_amdgcn_permlane32_swap(__float_as_uint(l_reg),__float_as_uint(l_reg),false,false);l_reg=__uint_as_float(rr[0])+__uint_as_float(rr[1]);}
  if(hi==0)wsf[32+r32]=l_reg;asm volatile("s_waitcnt lgkmcnt(0)":::"memory");
  float rli[16];
  #pragma unroll
  for(int r=0;r<16;++r)rli[r]=__builtin_amdgcn_rcpf(wsf[32+crow(r,hi)]);
  bf16*Ow=O+(rowbase+q0+wid*QBLK)*OPITCH+h*D;
  { bf16*stg=(bf16*)(shm+LDS_OST)+wid*2048;
    #pragma unroll
    for(int r=0;r<16;++r){const int orow=crow(r,hi);
      #pragma unroll
      for(int d0=0;d0<2;++d0)stg[orow*64+d0*32+r32]=__float2bfloat16(o[d0][r]*rli[r]);}
    asm volatile("s_waitcnt lgkmcnt(0)":::"memory");
    #pragma unroll
    for(int i=0;i<4;++i){const int row=i*8+(lane>>3),ch=lane&7; const u32x4 v=*(const u32x4*)(stg+row*64+ch*8); *(u32x4*)(Ow+(long)row*OPITCH+ch*8)=v;} }
  asm volatile("s_waitcnt lgkmcnt(0)\n\ts_barrier":::"memory");
  #undef DMA_K
  #undef DMA_V
  #undef ROT
  #undef WAIT_BAR
}
#undef MSK
constexpr int ATTN_LDS_BYTES=LDS_BYTES;
#undef SBAR
}
#define XB_TMO      128
#define XB_XCNT(j)  (256  + 64 * (j))
#define XB_XSUB(j)  (1280 + 64 * (j))
#define XB_XGEN(j)  (2304 + 64 * (j))
#define XB_TOP      3328
#define XB_TOPGEN   3392
#define XCD_BAR_WORDS 3456
#define XB_SPIN_CAP (1u << 18)

__device__ __forceinline__ unsigned xb_ld(unsigned* p)              { return __hip_atomic_load(p, __ATOMIC_RELAXED, __HIP_MEMORY_SCOPE_AGENT); }
__device__ __forceinline__ unsigned xb_add(unsigned* p, unsigned v) { return __hip_atomic_fetch_add(p, v, __ATOMIC_RELAXED, __HIP_MEMORY_SCOPE_AGENT); }
__device__ __forceinline__ unsigned xb_xcc_id() { return (unsigned)__builtin_amdgcn_s_getreg((3 << 11) | 20) & 0xFu; }
#define XB_SPIN(cond, bar) do { unsigned _sp = 0; while (cond) { __builtin_amdgcn_s_sleep(1); \
    if ((++_sp & 255u) == 0u) { if (xb_ld(&(bar)[XB_TMO])) break; if (_sp > XB_SPIN_CAP) { atomicAdd(&(bar)[XB_TMO], 1u); break; } } } } while (0)

struct XcdBarrier {
    unsigned* bar; unsigned x;
    volatile LAS unsigned* st;
};

__device__ __forceinline__ XcdBarrier xcd_barrier_post(unsigned* bar, volatile LAS unsigned* st) {
    XcdBarrier b; b.bar = bar; b.x = xb_xcc_id(); b.st = st;
    if (threadIdx.x == 0) (void)xb_add(&bar[XB_XCNT(b.x)], 1u);
    return b;
}
__device__ __forceinline__ void xcd_barrier_complete(unsigned* bar, unsigned x, unsigned& nloc, unsigned& nx) {
    const unsigned G = gridDim.x * gridDim.y * gridDim.z;
    unsigned sum, cnt, mine, sp = 0u;
    for (;;) {
        sum = 0u; cnt = 0u; mine = 0u;
#pragma unroll
        for (unsigned j = 0; j < 16; ++j) { const unsigned c = xb_ld(&bar[XB_XCNT(j)]); sum += c; cnt += (c > 0u) ? 1u : 0u; mine = (j == x) ? c : mine; }
        if (sum == G) break;
        __builtin_amdgcn_s_sleep(1);
        if ((++sp & 255u) == 0u) { if (xb_ld(&bar[XB_TMO])) break; if (sp > XB_SPIN_CAP) { atomicAdd(&bar[XB_TMO], 1u); break; } }
    }
    nloc = mine > 0u ? mine : 1u; nx = cnt > 0u ? cnt : 1u;
}

__device__ __forceinline__ void xcd_barrier(const XcdBarrier& b) {
    asm volatile("s_waitcnt vmcnt(0)" ::: "memory");
    __syncthreads();
    if (threadIdx.x == 0) {
        unsigned* bar = b.bar;
        __builtin_amdgcn_s_waitcnt(0);
        unsigned nloc = b.st[0], nx = b.st[1];
        if (nloc == 0u) { xcd_barrier_complete(bar, b.x, nloc, nx); b.st[0] = nloc; b.st[1] = nx; }
        const unsigned old = xb_add(&bar[XB_XSUB(b.x)], 1u);
        const unsigned gen = old / nloc;
        if (old + 1u == (gen + 1u) * nloc) {
            __builtin_amdgcn_fence(__ATOMIC_RELEASE, "agent");
            asm volatile("s_waitcnt vmcnt(0)" ::: "memory");
            const unsigned og = xb_add(&bar[XB_TOP], 1u);
            const unsigned tg = og / nx;
            if (og + 1u == (tg + 1u) * nx) xb_add(&bar[XB_TOPGEN], 1u);
            else XB_SPIN(xb_ld(&bar[XB_TOPGEN]) == tg, bar);
            __builtin_amdgcn_fence(__ATOMIC_ACQUIRE, "agent");
            xb_add(&bar[XB_XGEN(b.x)], 1u);
            asm volatile("s_waitcnt vmcnt(0)" ::: "memory");
        } else {
            XB_SPIN(xb_ld(&bar[XB_XGEN(b.x)]) == gen, bar);
            __builtin_amdgcn_fence(__ATOMIC_ACQUIRE, "agent");
            asm volatile("s_waitcnt vmcnt(0)" ::: "memory");
        }
    }
    __syncthreads();
}
struct Frame {
    LAS unsigned char* lds;
    volatile LAS unsigned* MISC;
    gu32* ctl;
    int tid, lane, wave;
    int vcu, G;
    unsigned char* ws;
    const float* in[18]; float* out;
};
__device__ __forceinline__ float wave_sum(float v) {
#pragma unroll
    for (int o = 1; o < 64; o <<= 1) v += __shfl_xor(v, o);
    return v;
}
__device__ __forceinline__ float wave_max(float v) {
#pragma unroll
    for (int o = 1; o < 64; o <<= 1) v = fmaxf(v, __shfl_xor(v, o));
    return v;
}
template <int MODE> __device__ __forceinline__ int tr_row(int n) {
    if (MODE == 0) return n < 1860 ? n : n + 188;
    if (MODE == 1) return n < 1024 ? 256 * (n >> 7) + (n & 127) : 256 * ((n - 1024) >> 7) + 128 + ((n - 1024) & 127);
    if (MODE == 4) return 256 * (n >> 7) + (n & 127);
    if (MODE == 5) return 256 * (n >> 7) + 128 + (n & 127);
    return n;
}
template <int MODE> __device__ __forceinline__ void tr_item(const float* W, int N, bf16* WT, int ldt, int koff, LAS float* scr, int kb, int nb, int lane) {
    const int k0 = 64 * kb, n0 = 64 * nb, cq = 4 * (lane & 15), r0 = lane >> 4; const bool colok = (n0 + cq) < N;
    f32x4 v[16];
#pragma unroll
    for (int j = 0; j < 16; ++j) v[j] = colok ? *(const GAS f32x4*)(W + (size_t)(k0 + r0 + 4 * j) * N + n0 + cq) : (f32x4){0.f, 0.f, 0.f, 0.f};
#pragma unroll
    for (int j = 0; j < 16; ++j) { LAS float* d = scr + (r0 + 4 * j) * 65 + cq; d[0] = v[j].x; d[1] = v[j].y; d[2] = v[j].z; d[3] = v[j].w; }
    LDS_WAIT(); asm volatile("" ::: "memory");
    const int c = lane & 7;
#pragma unroll
    for (int j = 0; j < 8; ++j) { const int n = (lane >> 3) + 8 * j; const LAS float* s = scr + (8 * c) * 65 + n;
        v4u o; o.x = pk2(s[0 * 65], s[1 * 65]); o.y = pk2(s[2 * 65], s[3 * 65]); o.z = pk2(s[4 * 65], s[5 * 65]); o.w = pk2(s[6 * 65], s[7 * 65]);
        if (n0 + n < N) *(GAS v4u*)(WT + (size_t)tr_row<MODE>(n0 + n) * ldt + koff + k0 + 8 * c) = o; }
    LDS_WAIT(); asm volatile("" ::: "memory");
}
__device__ __forceinline__ void rms_row_to_bf16(const float* xrow, const float* g, bf16* orow, int lane) {
    const GAS f32x4* xr = (const GAS f32x4*)xrow + lane; const GAS f32x4* gr = (const GAS f32x4*)g + lane;
    f32x4 v[4]; float s = 0.f;
#pragma unroll
    for (int j = 0; j < 4; ++j) { v[j] = xr[64 * j]; s += (v[j].x * v[j].x + v[j].y * v[j].y) + (v[j].z * v[j].z + v[j].w * v[j].w); }
    const float r = 1.0f / sqrtf(wave_sum(s) * (1.f / 1024.f) + EPS);
    GAS unsigned long long* o8 = (GAS unsigned long long*)orow + lane;
#pragma unroll
    for (int j = 0; j < 4; ++j) { const f32x4 gv = gr[64 * j]; o8[64 * j] = (unsigned long long)pk2(v[j].x * r * gv.x, v[j].y * r * gv.y) | ((unsigned long long)pk2(v[j].z * r * gv.z, v[j].w * r * gv.w) << 32); }
}
__device__ __forceinline__ void p0_prologue(Frame& F) {
    LAS float* scr = (LAS float*)(F.lds + RING_OFF + F.wave * 16640);
    const int gw = F.vcu * NWAVES + F.wave, NGW = F.G * NWAVES;
    bf16* Win_t = (bf16*)(F.ws + WS_WIN); bf16* Wab_t = (bf16*)(F.ws + WS_WAB); bf16* Wout_t = (bf16*)(F.ws + WS_WOUT); bf16* Wpool_t = (bf16*)(F.ws + WS_WPOOL);
    bf16* W1_t = (bf16*)(F.ws + WS_W1); bf16* W2_t = (bf16*)(F.ws + WS_W2);
    constexpr int I_W1 = 32 * 16 * 32, I_W2 = 32 * 16 * 16, I_IN = 16 * 70, I_OUT = 16 * 16, I_WA = 8 * 16, I_WB = 8 * 16, I_POOL = 16;
    constexpr int NITEMS = I_W1 + I_W2 + I_IN + I_OUT + I_WA + I_WB + I_POOL;
    for (int it = gw; it < NITEMS; it += NGW) {
        int r = it;
        if (r < I_W1) { const int e = r >> 9, rr = r & 511; tr_item<1>(F.in[14] + (size_t)e * 1024 * 2048, 2048, W1_t + (size_t)e * 2048 * 1024, 1024, 0, scr, rr >> 5, rr & 31, F.lane); continue; } r -= I_W1;
        if (r < I_W2) { const int e = r >> 8, rr = r & 255; tr_item<2>(F.in[16] + (size_t)e * 1024 * 1024, 1024, W2_t + (size_t)e * 1024 * 1024, 1024, 0, scr, rr >> 4, rr & 15, F.lane); continue; } r -= I_W2;
        if (r < I_IN) { tr_item<0>(F.in[2], NIN, Win_t, 1024, 0, scr, r / 70, r % 70, F.lane); continue; } r -= I_IN;
        if (r < I_OUT) { tr_item<2>(F.in[10], 1024, Wout_t, 1024, 0, scr, r >> 4, r & 15, F.lane); continue; } r -= I_OUT;
        if (r < I_WA) { tr_item<2>(F.in[8], 1024, Wab_t, 512, 0, scr, r >> 4, r & 15, F.lane); continue; } r -= I_WA;
        if (r < I_WB) { tr_item<2>(F.in[9], 1024, Wab_t + 1024 * 512, 512, 0, scr, r >> 4, r & 15, F.lane); continue; } r -= I_WB;
        { const int g = r >> 2, rr = r & 3; tr_item<2>(F.in[5] + (size_t)g * 128 * 128, 128, Wpool_t + (size_t)(128 * g) * 512, 512, 128 * g, scr, rr >> 1, rr & 1, F.lane); }
    }
    const int gt = F.vcu * (NWAVES * 64) + F.tid, NGT = F.G * NWAVES * 64; const v4u z = {0u, 0u, 0u, 0u};
    for (int i = gt; i < 512 * 64; i += NGT) { const int row = i >> 6, ch = i & 63; if ((ch >> 4) != (row >> 7)) *(GAS v4u*)(Wpool_t + (size_t)row * 512 + ch * 8) = z; }
    for (int i = gt; i < 188 * 128; i += NGT) { const int row = 1860 + (i >> 7), ch = i & 127; *(GAS v4u*)(Win_t + (size_t)row * 1024 + ch * 8) = z; }
    bf16* H = (bf16*)(F.ws + WS_H);
    { const GAS f32x4* gr = (const GAS f32x4*)F.in[1] + F.lane; f32x4 gv[4];
#pragma unroll
      for (int j = 0; j < 4; ++j) gv[j] = gr[64 * j];
      for (int m0 = gw; m0 < M; m0 += 4 * NGW) { f32x4 v[4][4];
#pragma unroll
          for (int u = 0; u < 4; ++u) { const GAS f32x4* xr = (const GAS f32x4*)(F.in[0] + (size_t)(m0 + u * NGW) * 1024) + F.lane;
#pragma unroll
              for (int j = 0; j < 4; ++j) v[u][j] = xr[64 * j]; }
#pragma unroll
          for (int u = 0; u < 4; ++u) { float ss = 0.f;
#pragma unroll
              for (int j = 0; j < 4; ++j) ss += (v[u][j].x * v[u][j].x + v[u][j].y * v[u][j].y) + (v[u][j].z * v[u][j].z + v[u][j].w * v[u][j].w);
              const float r = 1.0f / sqrtf(wave_sum(ss) * (1.f / 1024.f) + EPS); GAS unsigned long long* o8 = (GAS unsigned long long*)(H + (size_t)(m0 + u * NGW) * 1024) + F.lane;
#pragma unroll
              for (int j = 0; j < 4; ++j) { const f32x4 y = v[u][j] * r * gv[j]; o8[64 * j] = (unsigned long long)pk2(y.x, y.y) | ((unsigned long long)pk2(y.z, y.w) << 32); } } } }
}
__device__ __forceinline__ void qknorm_rows(Frame& F, bool dry = false) {
    const int gw = F.vcu * NWAVES + F.wave, NGW = F.G * NWAVES, lane = F.lane;
    bf16* Q = (bf16*)(F.ws + WS_Q); bf16* K = (bf16*)(F.ws + WS_K);
    const int d0 = (lane & 7) * 8;
    float gq[8], gk[8];
#pragma unroll
    for (int j = 0; j < 8; ++j) { gq[j] = F.in[3][d0 + j] * attn_body::C2; gk[j] = F.in[4][d0 + j]; }
    for (int m0 = gw; m0 < 2 * M; m0 += 4 * NGW) {
        v4u w[4]; bf16* p[4]; bool isq[4];
#pragma unroll
        for (int u = 0; u < 4; ++u) { const int m = m0 + u * NGW; isq[u] = m < M; p[u] = (isq[u] ? Q + (size_t)m * 512 : K + (size_t)(m - M) * 512) + lane * 8; w[u] = (m < 2 * M) ? *(const GAS v4u*)p[u] : (v4u){0u, 0u, 0u, 0u}; }
#pragma unroll
        for (int u = 0; u < 4; ++u) { if (m0 + u * NGW >= 2 * M) break;
            float x[8] = {bflo(w[u].x), bfhi(w[u].x), bflo(w[u].y), bfhi(w[u].y), bflo(w[u].z), bfhi(w[u].z), bflo(w[u].w), bfhi(w[u].w)};
            float s = 0.f;
#pragma unroll
            for (int j = 0; j < 8; ++j) s += x[j] * x[j];
            s += __shfl_xor(s, 1); s += __shfl_xor(s, 2); s += __shfl_xor(s, 4);
            const float r = 1.0f / sqrtf(s * (1.f / 64.f) + EPS);
#pragma unroll
            for (int j = 0; j < 8; ++j) x[j] = x[j] * r * (isq[u] ? gq[j] : gk[j]);
            v4u o; o.x = pk2(x[0], x[1]); o.y = pk2(x[2], x[3]); o.z = pk2(x[4], x[5]); o.w = pk2(x[6], x[7]);
            *(GAS v4u*)p[u] = dry ? w[u] : o; }
    }
}
__device__ __forceinline__ void pool_diff_rows(Frame& F) {
    const int gw = F.vcu * NWAVES + F.wave, NGW = F.G * NWAVES, lane = F.lane;
    const bf16* U = (const bf16*)(F.ws + WS_U); bf16* Dd = (bf16*)(F.ws + WS_DIFF);
    const int win = 2 << (lane >> 4);
    for (int m0 = gw; m0 < M; m0 += 2 * NGW) {
        v4u w[2][16]; int cnt[2];
#pragma unroll
        for (int u = 0; u < 2; ++u) { const int m = m0 + u * NGW, t = m & (SEQ - 1); cnt[u] = (t + 1 < win) ? t + 1 : win;
#pragma unroll
            for (int j = 0; j < 16; ++j) w[u][j] = (j < cnt[u]) ? *(const GAS v4u*)(U + (size_t)(m - j) * 512 + lane * 8) : (v4u){0u, 0u, 0u, 0u}; }
#pragma unroll
        for (int u = 0; u < 2; ++u) { const int m = m0 + u * NGW;
            float a[8] = {0.f, 0.f, 0.f, 0.f, 0.f, 0.f, 0.f, 0.f};
#pragma unroll
            for (int j = 0; j < 16; ++j) { a[0] += bflo(w[u][j].x); a[1] += bfhi(w[u][j].x); a[2] += bflo(w[u][j].y); a[3] += bfhi(w[u][j].y); a[4] += bflo(w[u][j].z); a[5] += bfhi(w[u][j].z); a[6] += bflo(w[u][j].w); a[7] += bfhi(w[u][j].w); }
            const float inv = 1.0f / (float)cnt[u]; v4u o;
            o.x = pk2(a[0] * inv - bflo(w[u][0].x), a[1] * inv - bfhi(w[u][0].x)); o.y = pk2(a[2] * inv - bflo(w[u][0].y), a[3] * inv - bfhi(w[u][0].y));
            o.z = pk2(a[4] * inv - bflo(w[u][0].z), a[5] * inv - bfhi(w[u][0].z)); o.w = pk2(a[6] * inv - bflo(w[u][0].w), a[7] * inv - bfhi(w[u][0].w));
            *(GAS v4u*)(Dd + (size_t)m * 512 + lane * 8) = o; }
    }
}
__device__ __forceinline__ int tk_fidx(int q) { return (((q >> 3) * 2 + (q & 1)) * 4) + ((q & 7) >> 1); }
__device__ __forceinline__ float relu_f(float x) { const int b = __builtin_bit_cast(int, x); return __builtin_bit_cast(float, b > 0 ? b : 0); }
__device__ __forceinline__ unsigned wave_incl_scan(unsigned v, int lane) {
    v += (unsigned)__builtin_amdgcn_update_dpp(0, (int)v, 0x111, 0xf, 0xf, false);
    v += (unsigned)__builtin_amdgcn_update_dpp(0, (int)v, 0x112, 0xf, 0xf, false);
    v += (unsigned)__builtin_amdgcn_update_dpp(0, (int)v, 0x114, 0xf, 0xf, false);
    v += (unsigned)__builtin_amdgcn_update_dpp(0, (int)v, 0x118, 0xf, 0xf, false);
    const unsigned t0 = (unsigned)__builtin_amdgcn_readlane((int)v, 15), t1 = (unsigned)__builtin_amdgcn_readlane((int)v, 31), t2 = (unsigned)__builtin_amdgcn_readlane((int)v, 47);
    return v + (lane >= 16 ? t0 : 0u) + (lane >= 32 ? t1 : 0u) + (lane >= 48 ? t2 : 0u);
}
struct TkState {
    LAS unsigned char* lds;
    __device__ __forceinline__ LAS unsigned* x(int words) const { return (LAS unsigned*)(lds + XTRA_OFF) + words; }
    __device__ __forceinline__ LAS unsigned* hist_() const { return (LAS unsigned*)(lds + RING_OFF); }
    __device__ __forceinline__ LAS unsigned long long* clist_() const { return (LAS unsigned long long*)(lds + XTRA_OFF + 4096); }
    __device__ __forceinline__ const LAS bf16x8* afl_() const { return (const LAS bf16x8*)(lds + RING_OFF + 131072); }
#define TK_F(name, off) __device__ __forceinline__ LAS unsigned* name() const { return x(off); }
    TK_F(sl_lb_, 0)
    TK_F(sl_p1_, 32)
    TK_F(sl_p2_, 64)
    TK_F(sl_lo_, 96)
    TK_F(sl_hi_, 128)
    TK_F(sl_kth_, 160)
    TK_F(need_, 192)
    TK_F(neq_, 224)
    TK_F(ccnt_, 256)
    TK_F(cmin_, 288)
    TK_F(cmax_, 320)
    TK_F(flag_, 352)
    TK_F(wl_, 448)
#undef TK_F
};
constexpr int TK_CAP = 32;
template <int MODE> __device__ __forceinline__ void tk_scan(const TkState& T, int wave, int lane_in, bool MID) {
    int lane = lane_in; asm volatile("" : "+v"(lane));
    for (int qq = 0; qq < 4; ++qq) {
        const int q = 4 * wave + qq, fi = tk_fidx(q); LAS unsigned* hq = T.hist_() + q * 1024;
        bool up;
        int base;
        unsigned pre = 0u;
        if (MODE == 2) { pre = MID ? T.sl_p1_()[fi] : T.sl_p2_()[fi]; const bool neg = MID ? (pre >= 512u) : (pre >= (512u << 11)); up = neg; base = neg ? 16 * lane : 1024 - 16 * (lane + 1); }
        else { up = lane >= 32; base = up ? 512 + 16 * (lane - 32) : 512 - 16 * (lane + 1); }
        unsigned dr[16], d[16];
#pragma unroll
        for (int i = 0; i < 4; ++i) { const v4u v = *(const LAS v4u*)(hq + base + 4 * i); dr[4 * i] = v.x; dr[4 * i + 1] = v.y; dr[4 * i + 2] = v.z; dr[4 * i + 3] = v.w;
            if (MODE != 1) *(LAS v4u*)(hq + base + 4 * i) = (v4u){0u, 0u, 0u, 0u}; }
#pragma unroll
        for (int i = 0; i < 16; ++i) d[i] = up ? dr[i] : dr[15 - i];
        unsigned s = 0u;
#pragma unroll
        for (int i = 0; i < 16; ++i) s += (MODE == 2) ? ((d[i] & 0xffffu) + (d[i] >> 16)) : d[i];
        const unsigned inc = wave_incl_scan(s, lane);
        const unsigned nd = (MODE == 1) ? (unsigned)TOPK : T.need_()[q];
        const unsigned long long bal = __ballot(inc >= nd);
        if (MODE == 1 && bal == 0ull) continue;
        const int Ls = __builtin_amdgcn_readfirstlane(bal ? (int)__ffsll((long long)bal) - 1 : 63);
        unsigned run = inc - s, fpos = 0u, fneed = 1u, fcnt = 1u; bool found = false;
#pragma unroll
        for (int i = 0; i < 16; ++i) {
            if (MODE != 2) { const unsigned c = d[i]; if (!found && run + c >= nd) { found = true; fpos = (unsigned)i; fneed = nd - run; fcnt = c; } run += c; }
            else { const unsigned c0 = up ? (d[i] & 0xffffu) : (d[i] >> 16), c1 = up ? (d[i] >> 16) : (d[i] & 0xffffu);
                if (!found && run + c0 >= nd) { found = true; fpos = 2u * i; fneed = nd - run; fcnt = c0; } run += c0;
                if (!found && run + c1 >= nd) { found = true; fpos = 2u * i + 1u; fneed = nd - run; fcnt = c1; } run += c1; }
        }
        unsigned fbin;
        if (MODE != 2) fbin = up ? (unsigned)base + fpos : (unsigned)base + 15u - fpos;
        else { const unsigned dw = up ? (unsigned)base + (fpos >> 1) : (unsigned)base + 15u - (fpos >> 1); fbin = 2u * dw + (up ? (fpos & 1u) : 1u - (fpos & 1u)); }
        fbin = (unsigned)__builtin_amdgcn_readlane((int)fbin, Ls); fneed = (unsigned)__builtin_amdgcn_readlane((int)fneed, Ls); fcnt = (unsigned)__builtin_amdgcn_readlane((int)fcnt, Ls);
        if (lane == 0) {
            if (MODE == 1) T.sl_lb_()[fi] = fbin < 512u ? (fbin << 22) : ((fbin << 22) | 0x3fffffu);
            if (MODE == 0) { T.sl_p1_()[fi] = fbin; T.need_()[q] = fneed; T.neq_()[q] = fcnt; }
            if (MODE == 2 && MID) { const unsigned p21 = (pre << 11) | fbin, a = p21 << 11, bb = a | 0x7ffu; const bool neg = pre >= 512u;
                T.sl_p2_()[fi] = p21; T.sl_lo_()[fi] = neg ? bb : a; T.sl_hi_()[fi] = neg ? a : bb; T.need_()[q] = fneed; T.neq_()[q] = fcnt; }
            if (MODE == 2 && !MID) { const unsigned kth = (pre << 11) | fbin; T.sl_lo_()[fi] = kth; T.sl_hi_()[fi] = kth; T.need_()[q] = fneed; T.neq_()[q] = fcnt; }
        }
    }
}
#define TK_WL8(v, b) asm volatile("s_nop 4\n\tv_writelane_b32 %0, %1, 0\n\tv_writelane_b32 %0, %2, 1\n\tv_writelane_b32 %0, %3, 2\n\tv_writelane_b32 %0, %4, 3\n\tv_writelane_b32 %0, %5, 4\n\tv_writelane_b32 %0, %6, 5\n\tv_writelane_b32 %0, %7, 6\n\tv_writelane_b32 %0, %8, 7" \
    : "+v"(v) : "s"((unsigned)b[0]), "s"((unsigned)(b[0] >> 32)), "s"((unsigned)b[1]), "s"((unsigned)(b[1] >> 32)), "s"((unsigned)b[2]), "s"((unsigned)(b[2] >> 32)), "s"((unsigned)b[3]), "s"((unsigned)(b[3] >> 32)))
template <int PASS> __device__ __forceinline__ void topk_pass(const bf16x8 (&af)[4][4], const LAS f32x4* wl4, const bf16* IKb, int nb, const TkState& T, int wave, int lane_in, bool low, bf16x8 (&bfirst)[4], unsigned one = 1u) {
    int lane = lane_in; asm volatile("" : "+v"(lane));
    const int hi = lane >> 5, n32 = lane & 31;
    const unsigned sh_m = low ? 11u : 22u, sh_b = low ? 0u : 11u;
    LAS unsigned* GT = T.hist_(); LAS unsigned* EQ = T.hist_() + 32 * 257;
    const bf16* kp0 = IKb + (size_t)lane * 8;
    bf16x8 bc[4];
#pragma unroll
    for (int kk = 0; kk < 4; ++kk) bc[kk] = bfirst[kk];
    const LAS v4u* pa = (const LAS v4u*)(PASS == 2 ? T.sl_lo_() : (low ? T.sl_p2_() : T.sl_p1_()));
    const LAS v4u* pb = (const LAS v4u*)T.sl_hi_();
    for (int blk = wave; blk < nb; blk += 8) {
        constexpr int DB = (PASS == 2) ? 0 : 1;
        f32x4 wq2[2][4]; v4u pfv2[2], pgv2[2];
#define TK_LDW(qg) do { _Pragma("unroll") for (int jj = 0; jj < 4; ++jj) wq2[(qg) & DB][jj] = wl4[((qg) * 2 + hi) * 4 + jj]; if (PASS != 0) pfv2[(qg) & DB] = pa[(qg) * 2 + hi]; if (PASS == 2) pgv2[(qg) & DB] = pb[(qg) * 2 + hi]; } while (0)
        f32x16 acc[2];
#define TK_MMA(dst, qg) do { dst = f32x16{}; _Pragma("unroll") for (int kk = 0; kk < 4; ++kk) dst = __builtin_amdgcn_mfma_f32_32x32x16_bf16(af[qg][kk], bc[kk], dst, 0, 0, 0); } while (0)
        if (DB) TK_LDW(0);
        TK_MMA(acc[0], 0);
#pragma unroll
        for (int qg = 0; qg < 4; ++qg) {
            if (!DB) TK_LDW(qg);
            if (qg < 3) { if (DB) TK_LDW(qg + 1); TK_MMA(acc[(qg + 1) & 1], qg + 1); }
            const f32x4 (&wq)[4] = wq2[qg & DB]; const v4u pfv = pfv2[qg & DB]; const v4u pgv = pgv2[qg & DB];
            if (qg == 2 && blk + 8 < nb) {
#pragma unroll
                for (int kk = 0; kk < 4; ++kk) bc[kk] = *(const GAS bf16x8*)(kp0 + (size_t)(blk + 8) * 2048 + 512 * kk); }
            const f32x16& a = acc[qg & 1];
#define TK_PIN4(x) asm volatile("" : "+v"(x[0]), "+v"(x[1]), "+v"(x[2]), "+v"(x[3]))
            float sc[4], r0[4], r1[4], r2[4], r3[4];
#pragma unroll
            for (int jj = 0; jj < 4; ++jj) { r0[jj] = relu_f(a[4 * jj + 0]); r1[jj] = relu_f(a[4 * jj + 1]); r2[jj] = relu_f(a[4 * jj + 2]); r3[jj] = relu_f(a[4 * jj + 3]); }
            TK_PIN4(r0); TK_PIN4(r1); TK_PIN4(r2); TK_PIN4(r3);
#pragma unroll
            for (int jj = 0; jj < 4; ++jj) sc[jj] = fmaf(wq[jj][0], r0[jj], 0.f);
            TK_PIN4(sc);
#pragma unroll
            for (int jj = 0; jj < 4; ++jj) sc[jj] = fmaf(wq[jj][1], r1[jj], sc[jj]);
            TK_PIN4(sc);
#pragma unroll
            for (int jj = 0; jj < 4; ++jj) sc[jj] = fmaf(wq[jj][2], r2[jj], sc[jj]);
            TK_PIN4(sc);
#pragma unroll
            for (int jj = 0; jj < 4; ++jj) sc[jj] = fmaf(wq[jj][3], r3[jj], sc[jj]);
            TK_PIN4(sc);
#undef TK_PIN4
            LAS unsigned* hq0 = T.hist_() + (8 * qg + hi) * 1024;
            if (PASS == 0) {
#pragma unroll
                for (int jj = 0; jj < 4; ++jj) __hip_atomic_fetch_add(hq0 + jj * 2048 + (__float_as_uint(sc[jj]) >> 22), one, __ATOMIC_RELAXED, __HIP_MEMORY_SCOPE_WORKGROUP); }
            if (PASS == 1) {
#pragma unroll
                for (int jj = 0; jj < 4; ++jj) { const unsigned u = __float_as_uint(sc[jj]); if ((u >> sh_m) == pfv[jj]) { const unsigned bin = (u >> sh_b) & 0x7ffu; __hip_atomic_fetch_add(hq0 + jj * 2048 + (bin >> 1), one << ((bin & 1u) * 16u), __ATOMIC_RELAXED, __HIP_MEMORY_SCOPE_WORKGROUP); } } }
            if (PASS == 2) {
                unsigned long long bg[4], be[4]; unsigned long long anye = 0ull;
#pragma unroll
                for (int jj = 0; jj < 4; ++jj) {
                    bg[jj] = __ballot(sc[jj] > __uint_as_float(pgv[jj])); be[jj] = __ballot(sc[jj] >= __uint_as_float(pfv[jj])) & ~bg[jj];
                    anye |= be[jj]; }
                unsigned vg = 0u;
                TK_WL8(vg, bg);
                if (lane < 8) GT[(8 * qg + lane) * 257 + blk] = vg;
                if (anye != 0ull) {
                    unsigned ve = 0u;
                    TK_WL8(ve, be);
                    if (lane < 8) EQ[(8 * qg + lane) * 257 + blk] = ve;
                    if (!low) {
#pragma unroll
                        for (int jj = 0; jj < 4; ++jj) { if ((be[jj] >> lane) & 1ull) { const int q = 8 * qg + 2 * jj + hi; const unsigned u = __float_as_uint(sc[jj]);
                            const unsigned slot = __hip_atomic_fetch_add(T.ccnt_() + q, 1u, __ATOMIC_RELAXED, __HIP_MEMORY_SCOPE_WORKGROUP);
                            __hip_atomic_fetch_min(T.cmin_() + q, u, __ATOMIC_RELAXED, __HIP_MEMORY_SCOPE_WORKGROUP); __hip_atomic_fetch_max(T.cmax_() + q, u, __ATOMIC_RELAXED, __HIP_MEMORY_SCOPE_WORKGROUP);
                            if (slot < (unsigned)TK_CAP) T.clist_()[q * TK_CAP + slot] = ((unsigned long long)u << 32) | (unsigned)(32 * blk + n32); } } }
                }
            }
        }
#undef TK_MMA
#undef TK_LDW
#undef TK_LDA
    }
    if (wave < nb) {
#pragma unroll
        for (int kk = 0; kk < 4; ++kk) bfirst[kk] = *(const GAS bf16x8*)(kp0 + (size_t)wave * 2048 + 512 * kk); }
}
__device__ __forceinline__ void tk_keep_first(LAS unsigned* eqr, unsigned nd, int lane) {
    unsigned w[4], pc = 0u;
#pragma unroll
    for (int i = 0; i < 4; ++i) { w[i] = eqr[4 * lane + i]; pc += (unsigned)__builtin_popcount(w[i]); }
    const unsigned inc = wave_incl_scan(pc, lane);
    unsigned before = inc - pc;
#pragma unroll
    for (int i = 0; i < 4; ++i) { const unsigned p = (unsigned)__builtin_popcount(w[i]); const int take = (int)nd - (int)before;
        if (take <= 0) w[i] = 0u; else if (take < (int)p) { unsigned x = w[i], r = 0u; for (int k = 0; k < take; ++k) { const unsigned lsb = x & (0u - x); r |= lsb; x ^= lsb; } w[i] = r; }
        before += p; eqr[4 * lane + i] = w[i]; }
}
__device__ __forceinline__ void topk_unit(Frame& F, int b, int c, int half) {
    const bf16* IQ = (const bf16*)(F.ws + WS_IQ); const bf16* IK = (const bf16*)(F.ws + WS_IK); const float* IW = (const float*)(F.ws + WS_IW);
    unsigned long long* MK = (unsigned long long*)(F.ws + WS_MASK);
    TkState T; T.lds = F.lds;
    LAS float* wl = (LAS float*)T.wl_();
    LAS unsigned* GT = T.hist_(); LAS unsigned* EQ = T.hist_() + 32 * 257;
    int tid = F.tid; asm volatile("" : "+v"(tid));
    const int lane = tid & 63, wave = F.wave;
    const int t0 = 64 * c + 32 * half, L = 64 * (c + 1), nb = L / 32; const size_t tokb = (size_t)b * SEQ;
    const int ntile = 4 * (c / 4 + 1);
#pragma unroll
    for (int i = 0; i < 16; ++i) ((LAS v4u*)T.hist_())[tid + 512 * i] = (v4u){0u, 0u, 0u, 0u};
    if (tid < 32) { T.sl_lb_()[tid] = 0xff800000u  ; T.need_()[tid] = (unsigned)TOPK; T.neq_()[tid] = 0u; T.ccnt_()[tid] = 0u; T.cmin_()[tid] = 0xffffffffu; T.cmax_()[tid] = 0u; if (tid == 0) T.flag_()[0] = 0u; }
    if (tid < 128) { const int q = tid >> 2, hd = tid & 3; wl[tk_fidx(q) * 4 + hd] = IW[(tokb + t0 + q) * 4 + hd] * 0.0625f; }
    __syncthreads();
    if (L > TOPK) {
        const LAS f32x4* wr = (const LAS f32x4*)wl;
        bf16x8 af[4][4];
#pragma unroll
        for (int qg = 0; qg < 4; ++qg)
#pragma unroll
            for (int kk = 0; kk < 4; ++kk) af[qg][kk] = *(const GAS bf16x8*)(IQ + (tokb + t0 + 8 * qg) * 256 + (lane & 31) * 64 + 16 * kk + 8 * (lane >> 5));
        const bf16* IKb = IK + tokb * 64;
        bf16x8 bfirst[4];
        if (wave < nb) {
#pragma unroll
            for (int kk = 0; kk < 4; ++kk) bfirst[kk] = *(const GAS bf16x8*)(IKb + (size_t)lane * 8 + (size_t)wave * 2048 + 512 * kk); }
        if ((REP_PHASE) == 22) topk_pass<0>(af, wr, IKb, nb, T, wave, lane, false, bfirst, 0u);
        topk_pass<0>(af, wr, IKb, nb, T, wave, lane, false, bfirst); __syncthreads(); tk_scan<0>(T, wave, lane, true); __syncthreads();
        for (int round = 0; round < 2; ++round) {
            const bool low = round != 0;
            if (low) { if (T.flag_()[0] == 0u && (REP_PHASE) != 50) break;
                __syncthreads();
#pragma unroll
                for (int i = 0; i < 16; ++i) ((LAS v4u*)T.hist_())[tid + 512 * i] = (v4u){0u, 0u, 0u, 0u};
                __syncthreads(); }
            if ((REP_PHASE) == 23) topk_pass<1>(af, wr, IKb, nb, T, wave, lane, low, bfirst, 0u);
            topk_pass<1>(af, wr, IKb, nb, T, wave, lane, low, bfirst); __syncthreads(); tk_scan<2>(T, wave, lane, !low); __syncthreads();
            for (int rep_ = 0; rep_ < ((REP_PHASE) == 20 ? 2 : 1); ++rep_) { if (rep_) { __syncthreads(); if (tid < 32) { T.ccnt_()[tid] = 0u; } __syncthreads(); } topk_pass<2>(af, wr, IKb, nb, T, wave, lane, low, bfirst); }
            __syncthreads();
            for (int qq = 0; qq < 4; ++qq) { const int q = 4 * wave + qq; const unsigned nd = T.need_()[q], nc = T.neq_()[q];
                if (nd >= nc) continue;
                if (low || T.cmin_()[q] == T.cmax_()[q]) { tk_keep_first(EQ + q * 257, nd, lane); continue; }
                if (nc <= (unsigned)TK_CAP && (TK_CAP) > 0) {
                    const unsigned long long me = (lane < (int)nc) ? T.clist_()[q * TK_CAP + lane] : 0ull; const float mv = __uint_as_float((unsigned)(me >> 32)); const unsigned mi = (unsigned)me; unsigned rank = 0u;
                    for (unsigned j = 0; j < nc; ++j) { const unsigned long long o = T.clist_()[q * TK_CAP + j]; const float ov = __uint_as_float((unsigned)(o >> 32)); const unsigned oi = (unsigned)o; rank += (ov > mv || (ov == mv && oi < mi)) ? 1u : 0u; }
                    if (lane < (int)nc && rank >= nd) __hip_atomic_fetch_and(EQ + q * 257 + (mi >> 5), ~(1u << (mi & 31u)), __ATOMIC_RELAXED, __HIP_MEMORY_SCOPE_WORKGROUP);
                    continue; }
                if (lane == 0) T.flag_()[0] = 1u;
            }
            __syncthreads();
            if ((REP_PHASE) == 50 && low) { if (tid < 32) T.ccnt_()[tid] = 0u; __syncthreads(); }
            for (int idx = tid; idx < 32 * ntile; idx += NWAVES * 64) { const int q = idx & 31, t = idx >> 5;
                const unsigned w0 = GT[q * 257 + 2 * t] | EQ[q * 257 + 2 * t], w1 = GT[q * 257 + 2 * t + 1] | EQ[q * 257 + 2 * t + 1];
                const unsigned long long wv = (unsigned long long)w0 | ((unsigned long long)w1 << 32); unsigned long long* dst = MK + ((size_t)b * 128 + t) * SEQ + t0 + q;
                if ((REP_PHASE) == 50 && low) { if (*dst != wv) __hip_atomic_store(F.ctl + CW_CODE, 1u, RLX_AGENT); __hip_atomic_fetch_add(T.ccnt_() + q, (unsigned)__builtin_popcountll(wv), __ATOMIC_RELAXED, __HIP_MEMORY_SCOPE_WORKGROUP); }
                else *dst = wv; }
            __syncthreads();
            if ((REP_PHASE) == 50 && low) { if (tid < 32 && T.ccnt_()[tid] != (unsigned)TOPK) __hip_atomic_store(F.ctl + CW_CODE, 1u, RLX_AGENT); __syncthreads(); }
        }
    } else {
        for (int idx = tid; idx < 32 * ntile; idx += NWAVES * 64) { const int q = idx & 31, t = idx >> 5;
            const unsigned w0 = (2 * t < nb) ? 0xffffffffu : 0u, w1 = (2 * t + 1 < nb) ? 0xffffffffu : 0u;
            MK[((size_t)b * 128 + t) * SEQ + t0 + q] = (unsigned long long)w0 | ((unsigned long long)w1 << 32); }
        __syncthreads();
    }
}
__device__ __forceinline__ void check_indexer(Frame& F) {
    const int gw = F.vcu * NWAVES + F.wave, lane = F.lane; LAS float* qv = (LAS float*)(F.lds + RING_OFF) + F.wave * 256;
    const bf16* IQ = (const bf16*)(F.ws + WS_IQ); const bf16* IK = (const bf16*)(F.ws + WS_IK); const float* IW = (const float*)(F.ws + WS_IW);
    const unsigned long long* MK = (const unsigned long long*)(F.ws + WS_MASK);
    for (int smp = gw; smp < 2048; smp += F.G * NWAVES) { const int b = smp & 1, t = (smp >> 1) * 8 + 3, c = t >> 6, L = 64 * (c + 1); const size_t tok = (size_t)b * SEQ + t;
#pragma unroll
        for (int i = 0; i < 4; ++i) { const unsigned short v = IQ[tok * 256 + lane * 4 + i]; qv[lane * 4 + i] = __uint_as_float((unsigned)v << 16); }
        LDS_WAIT(); asm volatile("" ::: "memory");
        const float w0 = IW[tok * 4 + 0] * 0.0625f, w1 = IW[tok * 4 + 1] * 0.0625f, w2 = IW[tok * 4 + 2] * 0.0625f, w3 = IW[tok * 4 + 3] * 0.0625f;
        float mins = INFINITY, maxu = -INFINITY; int cnt = 0; bool bad = false;
        for (int s = lane; s < 4 * (c / 4 + 1) * 64; s += 64) { const bool sel = (MK[((size_t)b * 128 + (s >> 6)) * SEQ + t] >> (s & 63)) & 1ull;
            if (s >= L) { bad |= sel; continue; }
            cnt += sel ? 1 : 0;
            if (L <= TOPK) { bad |= !sel; continue; }
            const size_t row = (size_t)b * SEQ + s; const bf16* kb = IK + (row >> 5) * 2048 + (row & 31) * 8; float d[4] = {0.f, 0.f, 0.f, 0.f};
            for (int ch = 0; ch < 8; ++ch) { const v4u kv = *(const GAS v4u*)(kb + (ch >> 1) * 512 + (ch & 1) * 256);
                const float kf[8] = {bflo(kv.x), bfhi(kv.x), bflo(kv.y), bfhi(kv.y), bflo(kv.z), bfhi(kv.z), bflo(kv.w), bfhi(kv.w)};
#pragma unroll
                for (int h = 0; h < 4; ++h)
#pragma unroll
                    for (int j = 0; j < 8; ++j) d[h] = fmaf(qv[h * 64 + ch * 8 + j], kf[j], d[h]); }
            const float sc = w0 * fmaxf(d[0], 0.f) + w1 * fmaxf(d[1], 0.f) + w2 * fmaxf(d[2], 0.f) + w3 * fmaxf(d[3], 0.f);
            if (sel) mins = fminf(mins, sc); else maxu = fmaxf(maxu, sc); }
        for (int o = 1; o < 64; o <<= 1) { mins = fminf(mins, __shfl_xor(mins, o)); maxu = fmaxf(maxu, __shfl_xor(maxu, o)); cnt += __shfl_xor(cnt, o); }
        if (L > TOPK) { bad |= (cnt != TOPK); const float tol = 2e-4f * (fabsf(mins) + fabsf(maxu)) + 1e-7f; bad |= (maxu > mins + tol); } else bad |= (cnt != L);
        if (__any(bad) && lane == 0) __hip_atomic_store(F.ctl + CW_CODE, 1u, RLX_AGENT);
        LDS_WAIT(); asm volatile("" ::: "memory");
    }
}
__device__ __forceinline__ void check_attention(Frame& F) {
    const int gw = F.vcu * NWAVES + F.wave, lane = F.lane;
    const bf16* Q = (const bf16*)(F.ws + WS_Q); const bf16* K = (const bf16*)(F.ws + WS_K); const bf16* V = (const bf16*)(F.ws + WS_V); const bf16* YA = (const bf16*)(F.ws + WS_YAP);
    const unsigned long long* MK = (const unsigned long long*)(F.ws + WS_MASK);
    for (int smp = gw; smp < 4096; smp += F.G * NWAVES) { const int b = smp & 1, h = (smp >> 1) & 7, t = (smp >> 4) * 32 + ((smp * 7) & 31), c = t >> 6; const size_t tok = (size_t)b * SEQ + t;
        const float q = __uint_as_float((unsigned)Q[tok * 512 + h * 64 + lane] << 16); float l = 0.f, o = 0.f;
        for (int tt = 0; tt < 4 * (c / 4 + 1); ++tt) { unsigned long long m = MK[((size_t)b * 128 + tt) * SEQ + t];
            while (m) { const int s = tt * 64 + (int)__builtin_ctzll(m); m &= m - 1; const size_t row = (size_t)b * SEQ + s;
                const float kd = __uint_as_float((unsigned)K[row * 512 + h * 64 + lane] << 16), vd = __uint_as_float((unsigned)V[row * 512 + h * 64 + lane] << 16);
                const float p = __builtin_amdgcn_exp2f(wave_sum(q * kd)); l += p; o = fmaf(p, vd, o); } }
        const float ref = o / l, got = __uint_as_float((unsigned)YA[tok * 512 + h * 64 + lane] << 16); const float scale = wave_max(fabsf(ref));
        const bool bad = !(fabsf(got - ref) <= 0.03f * scale + 1e-4f);
        if (__any(bad) && lane == 0) __hip_atomic_store(F.ctl + CW_CODE, 1u, RLX_AGENT);
    }
}
typedef float f32x16r __attribute__((ext_vector_type(16)));
__device__ __forceinline__ void router_phase(Frame& F, bool dry = false) {
    LAS float* tab = (LAS float*)(F.lds + RING_OFF);
    LAS float* xch = (LAS float*)(F.lds + RING_OFF + 131072);
    LAS float* ssq = (LAS float*)(F.lds + XTRA_OFF);
    LAS float* rs = ssq + 512;
    LAS unsigned* lc = (LAS unsigned*)(rs + 64);
    LAS unsigned* basep = lc + 32;
    LAS unsigned* rec_e = basep + 32; LAS unsigned* rec_r = rec_e + 256; LAS float* rec_w = (LAS float*)(rec_r + 256);
    const int tid = F.tid, lane = F.lane, wave = F.wave, m32 = lane & 31, kh = lane >> 5, tile = wave >> 2, kq = wave & 3;
    const float* x1 = F.out; const float* g2 = F.in[11]; const float* rw = F.in[12]; const float* rb = F.in[13];
    bf16* H2 = (bf16*)(F.ws + WS_H2); int* TOKE = (int*)(F.ws + WS_TOKE); int* TOKP = TOKE + M * 4; float* TOKW = (float*)(TOKP + M * 4);
    for (int i0 = tid; i0 < 1024 * 8; i0 += 4 * NWAVES * 64) { f32x4 v[4]; float g[4];
#pragma unroll
        for (int u = 0; u < 4; ++u) { const int i = i0 + u * NWAVES * 64; v[u] = *(const GAS f32x4*)(rw + (size_t)(i >> 3) * 32 + 4 * (i & 7)); g[u] = g2[i >> 3]; }
#pragma unroll
        for (int u = 0; u < 4; ++u) { const int i = i0 + u * NWAVES * 64, k = i >> 3, n0 = 4 * (i & 7); LAS float* d = tab + ((k >> 2) * 32 + n0) * 4 + (k & 3);
            d[0] = v[u].x * g[u]; d[4] = v[u].y * g[u]; d[8] = v[u].z * g[u]; d[12] = v[u].w * g[u]; } }
    if (tid < 32) lc[tid] = 0u;
    __syncthreads();
    for (int tb = blockIdx.x; tb < M / 64; tb += F.G) {
        {
            const size_t tok = (size_t)tb * 64 + tile * 32 + m32; const GAS f32x4* xr = (const GAS f32x4*)(x1 + tok * 1024) + 64 * kq + kh;
            const LAS f32x4* br = (const LAS f32x4*)tab + (size_t)(64 * kq + kh) * 32 + m32;
            f32x16r acc = {}; float ss = 0.f;
#pragma unroll 1
            for (int j0 = 0; j0 < 32; j0 += 8) { f32x4 xv[8];
#pragma unroll
                for (int u = 0; u < 8; ++u) xv[u] = xr[2 * (j0 + u)];
#pragma unroll
                for (int u = 0; u < 8; ++u) { const f32x4 bv = br[2 * (j0 + u) * 32]; const f32x4 x4 = xv[u];
                    ss += (x4.x * x4.x + x4.y * x4.y) + (x4.z * x4.z + x4.w * x4.w);
                    acc = __builtin_amdgcn_mfma_f32_32x32x2f32(x4.x, bv.x, acc, 0, 0, 0); acc = __builtin_amdgcn_mfma_f32_32x32x2f32(x4.y, bv.y, acc, 0, 0, 0);
                    acc = __builtin_amdgcn_mfma_f32_32x32x2f32(x4.z, bv.z, acc, 0, 0, 0); acc = __builtin_amdgcn_mfma_f32_32x32x2f32(x4.w, bv.w, acc, 0, 0, 0); } }
            ssq[(tile * 4 + kq) * 64 + lane] = ss;
            LAS float* xw = xch + ((tile * 2 + (kq >> 1)) * 16) * 64 + lane;
            if (kq & 1) {
#pragma unroll
                for (int r = 0; r < 16; ++r) xw[r * 64] = acc[r]; }
            __syncthreads();
            if (!(kq & 1)) {
#pragma unroll
                for (int r = 0; r < 16; ++r) acc[r] += xw[r * 64]; }
            if (tid < 64) { float q = 0.f;
#pragma unroll
                for (int u = 0; u < 4; ++u) q += ssq[((tid >> 5) * 4 + u) * 64 + (tid & 31)] + ssq[((tid >> 5) * 4 + u) * 64 + 32 + (tid & 31)];
                rs[tid] = 1.0f / sqrtf(q * (1.f / 1024.f) + EPS); }
            __syncthreads();
            LAS float* xw2 = xch + ((tile * 2) * 16) * 64 + lane;
            if (kq == 2) {
#pragma unroll
                for (int r = 0; r < 16; ++r) xw2[r * 64] = acc[r]; }
            __syncthreads();
            if (kq == 0) {
#pragma unroll
                for (int r = 0; r < 16; ++r) acc[r] += xw2[r * 64]; }
            __syncthreads();
            if (kq == 0) { const float bias = rb[m32];
#pragma unroll
                for (int r = 0; r < 16; ++r) { const int tk = (r & 3) + 8 * (r >> 2) + 4 * kh; xch[(tile * 32 + tk) * 33 + m32] = acc[r] * rs[tile * 32 + tk] + bias; } }
            __syncthreads();
        }
        if (tid < 64) {
            const LAS float* lg = xch + tid * 33; float bv[4] = {-INFINITY, -INFINITY, -INFINITY, -INFINITY}; int be[4] = {0, 0, 0, 0};
#pragma unroll
            for (int n = 0; n < 32; ++n) { float v = lg[n]; int e = n;
#pragma unroll
                for (int s2 = 0; s2 < 4; ++s2) { if (v > bv[s2]) { const float tv = bv[s2]; const int te = be[s2]; bv[s2] = v; be[s2] = e; v = tv; e = te; } } }
            const float p1 = __expf(bv[1] - bv[0]), p2 = __expf(bv[2] - bv[0]), p3 = __expf(bv[3] - bv[0]); const float inv = 1.0f / (1.0f + p1 + p2 + p3);
            const float pw[4] = {inv, p1 * inv, p2 * inv, p3 * inv};
            if (!dry) {
#pragma unroll
            for (int s2 = 0; s2 < 4; ++s2) { const unsigned rk = __hip_atomic_fetch_add(lc + be[s2], 1u, __ATOMIC_RELAXED, __HIP_MEMORY_SCOPE_WORKGROUP);
                rec_e[tid * 4 + s2] = (unsigned)be[s2]; rec_r[tid * 4 + s2] = rk; rec_w[tid * 4 + s2] = pw[s2]; } }
        }
        { const GAS f32x4* gr = (const GAS f32x4*)g2 + lane; f32x4 gv[4];
#pragma unroll
          for (int j = 0; j < 4; ++j) gv[j] = gr[64 * j];
          for (int h = 0; h < 2; ++h) { f32x4 v[4][4];
#pragma unroll
            for (int u = 0; u < 4; ++u) { const size_t t = (size_t)tb * 64 + wave * 8 + h * 4 + u; const GAS f32x4* xr = (const GAS f32x4*)(x1 + t * 1024) + lane;
#pragma unroll
                for (int j = 0; j < 4; ++j) v[u][j] = xr[64 * j]; }
#pragma unroll
            for (int u = 0; u < 4; ++u) { const int tl = wave * 8 + h * 4 + u; const size_t t = (size_t)tb * 64 + tl; const float r = rs[tl]; GAS unsigned long long* o8 = (GAS unsigned long long*)(H2 + t * 1024) + lane;
#pragma unroll
                for (int j = 0; j < 4; ++j) { const f32x4 y = v[u][j] * r * gv[j]; o8[64 * j] = (unsigned long long)pk2(y.x, y.y) | ((unsigned long long)pk2(y.z, y.w) << 32); } } } }
        __syncthreads();
        if (tid < 32) basep[tid] = __hip_atomic_fetch_add(F.ctl + CW_CNT + tid, lc[tid], RLX_AGENT);
        __syncthreads();
        if (tid < 256 && !dry) { const size_t p = (size_t)tb * 256 + tid; const unsigned me = rec_e[tid]; TOKE[p] = (int)me; TOKP[p] = (int)(basep[me] + rec_r[tid]); TOKW[p] = rec_w[tid]; }
        __syncthreads();
        if (tid < 32) lc[tid] = 0u;
        __syncthreads();
    }
}
__device__ __forceinline__ void moe_tables(Frame& F, LAS unsigned*& tpre, LAS unsigned*& cntl) {
    cntl = (LAS unsigned*)(F.lds + XTRA_OFF + 8192); tpre = cntl + 32;
    if (F.tid < 32) cntl[F.tid] = __hip_atomic_load(F.ctl + CW_CNT + F.tid, RLX_AGENT);
    __syncthreads();
    if (F.tid == 0) { unsigned a = 0u; for (int e = 0; e < 32; ++e) { tpre[e] = a; a += (cntl[e] + 255u) >> 8; } tpre[32] = a; }
    __syncthreads();
}
__device__ __forceinline__ LAS unsigned* moe_build_units(Frame& F, const LAS unsigned* tpre, int NT) {
    LAS unsigned* list = (LAS unsigned*)(F.lds + XTRA_OFF + 8192 + 512);
    if (F.tid < 24) { unsigned w = 0xffffffffu; const int U = (int)tpre[32] * NT; const long Lg = (long)F.tid * F.G + blockIdx.x;
        if (F.tid < 20 && Lg < U) { int wg = (int)Lg; { const int q = U / 8, r = U % 8, xcd = wg % 8, off = wg / 8; wg = (xcd < r ? xcd * (q + 1) : r * (q + 1) + (xcd - r) * q) + off; }
            int e = 0; while (e < 31 && wg >= (int)tpre[e + 1] * NT) ++e;
            const int rr = wg - (int)tpre[e] * NT, mt = (int)(tpre[e + 1] - tpre[e]); const int n = rr / mt, m = rr % mt;
            w = (unsigned)(tpre[e] + m) | ((unsigned)(e * NT + n) << 16); }
        list[F.tid] = w; }
    __syncthreads();
    return list;
}
__device__ __forceinline__ void gather_phase(Frame& F) {
    LAS unsigned* tpre; LAS unsigned* cntl; moe_tables(F, tpre, cntl);
    const int gt = F.vcu * (NWAVES * 64) + F.tid, NGT = F.G * NWAVES * 64;
    float* ROWW = (float*)(F.ws + WS_ROWW); int* ROWTOK = (int*)(F.ws + WS_ROWW + 1 * MiB);
    const int* TOKE = (const int*)(F.ws + WS_TOKE); const int* TOKP = TOKE + M * 4; const float* TOKW = (const float*)(TOKP + M * 4); int* TOKR = (int*)(TOKW + M * 4);
    for (int p = gt; p < M * 4; p += NGT) { const int e = TOKE[p]; const int row = (int)tpre[e] * 256 + TOKP[p]; TOKR[p] = row; ROWW[row] = TOKW[p]; ROWTOK[row] = p >> 2; }
    for (int i = gt; i < 32 * 256; i += NGT) { const int e = i >> 8; const int row = (int)tpre[e] * 256 + (int)cntl[e] + (i & 255);
        if (row < (int)tpre[e + 1] * 256) { ROWW[row] = 0.f; ROWTOK[row] = 0; } }
}
__device__ __forceinline__ void combine_phase(Frame& F, bool dry = false) {
    const int gw = F.vcu * NWAVES + F.wave, NGW = F.G * NWAVES, lane = F.lane;
    const bf16* Y = (const bf16*)(F.ws + WS_XP); const int* TOKR = (const int*)(F.ws + WS_TOKE) + 3 * M * 4;
    const bool poison = ((REP_PHASE) == 50 || (REP_PHASE) == 51 || (REP_PHASE) == 52 || (REP_PHASE) == 53) && __hip_atomic_load(F.ctl + CW_CODE, RLX_AGENT) != 0u;
    for (int t0 = gw; t0 < M; t0 += 2 * NGW) {
        GAS f32x4* o[2]; f32x4 v[2][4]; v2u y[2][4][4]; int row[2][4];
#pragma unroll
        for (int u = 0; u < 2; ++u) { const int t = t0 + u * NGW; o[u] = (GAS f32x4*)(F.out + (size_t)t * 1024) + lane;
#pragma unroll
            for (int s = 0; s < 4; ++s) row[u][s] = TOKR[t * 4 + s]; }
#pragma unroll
        for (int u = 0; u < 2; ++u) {
#pragma unroll
            for (int j = 0; j < 4; ++j) v[u][j] = o[u][64 * j];
#pragma unroll
            for (int s = 0; s < 4; ++s) { const GAS v2u* yp = (const GAS v2u*)(Y + (size_t)row[u][s] * 1024) + lane;
#pragma unroll
                for (int j = 0; j < 4; ++j) y[u][s][j] = yp[64 * j]; } }
#pragma unroll
        for (int u = 0; u < 2; ++u) { const f32x4 v0[4] = {v[u][0], v[u][1], v[u][2], v[u][3]};
#pragma unroll
            for (int s = 0; s < 4; ++s)
#pragma unroll
                for (int j = 0; j < 4; ++j) { v[u][j].x += bflo(y[u][s][j].x); v[u][j].y += bfhi(y[u][s][j].x); v[u][j].z += bflo(y[u][s][j].y); v[u][j].w += bfhi(y[u][s][j].y); }
#pragma unroll
            for (int j = 0; j < 4; ++j) o[u][64 * j] = poison ? (f32x4){__builtin_nanf(""), __builtin_nanf(""), __builtin_nanf(""), __builtin_nanf("")} : ((dry && v[u][j].x == v[u][j].x) ? v0[j] : v[u][j]); }
    }
}
struct Args { const float* in[18]; float* out; unsigned char* ws; int ph_lo, ph_hi; };
static_assert(sizeof(Args) == 18 * 8 + 8 + 8 + 8, "Args has no padding bytes");
__global__ void __launch_bounds__(NWAVES * 64, 2) mk_fwd(Args args) {
    extern __shared__ __attribute__((aligned(16))) unsigned char lds[];
    Frame F;
    F.lds = (LAS unsigned char*)lds;
    F.MISC = (volatile LAS unsigned*)(F.lds + MISC_OFF);
    F.tid = threadIdx.x; F.lane = F.tid & 63; F.wave = __builtin_amdgcn_readfirstlane(F.tid >> 6);
    F.G = gridDim.x; { const int bx = blockIdx.x; F.vcu = (F.G % 8 == 0) ? (bx % 8) * (F.G / 8) + bx / 8 : bx; }
    F.ws = args.ws; F.ctl = (gu32*)(args.ws + WS_CTL); F.out = args.out;
#pragma unroll
    for (int i = 0; i < 18; ++i) F.in[i] = args.in[i];
    for (int u = F.tid; u < (LDS_BYTES - LDSCTL_OFF) / 4; u += NWAVES * 64) ((LAS unsigned*)(F.lds + LDSCTL_OFF))[u] = 0u;
    __syncthreads();
    XcdBarrier bar; bar.bar = (unsigned*)(F.ctl + CW_BAR); bar.x = 0; bar.st = nullptr;
    if (!MK_SPLIT) bar = xcd_barrier_post((unsigned*)(F.ctl + CW_BAR), F.MISC + 8);
#define GRID_BAR() do { if (MK_SPLIT) { if (F.tid == 0) __hip_atomic_store(F.ctl + CW_TMO, 0xBADBA0u, RLX_AGENT); } else { xcd_barrier(bar); if ((REP_PHASE) == 40) xcd_barrier(bar); } } while (0)
    const int lo = args.ph_lo, hi = args.ph_hi;
#define IN(k) (lo <= (k) && (k) < hi)
#define BOTH(k) (IN(k) && IN((k) + 1))
    constexpr bool AL = true, SP = true;
#ifndef REP_PHASE
#define REP_PHASE -1
#endif
#define REPS(k) for (int rep_ = 0; rep_ < ((REP_PHASE) == (k) ? 2 : 1); ++rep_)
    if (IN(0)) { REPS(0) p0_prologue(F); if (BOTH(0)) GRID_BAR(); }
    if (IN(1)) {
        pg8::Gemm g{(const bf16*)(F.ws + WS_H), (const bf16*)(F.ws + WS_WIN), M, NINP, DMODEL}; pg8::StaticOrder S; S.init(M, NINP, F.G, (int)blockIdx.x);
        pg8::EpiInProj E{F.ws};
        REPS(1) pg8::gemm_phase<pg8::EpiInProj, pg8::StaticOrder, AL, SP>(F.lds + RING_OFF, g, S, E);
        if (BOTH(1)) GRID_BAR();
    }
    if (IN(2)) {
        if ((REP_PHASE) == 32) qknorm_rows(F, true);
        qknorm_rows(F); REPS(30) pool_diff_rows(F);
        REPS(2) for (int v = F.vcu; v < 256; v += F.G) { const int b = v >> 7, half = (v >> 6) & 1, cc = v & 63; for (int k = 0; k < ((REP_PHASE) == 24 ? 3 : (REP_PHASE) == 25 ? 4 : 2); ++k) topk_unit(F, b, k >= 2 ? 4 : (k ? cc : 127 - cc), half); }
        if (BOTH(2)) GRID_BAR();
    }
    if (IN(3)) {
        { pg8::Gemm g{(const bf16*)(F.ws + WS_DIFF), (const bf16*)(F.ws + WS_WPOOL), M, DPOOL, DPOOL}; pg8::StaticOrder S; S.init(M, DPOOL, F.G, (int)blockIdx.x);
          pg8::EpiPool E{(bf16*)(F.ws + WS_YAP + 16 * MiB), F.in[6], F.in[7]};
          REPS(31) pg8::gemm_phase<pg8::EpiPool, pg8::StaticOrder, AL, SP>(F.lds + RING_OFF, g, S, E); }
        const float cshift = attn_body::C2 * 64.0f * wave_max(fabsf(F.in[3][F.lane])) * wave_max(fabsf(F.in[4][F.lane]));
        REPS(3) for (int v = F.vcu; v < 256; v += F.G) { const int bh = v >> 4, s = v & 15;
            for (int i = 0; i < 2; ++i) attn_body::attn_unit(bh >> 3, bh & 7, i == 0 ? 31 - s : s, (const attn_body::bf16*)(F.ws + WS_Q), (const attn_body::bf16*)(F.ws + WS_K), (const attn_body::bf16*)(F.ws + WS_V),
                                                             (attn_body::bf16*)(F.ws + WS_YAP), (const unsigned long long*)(F.ws + WS_MASK), cshift, (char*)lds + RING_OFF); }
        if (BOTH(3)) GRID_BAR();
    }
    if (IN(4)) {
        if ((REP_PHASE) == 52) { check_attention(F); __syncthreads(); }
        if ((REP_PHASE) == 53) { check_indexer(F); __syncthreads(); }
        pg8::StaticOrder S; S.init(M, DMODEL, F.G, (int)blockIdx.x);
        { pg8::Gemm g{(const bf16*)(F.ws + WS_YAP), (const bf16*)(F.ws + WS_WAB), M, DMODEL, 512};
          pg8::EpiGate E{(const bf16*)(F.ws + WS_GA), nullptr, (bf16*)(F.ws + WS_TMP)};
          pg8::gemm_phase<pg8::EpiGate, pg8::StaticOrder, AL, SP>(F.lds + RING_OFF, g, S, E); }
        { pg8::Gemm g{(const bf16*)(F.ws + WS_YAP + 16 * MiB), (const bf16*)(F.ws + WS_WAB + 1 * MiB), M, DMODEL, 512};
          pg8::EpiGate E{(const bf16*)(F.ws + WS_GB), (const bf16*)(F.ws + WS_TMP), (bf16*)(F.ws + WS_MERGED)};
          pg8::gemm_phase<pg8::EpiGate, pg8::StaticOrder, AL, SP>(F.lds + RING_OFF, g, S, E); }
        if (BOTH(4)) GRID_BAR();
    }
    if (IN(5)) {
        pg8::Gemm g{(const bf16*)(F.ws + WS_MERGED), (const bf16*)(F.ws + WS_WOUT), M, DMODEL, DMODEL}; pg8::StaticOrder S; S.init(M, DMODEL, F.G, (int)blockIdx.x);
        pg8::EpiResF32 E{F.in[0], F.out};
        REPS(5) pg8::gemm_phase<pg8::EpiResF32, pg8::StaticOrder, AL, SP>(F.lds + RING_OFF, g, S, E);
        if (BOTH(5)) GRID_BAR();
    }
    if (IN(6)) { if ((REP_PHASE) == 6) router_phase(F, true); router_phase(F); if (BOTH(6)) GRID_BAR(); }
    if (IN(7)) { REPS(7) gather_phase(F); if (BOTH(7)) GRID_BAR(); }
    if (IN(8)) {
        LAS unsigned* tpre; LAS unsigned* cntl; moe_tables(F, tpre, cntl);
        pg8::ListOrder S{moe_build_units(F, tpre, 8)};
        pg8::Gemm g{(const bf16*)(F.ws + WS_H2), (const bf16*)(F.ws + WS_W1), MPAD, NEXP * 2048, DMODEL};
        pg8::EpiSwiglu E{F.in[15], (bf16*)(F.ws + WS_ACT)};
        REPS(8) pg8::gemm_phase<pg8::EpiSwiglu, pg8::ListOrder, AL, SP, true>(F.lds + RING_OFF, g, S, E, (const int*)(F.ws + WS_ROWW + 1 * MiB));
        if (BOTH(8)) GRID_BAR();
    }
    if (IN(9)) {
        LAS unsigned* tpre; LAS unsigned* cntl; moe_tables(F, tpre, cntl);
        pg8::ListOrder S{moe_build_units(F, tpre, 4)};
        pg8::Gemm g{(const bf16*)(F.ws + WS_ACT), (const bf16*)(F.ws + WS_W2), MPAD, NEXP * 1024, DEXP};
        pg8::EpiDown E{F.in[17], (const float*)(F.ws + WS_ROWW), (bf16*)(F.ws + WS_XP)};
        REPS(9) pg8::gemm_phase<pg8::EpiDown, pg8::ListOrder, AL, SP>(F.lds + RING_OFF, g, S, E);
        if (BOTH(9)) GRID_BAR();
    }
    if (IN(2) && (REP_PHASE) == 51 && blockIdx.x == 3 && F.tid == 0) __hip_atomic_store(F.ctl + CW_CODE, 1u, RLX_AGENT);
    if (IN(10)) { if ((REP_PHASE) == 10) combine_phase(F, true); combine_phase(F); }
#undef IN
#undef BOTH
}

extern "C" void kernel_launch(void* const* d_in, const int* in_sizes, int n_in, void* d_out, int out_size, void* d_ws, size_t ws_size, hipStream_t stream) {
    static int grid = 0;
    if (grid == 0) {
        if (n_in != 18 || in_sizes[0] != M * DMODEL || out_size != M * DMODEL || ws_size < WS_END) { fprintf(stderr, "kernel_launch: built for 18 inputs, x/out of %d floats, >= %zu bytes of workspace; got n_in %d, in0 %d, out %d, ws %zu; nothing launched\n", M * DMODEL, (size_t)WS_END, n_in, n_in > 0 ? in_sizes[0] : -1, out_size, ws_size); grid = -1; return; }
        int dev = 0, cus = 0, per_cu = 0;
        if (hipGetDevice(&dev) != hipSuccess || hipDeviceGetAttribute(&cus, hipDeviceAttributeMultiprocessorCount, dev) != hipSuccess) { fprintf(stderr, "kernel_launch: hipGetDevice / hipDeviceGetAttribute failed; nothing launched\n"); grid = -1; return; }
        if (hipFuncSetAttribute((const void*)mk_fwd, hipFuncAttributeMaxDynamicSharedMemorySize, LDS_BYTES) != hipSuccess) { fprintf(stderr, "kernel_launch: hipFuncSetAttribute failed; nothing launched\n"); grid = -1; return; }
        if (hipOccupancyMaxActiveBlocksPerMultiprocessor(&per_cu, (const void*)mk_fwd, NWAVES * 64, LDS_BYTES) != hipSuccess || per_cu < 1) { fprintf(stderr, "kernel_launch: occupancy query reports %d workgroups per CU; nothing launched\n", per_cu); (void)hipGetLastError(); grid = -1; return; }
        (void)hipGetLastError();
        grid = cus;
    }
    if (grid < 0) return;
    if (hipMemsetAsync((char*)d_ws + WS_CTL, 0, CTL_ZERO_BYTES, stream) != hipSuccess) { fprintf(stderr, "kernel_launch: hipMemsetAsync of the control words failed; nothing launched\n"); return; }
    Args a{};
    for (int i = 0; i < 18; ++i) a.in[i] = (const float*)d_in[i];
    a.out = (float*)d_out; a.ws = (unsigned char*)d_ws;
    const int nl = MK_SPLIT ? N_PHASES : 1;
    for (int li = 0; li < nl; ++li) {
        a.ph_lo = MK_SPLIT ? li : 0; a.ph_hi = MK_SPLIT ? li + 1 : N_PHASES;
        hipLaunchKernelGGL(mk_fwd, dim3(grid), dim3(NWAVES * 64), LDS_BYTES, stream, a);
        const hipError_t le = hipPeekAtLastError();
        if (le != hipSuccess) { fprintf(stderr, "kernel_launch: launch %d failed: %s (grid %d x %d threads, %d B LDS)\n", li, hipGetErrorName(le), grid, NWAVES * 64, LDS_BYTES); break; }
    }
}
```
